# Optimizing an MI355X kernel written in HIP

```python
import jax, jax.numpy as jnp
from jax import lax
import numpy as np

D_MODEL = 1024
BATCH = 4
SEQ = 8192
DEPTH = 4

CTX_LEN = 256
GRID_W = 64
N_MIXERS = 2
HG_DK = 128
HG_HEADS = D_MODEL // HG_DK
HG_DV = D_MODEL // HG_HEADS
HG_CHUNK = 64
HK = HG_HEADS * HG_DK
HV = HG_HEADS * HG_DV
HG_IN = 3 * HK + 2 * HV
HG_SPLITS = [HK, HK + HV, HK + 2 * HV, 2 * HK + 2 * HV]
SGU_CHUNK = 128
SGU_WIDTH = 3 * D_MODEL
SGU_GROUPS = 8
D_FF = 128 * ((8 * D_MODEL // 3 + 127) // 128)
CONV_W = 3
N_HGRN = (DEPTH + 1) // 2
N_SGU = DEPTH // 2
ALPHA = (2.0 * DEPTH) ** 0.25
BETA = (8.0 * DEPTH) ** -0.25
LN_EPS = 1e-5
RMS_EPS = 1e-6

kernel_name = "hybrid_hgrn2_chunkgmlp_convffn_deepnorm_prefix"


def layer_norm(x, g, b):
    xf = x.astype(jnp.float32)
    mu = jnp.mean(xf, axis=-1, keepdims=True)
    var = jnp.mean(jnp.square(xf - mu), axis=-1, keepdims=True)
    return ((xf - mu) * lax.rsqrt(var + LN_EPS)).astype(x.dtype) * g + b


def modulate(h, shift, scale):
    return h * (1.0 + scale) + shift


def _heads(t, d):
    b, l, _ = t.shape
    return t.reshape(b, l, HG_HEADS, d).transpose(0, 2, 1, 3).astype(jnp.float32)


def _flip(t):
    return jnp.flip(t, axis=2)


def _forget(z_f, lb):
    lb = lb.reshape(HG_HEADS, 1, HG_DK)
    f = lb + (1.0 - lb) * jax.nn.sigmoid(_heads(z_f, HG_DK))
    return 1.0 - f, jnp.log(f)


def gla_scan(q, k, v, logf, s0):
    b, h, l, _ = q.shape
    n = l // HG_CHUNK
    to_chunks = lambda t: jnp.moveaxis(t.reshape(b, h, n, HG_CHUNK, t.shape[-1]), 2, 0)
    mask = jnp.tril(jnp.ones((HG_CHUNK, HG_CHUNK), bool))[:, :, None]

    def step(s, inp):
        qc, kc, vc, gc = inp
        G = jnp.cumsum(gc, axis=2)
        g_end = G[:, :, -1, :]
        o_inter = jnp.einsum('bhtk,bhkv->bhtv', qc * jnp.exp(G), s)
        rel = jnp.where(mask, G[:, :, :, None, :] - G[:, :, None, :, :], -jnp.inf)
        scores = jnp.einsum('bhtk,bhsk,bhtsk->bhts', qc, kc, jnp.exp(rel))
        o = o_inter + jnp.einsum('bhts,bhsv->bhtv', scores, vc)
        s = jnp.exp(g_end)[..., None] * s + jnp.einsum(
            'bhsk,bhsv->bhkv', kc * jnp.exp(g_end[:, :, None, :] - G), vc)
        return s, o

    s, o = lax.scan(step, s0, (to_chunks(q), to_chunks(k), to_chunks(v), to_chunks(logf)))
    return jnp.moveaxis(o, 0, 2).reshape(b, h, l, -1), s


def gla_final_state(k, v, logf):
    G = jnp.cumsum(logf, axis=2)
    return jnp.einsum('bhsk,bhsv->bhkv', k * jnp.exp(G[:, :, -1:, :] - G), v)


def _hg_readout(o, g, norm_w, w_out, dtype):
    o = o * lax.rsqrt(jnp.mean(o * o, axis=-1, keepdims=True) + RMS_EPS) * norm_w.astype(jnp.float32)
    b, h, l, v = o.shape
    o = o.transpose(0, 2, 1, 3).reshape(b, l, h * v).astype(dtype)
    return (o * jax.nn.silu(g)) @ w_out


def hgrn2_mixer(hx, hc, w_in, lb_fwd, lb_bwd, norm_w, w_out, ctx_out):
    dt = hx.dtype
    if ctx_out:
        qc, gc, ic, ffc, fbc = jnp.split(hc @ w_in, HG_SPLITS, axis=-1)
        qc = _heads(jax.nn.silu(qc), HG_DK)
        vc = _heads(ic, HG_DV)
        kfc, lfc = _forget(ffc, lb_fwd)
        kbc, lbc = _forget(fbc, lb_bwd)
        zero = jnp.zeros(qc.shape[:2] + (HG_DK, HG_DV), jnp.float32)
        oc_f, s_f = gla_scan(qc, kfc, vc, lfc, zero)
        oc_b, s_b = gla_scan(_flip(qc), _flip(kbc), _flip(vc), _flip(lbc), zero)
        yc = _hg_readout(oc_f + _flip(oc_b), gc, norm_w, w_out, dt)
    else:
        ic, ffc, fbc = jnp.split(hc @ w_in[:, HK + HV:], [HV, HV + HK], axis=-1)
        vc = _heads(ic, HG_DV)
        kfc, lfc = _forget(ffc, lb_fwd)
        kbc, lbc = _forget(fbc, lb_bwd)
        s_f = gla_final_state(kfc, vc, lfc)
        s_b = gla_final_state(_flip(kbc), _flip(vc), _flip(lbc))
        yc = None
    qx, gx, ix, ffx, fbx = jnp.split(hx @ w_in, HG_SPLITS, axis=-1)
    qx = _heads(jax.nn.silu(qx), HG_DK)
    vx = _heads(ix, HG_DV)
    kfx, lfx = _forget(ffx, lb_fwd)
    kbx, lbx = _forget(fbx, lb_bwd)
    ox_f, _ = gla_scan(qx, kfx, vx, lfx, s_f)
    ox_b, _ = gla_scan(_flip(qx), _flip(kbx), _flip(vx), _flip(lbx), s_b)
    yx = _hg_readout(ox_f + _flip(ox_b), gx, norm_w, w_out, dt)
    return yx, yc


def hgrn_lower_bounds(hg_lb):
    p = jax.nn.softmax(hg_lb.astype(jnp.float32), axis=1)
    return jnp.cumsum(p, axis=1) - p[:, :1]


def chunk_sgu(h, w_in, ln_g, ln_b, w_s, b_s, w_out):
    b, l, _ = h.shape
    n = l // SGU_CHUNK
    z = jax.nn.gelu(h @ w_in, approximate=False)
    u, v = jnp.split(z, 2, axis=-1)
    v = layer_norm(v, ln_g, ln_b)
    v = v.reshape(b, n, SGU_CHUNK, SGU_GROUPS, SGU_WIDTH // SGU_GROUPS)
    v = jnp.einsum('gpq,bnqgc->bnpgc', w_s, v) + b_s.T[:, :, None]
    return (u * v.reshape(b, l, SGU_WIDTH)) @ w_out


def conv_ffn(h, w_up, conv_w, conv_b, w_down, rows, row_len):
    b, l, _ = h.shape
    y = (h @ w_up).reshape(b, rows, row_len, 2 * D_FF)
    yp = jnp.pad(y, ((0, 0), (0, 0), (1, 1), (0, 0)))
    y = yp[:, :, :-2] * conv_w[0] + yp[:, :, 1:-1] * conv_w[1] + yp[:, :, 2:] * conv_w[2] + conv_b
    a, g = jnp.split(y.reshape(b, l, 2 * D_FF), 2, axis=-1)
    return (jax.nn.silu(g) * a) @ w_down


def setup_inputs(seed: int = 0) -> dict:
    key = jax.random.key(seed)
    ks = jax.random.split(key, 24)
    nrm = lambda k, shape, s: jax.random.normal(k, shape, jnp.float32) * s
    D = D_MODEL
    return {
        "x": nrm(ks[0], (BATCH, SEQ, D), 1.0),
        "c": nrm(ks[1], (BATCH, D), 1.0),
        "ctx": nrm(ks[2], (BATCH, CTX_LEN, D), 1.0),
        "c_ctx": nrm(ks[3], (D,), 1.0),
        "ada_w": nrm(ks[4], (DEPTH, D, 6 * D), D ** -0.5),
        "ada_b": nrm(ks[5], (DEPTH, 6 * D), 0.02),
        "ln_g": 1.0 + nrm(ks[6], (DEPTH, 2, D), 0.02),
        "ln_b": nrm(ks[7], (DEPTH, 2, D), 0.02),
        "hg_w_in": nrm(ks[8], (N_HGRN, D, HG_IN), D ** -0.5),
        "hg_lb": nrm(ks[9], (2, N_HGRN, HK), 0.5),
        "hg_norm_w": 1.0 + nrm(ks[10], (N_HGRN, HG_DV), 0.02),
        "hg_w_out": nrm(ks[11], (N_HGRN, HV, D), HV ** -0.5 * BETA),
        "sgu_w_in": nrm(ks[12], (N_SGU, D, 2 * SGU_WIDTH), D ** -0.5),
        "sgu_ln_g": 1.0 + nrm(ks[13], (N_SGU, SGU_WIDTH), 0.02),
        "sgu_ln_b": nrm(ks[14], (N_SGU, SGU_WIDTH), 0.02),
        "sgu_w_s": nrm(ks[15], (N_SGU, SGU_GROUPS, SGU_CHUNK, SGU_CHUNK), SGU_CHUNK ** -0.5),
        "sgu_b_s": 1.0 + nrm(ks[16], (N_SGU, SGU_GROUPS, SGU_CHUNK), 0.02),
        "sgu_w_out": nrm(ks[17], (N_SGU, SGU_WIDTH, D), SGU_WIDTH ** -0.5 * BETA),
        "ffn_w_up": nrm(ks[18], (DEPTH, D, 2 * D_FF), D ** -0.5),
        "ffn_conv_w": nrm(ks[19], (DEPTH, CONV_W, 2 * D_FF), CONV_W ** -0.5),
        "ffn_conv_b": nrm(ks[20], (DEPTH, 2 * D_FF), 0.02),
        "ffn_w_down": nrm(ks[21], (DEPTH, D_FF, D), D_FF ** -0.5 * BETA),
    }


def reference(x, c, ctx, c_ctx, ada_w, ada_b, ln_g, ln_b, hg_w_in, hg_lb, hg_norm_w, hg_w_out,
              sgu_w_in, sgu_ln_g, sgu_ln_b, sgu_w_s, sgu_b_s, sgu_w_out,
              ffn_w_up, ffn_conv_w, ffn_conv_b, ffn_w_down):
    rows = x.shape[1] // GRID_W
    ctx_len = ctx.shape[1]
    lbs = hgrn_lower_bounds(hg_lb)
    sc, scc = jax.nn.silu(c), jax.nn.silu(c_ctx)
    h, hc = x, ctx
    for layer in range(DEPTH):
        kind = layer % N_MIXERS
        idx = layer // N_MIXERS
        ctx_later = any(j % N_MIXERS == 0 for j in range(layer + 1, DEPTH))
        mx = (sc @ ada_w[layer] + ada_b[layer])[:, None, :]
        sh1, sc1, ga1, sh2, sc2, ga2 = jnp.split(mx, 6, axis=-1)
        if kind == 0 or ctx_later:
            mc = scc @ ada_w[layer] + ada_b[layer]
            csh1, csc1, cga1, csh2, csc2, cga2 = jnp.split(mc, 6, axis=-1)
        if kind == 0:
            yx, yc = hgrn2_mixer(modulate(h, sh1, sc1), modulate(hc, csh1, csc1),
                                 hg_w_in[idx], lbs[0, idx], lbs[1, idx],
                                 hg_norm_w[idx], hg_w_out[idx], ctx_later)
        else:
            yx = chunk_sgu(modulate(h, sh1, sc1), sgu_w_in[idx], sgu_ln_g[idx], sgu_ln_b[idx],
                           sgu_w_s[idx], sgu_b_s[idx], sgu_w_out[idx])
            if ctx_later:
                yc = chunk_sgu(modulate(hc, csh1, csc1), sgu_w_in[idx], sgu_ln_g[idx], sgu_ln_b[idx],
                               sgu_w_s[idx], sgu_b_s[idx], sgu_w_out[idx])
        h = layer_norm(ALPHA * h + ga1 * yx, ln_g[layer, 0], ln_b[layer, 0])
        f = conv_ffn(modulate(h, sh2, sc2), ffn_w_up[layer], ffn_conv_w[layer], ffn_conv_b[layer],
                     ffn_w_down[layer], rows, GRID_W)
        h = layer_norm(ALPHA * h + ga2 * f, ln_g[layer, 1], ln_b[layer, 1])
        if ctx_later:
            hc = layer_norm(ALPHA * hc + cga1 * yc, ln_g[layer, 0], ln_b[layer, 0])
            fc = conv_ffn(modulate(hc, csh2, csc2), ffn_w_up[layer], ffn_conv_w[layer],
                          ffn_conv_b[layer], ffn_w_down[layer], 1, ctx_len)
            hc = layer_norm(ALPHA * hc + cga2 * fc, ln_g[layer, 1], ln_b[layer, 1])
    return h
```

```cpp
#include <hip/hip_runtime.h>
#include <hip/hip_cooperative_groups.h>
#include <cstdio>
namespace cg = cooperative_groups;

typedef unsigned short bf16_t;
typedef short bf16x8 __attribute__((ext_vector_type(8)));
typedef float f32x4 __attribute__((ext_vector_type(4)));
typedef float f32x2 __attribute__((ext_vector_type(2)));
typedef unsigned u32x4 __attribute__((ext_vector_type(4)));
typedef unsigned u32x2 __attribute__((ext_vector_type(2)));

__device__ __forceinline__ unsigned cvt_pk_bf16(float lo, float hi) { unsigned r; asm volatile("v_cvt_pk_bf16_f32 %0, %1, %2" : "=v"(r) : "v"(lo), "v"(hi)); return r; }
__device__ __forceinline__ bf16_t f2bf(float f) { return (bf16_t)(cvt_pk_bf16(f, 0.f) & 0xffffu); }
__device__ __forceinline__ float bf2f(bf16_t b) { return __uint_as_float(((unsigned)b) << 16); }
__device__ __forceinline__ float bflo(unsigned w) { return __uint_as_float(w << 16); }
__device__ __forceinline__ float bfhi(unsigned w) { return __uint_as_float(w & 0xffff0000u); }
__device__ __forceinline__ float silu_f(float v) { return v * __builtin_amdgcn_rcpf(1.0f + __expf(-v)); }
__device__ __forceinline__ float sigmoid_f(float v) { return __builtin_amdgcn_rcpf(1.0f + __expf(-v)); }
__device__ __forceinline__ f32x2 gelu_pk(f32x2 v) {
    const f32x2 av = __builtin_elementwise_abs(v), d = av * 0.2316418882f + 1.0f;
    f32x2 t; t.x = __builtin_amdgcn_rcpf(d.x); t.y = __builtin_amdgcn_rcpf(d.y);
    f32x2 q = t * 0.5307027145f + (-0.7265760135f); q = q * t + 0.7107068705f; q = q * t + (-0.142248368f); q = q * t + 0.127414796f; q = q * t;
    const f32x2 s = (v * v) * (-0.72134752044f);
    f32x2 e; e.x = __builtin_amdgcn_exp2f(s.x); e.y = __builtin_amdgcn_exp2f(s.y);
    const f32x2 m = v * (q * e), r = v - m;
    f32x2 o; o.x = v.x < 0.f ? m.x : r.x; o.y = v.y < 0.f ? m.y : r.y; return o;
}

__device__ __forceinline__ int tidx() { int t = threadIdx.x; asm volatile("" : "+v"(t)); return t; }
__device__ __forceinline__ int bidx() { int b = blockIdx.x; asm volatile("" : "+s"(b)); return b; }

constexpr int DM = 1024, NB = 4, SEQ = 8192, CTXL = 256, MLAT = NB * SEQ, MCTX = NB * CTXL;
constexpr int HGIN = 5120, SGW = 3072, SGIN = 6144, DFF = 2816, UPW = 5632;
constexpr int SLAB = 16384;
constexpr float ALPHA_F = 1.6817928305074292f;
constexpr int LDP = 136;

constexpr size_t al256(size_t x) { return (x + 255) & ~(size_t)255; }
constexpr size_t OFF_WT_HGIN = 0;
constexpr size_t OFF_WT_HGOUT = OFF_WT_HGIN + al256((size_t)2 * HGIN * DM * 2);
constexpr size_t OFF_WT_SGIN = OFF_WT_HGOUT + al256((size_t)2 * DM * DM * 2);
constexpr size_t OFF_WT_SGOUT = OFF_WT_SGIN + al256((size_t)2 * SGIN * DM * 2);
constexpr size_t OFF_WT_UP = OFF_WT_SGOUT + al256((size_t)2 * DM * SGW * 2);
constexpr size_t OFF_WT_DOWN = OFF_WT_UP + al256((size_t)4 * UPW * DM * 2);
constexpr size_t OFF_WS_B = OFF_WT_DOWN + al256((size_t)4 * DM * DFF * 2);
constexpr size_t OFF_MOD = OFF_WS_B + al256((size_t)2 * 8 * 128 * 128 * 2);
constexpr size_t OFF_LBS = OFF_MOD + al256((size_t)4 * 5 * 6144 * 4);
constexpr size_t OFF_HMOD = OFF_LBS + al256((size_t)2 * 2 * 1024 * 4);
constexpr size_t OFF_HC = OFF_HMOD + al256((size_t)MLAT * DM * 2);
constexpr size_t OFF_HCMOD = OFF_HC + al256((size_t)MCTX * DM * 4);
constexpr size_t OFF_ZC = OFF_HCMOD + al256((size_t)MCTX * DM * 2);
constexpr size_t OFF_ACTC = OFF_ZC + al256((size_t)MCTX * SGIN * 2);
constexpr size_t OFF_OLC = OFF_ACTC + al256((size_t)MCTX * DFF * 2);
constexpr size_t OFF_UCTX = OFF_OLC + al256((size_t)MCTX * DM * 2);
constexpr size_t OFF_DCTX = OFF_UCTX + al256((size_t)NB * 8 * 2 * 16384 * 4);
constexpr size_t OFF_BIG = OFF_DCTX + al256((size_t)NB * 8 * 2 * 128 * 4);
constexpr size_t BIG_HG_Z = 0;
constexpr size_t BIG_HG_OL = BIG_HG_Z + (size_t)SLAB * HGIN * 2;
constexpr size_t BIG_HG_U = BIG_HG_OL + (size_t)SLAB * DM * 2;
constexpr size_t BIG_HG_D = BIG_HG_U + (size_t)32 * 16 * 16384 * 4;
constexpr size_t BIG_HG_END = BIG_HG_D + (size_t)32 * 16 * 128 * 4;
constexpr size_t BIG_FF_ACT = (size_t)SLAB * UPW * 2;
constexpr size_t BIG_FF_END = BIG_FF_ACT + (size_t)SLAB * DFF * 2;
constexpr size_t BIG_SG_END = (size_t)SLAB * SGIN * 2;
constexpr size_t BIG_BYTES = BIG_FF_END > BIG_HG_END ? (BIG_FF_END > BIG_SG_END ? BIG_FF_END : BIG_SG_END) : (BIG_HG_END > BIG_SG_END ? BIG_HG_END : BIG_SG_END);
constexpr size_t WS_END = OFF_BIG + BIG_BYTES;
static_assert(WS_END <= (size_t)536870912, "workspace map exceeds the guaranteed 512 MiB");
constexpr int LDS_BYTES = 144 * 1024;

struct Params { const float* in[22]; float* out; unsigned char* ws; };
namespace pg8 {
#define PG8_LAS __attribute__((address_space(3)))
constexpr int BM = 256, BK = 64, HALF = 128, HTB = HALF * BK * 2, STAGE_BYTES = 8 * HTB, NXCD = 8, WGM = 8;
__host__ __device__ __forceinline__ int lds_byte(int r, int c) { const int st = (r >> 4) * 2 + (c >> 5), rr = r & 15, cc = c & 31, ob = rr * 64 + cc * 2; return st * 1024 + (ob ^ (((ob >> 9) & 1) << 5)); }
__host__ __device__ __forceinline__ void stage_rc(int b, int& R, int& C) { const int st = b / 1024, sb = b % 1024, swz = sb ^ (((sb >> 9) & 1) << 5); R = (st >> 1) * 16 + swz / 64; C = (st & 1) * 32 + (swz % 64) / 2; }
__host__ __device__ __forceinline__ int perm32(int rho) { const int n = rho >> 4, i = rho & 15; return 8 * (i >> 2) + 4 * n + (i & 3); }
struct Unit { int pm, pn; };
struct Gemm { const bf16_t* A; const bf16_t* Bt; int M, N, K, lda; };
struct StaticOrder {
    int nM, nN, nwg, G, c;
    __device__ void init(int M, int N, int G_, int c_) { nM = M / BM; nN = N / BM; nwg = nM * nN; G = G_; c = c_; }
    __device__ bool next(int i, Unit& u) const {
        const long L = (long)i * G + c; if (L >= nwg) return false;
        int wgid = (int)L; { const int q = nwg / NXCD, r = nwg % NXCD, xcd = wgid % NXCD, off = wgid / NXCD; wgid = (xcd < r ? xcd * (q + 1) : r * (q + 1) + (xcd - r) * q) + off; }
        const int nig = WGM * nN, gid = wgid / nig, fm = gid * WGM, gsz = (nM - fm) < WGM ? (nM - fm) : WGM;
        u.pm = fm + ((wgid % nig) % gsz); u.pn = (wgid % nig) / gsz; return true;
    }
};
template <class Epi>
__device__ __forceinline__ void gemm_phase(PG8_LAS unsigned char* lds, const Gemm g, const StaticOrder& S, const Epi& E) {
    const bool perm = E.perm();
    const int tid = tidx(), wid = __builtin_amdgcn_readfirstlane(tid >> 6), lane = tid & 63, wr = wid >> 2, wc = wid & 3, fr = lane & 15, fq = lane >> 4;
    const int K = g.K, nt = K / BK, lda = g.lda;
    unsigned voffA[2], voffB[2];
#pragma unroll
    for (int i = 0; i < 2; ++i) { int R, C; stage_rc(tid * 16 + i * 8192, R, C); const int Rb = perm ? ((R & ~31) + perm32(R & 31)) : R;
        voffA[i] = (unsigned)(R * lda + C) * 2u; voffB[i] = (unsigned)(Rb * K + C) * 2u; }
    const size_t kstep = (size_t)(BK * 2);
    const size_t hstepA = (size_t)HALF * lda * 2, hstepB = (size_t)HALF * K * 2;
    const size_t tstepA = 2 * hstepA, tstepB = 2 * hstepB;
    const unsigned ldsw = (unsigned)wid * 1024u;
    const int aoff = lds_byte(wr * 64 + fr, fq * 8), boff = lds_byte(wc * 32 + fr, fq * 8);
#define PG8_SA(b, h) (((b) * 2 + (h)) * HTB)
#define PG8_SB(b, h) ((4 + (b) * 2 + (h)) * HTB)
#define PG8_STAGE(bufoff, gbase, voff) do { _Pragma("unroll") for (int _i = 0; _i < 2; ++_i) \
        __builtin_amdgcn_global_load_lds((const unsigned*)((const char*)(gbase) + (voff)[_i]), (PG8_LAS unsigned*)(lds + (bufoff) + ldsw + _i * 8192), 16, 0, 0); } while (0)
#define PG8_LDA(dst, b, h) do { _Pragma("unroll") for (int m = 0; m < 4; ++m) _Pragma("unroll") for (int k = 0; k < 2; ++k) dst[m][k] = *(const PG8_LAS bf16x8*)(lds + PG8_SA(b, h) + aoff + m * 2048 + k * 1024); } while (0)
#define PG8_LDB(dst, b, h) do { _Pragma("unroll") for (int n = 0; n < 2; ++n) _Pragma("unroll") for (int k = 0; k < 2; ++k) dst[n][k] = *(const PG8_LAS bf16x8*)(lds + PG8_SB(b, h) + boff + n * 2048 + k * 1024); } while (0)
#define PG8_MMA(ai, bj, At, Bt) do { __builtin_amdgcn_s_setprio(1); _Pragma("unroll") for (int m = 0; m < 4; ++m) _Pragma("unroll") for (int n = 0; n < 2; ++n) _Pragma("unroll") for (int k = 0; k < 2; ++k) \
        acc[ai][bj][m][n] = __builtin_amdgcn_mfma_f32_16x16x32_bf16(Bt[n][k], At[m][k], acc[ai][bj][m][n], 0, 0, 0); __builtin_amdgcn_s_setprio(0); } while (0)
#define PG8_WAIT_V(n) asm volatile("s_waitcnt vmcnt(" #n ")" ::: "memory")
#define PG8_WAIT_L(n) asm volatile("s_waitcnt lgkmcnt(" #n ")" ::: "memory")
#define PG8_BAR __builtin_amdgcn_s_barrier()
#define PG8_SCHED __builtin_amdgcn_sched_barrier(0)
    Unit cur, nxt; int ui = 0;
    if (!S.next(0, cur)) return;
    f32x4 acc[2][2][4][2];
#pragma unroll
    for (int a = 0; a < 2; ++a)
#pragma unroll
        for (int b = 0; b < 2; ++b)
#pragma unroll
            for (int m = 0; m < 4; ++m)
#pragma unroll
                for (int n = 0; n < 2; ++n) acc[a][b][m][n] = (f32x4){0.f, 0.f, 0.f, 0.f};
    bf16x8 At[4][2], B0[2][2], B1[2][2];
    const char* cA = (const char*)g.A + (size_t)cur.pm * tstepA; const char* cB = (const char*)g.Bt + (size_t)cur.pn * tstepB;
    PG8_STAGE(PG8_SB(0, 0), cB, voffB); PG8_STAGE(PG8_SA(0, 0), cA, voffA); PG8_STAGE(PG8_SB(0, 1), cB + hstepB, voffB); PG8_STAGE(PG8_SA(0, 1), cA + hstepA, voffA);
    if (wr == 1) PG8_BAR;
    PG8_WAIT_V(4); PG8_BAR;
    PG8_STAGE(PG8_SB(1, 0), cB + kstep, voffB); PG8_STAGE(PG8_SA(1, 0), cA + kstep, voffA); PG8_STAGE(PG8_SB(1, 1), cB + hstepB + kstep, voffB);
    PG8_WAIT_V(6); PG8_BAR;
    for (;;) {
        const bool has_next = S.next(ui + 1, nxt);
        const char* nA = has_next ? (const char*)g.A + (size_t)nxt.pm * tstepA : cA; const char* nB = has_next ? (const char*)g.Bt + (size_t)nxt.pn * tstepB : cB;
        for (int t = 0; t < nt; t += 2) {
            const bool last = (t == nt - 2);
            const char* a1 = cA + (size_t)(t + 1) * kstep;
            const char* a2 = last ? nA : cA + (size_t)(t + 2) * kstep; const char* b2 = last ? nB : cB + (size_t)(t + 2) * kstep;
            const char* a3 = a2 + kstep; const char* b3 = b2 + kstep;
            PG8_LDB(B0, 0, 0); PG8_SCHED; PG8_LDA(At, 0, 0); PG8_STAGE(PG8_SA(1, 1), a1 + hstepA, voffA);
            PG8_WAIT_L(8); PG8_BAR; PG8_WAIT_L(0); PG8_MMA(0, 0, At, B0); PG8_BAR; PG8_SCHED;
            PG8_LDB(B1, 0, 1); PG8_STAGE(PG8_SB(0, 0), b2, voffB);
            PG8_BAR; PG8_WAIT_L(0); PG8_MMA(0, 1, At, B1); PG8_BAR;
            PG8_LDA(At, 0, 1); PG8_STAGE(PG8_SA(0, 0), a2, voffA);
            PG8_BAR; PG8_WAIT_L(0); PG8_MMA(1, 0, At, B0); PG8_BAR; PG8_SCHED;
            PG8_STAGE(PG8_SB(0, 1), b2 + hstepB, voffB);
            PG8_WAIT_V(6); PG8_BAR; PG8_MMA(1, 1, At, B1); PG8_BAR;
            PG8_LDB(B0, 1, 0); PG8_SCHED; PG8_LDA(At, 1, 0); PG8_STAGE(PG8_SA(0, 1), a2 + hstepA, voffA);
            PG8_WAIT_L(8); PG8_BAR; PG8_WAIT_L(0); PG8_MMA(0, 0, At, B0); PG8_BAR; PG8_SCHED;
            PG8_LDB(B1, 1, 1); PG8_STAGE(PG8_SB(1, 0), b3, voffB);
            PG8_BAR; PG8_WAIT_L(0); PG8_MMA(0, 1, At, B1); PG8_BAR;
            PG8_LDA(At, 1, 1); PG8_STAGE(PG8_SA(1, 0), a3, voffA);
            PG8_BAR; PG8_WAIT_L(0); PG8_MMA(1, 0, At, B0); PG8_BAR; PG8_SCHED;
            PG8_STAGE(PG8_SB(1, 1), b3 + hstepB, voffB);
            PG8_WAIT_V(6); PG8_BAR; PG8_MMA(1, 1, At, B1); PG8_BAR;
        }
        E(acc, cur, wr, wc, fr, fq);
        if (!has_next) break;
#pragma unroll
        for (int a = 0; a < 2; ++a)
#pragma unroll
            for (int b = 0; b < 2; ++b)
#pragma unroll
                for (int m = 0; m < 4; ++m)
#pragma unroll
                    for (int n = 0; n < 2; ++n) acc[a][b][m][n] = (f32x4){0.f, 0.f, 0.f, 0.f};
        cur = nxt; cA = nA; cB = nB; ++ui;
    }
    PG8_WAIT_V(0);
    if (wr == 0) PG8_BAR;
    PG8_BAR;
#undef PG8_SA
#undef PG8_SB
#undef PG8_STAGE
#undef PG8_LDA
#undef PG8_LDB
#undef PG8_MMA
#undef PG8_WAIT_V
#undef PG8_WAIT_L
#undef PG8_BAR
#undef PG8_SCHED
}
}
struct EpiAny {
    int kind;
    bf16_t* O; int ldc; int mode; int silu_tiles;
    const float* hin; float* out; const float* gate; int b0; int ctx;
    __device__ __forceinline__ bool perm() const { return kind == 0; }
    __device__ __forceinline__ void operator()(const f32x4 (&acc)[2][2][4][2], const pg8::Unit& u, int wr, int wc, int fr, int fq) const {
        if (kind == 0) {
            const int row0 = u.pm * 256 + wr * 64 + fr, col0 = u.pn * 256 + wc * 32 + 8 * fq;
            const bool do_silu = (mode == 1) && (u.pn < silu_tiles);
#pragma unroll
            for (int ai = 0; ai < 2; ++ai)
#pragma unroll
                for (int m = 0; m < 4; ++m) { bf16_t* rowp = O + (size_t)(row0 + ai * 128 + m * 16) * ldc + col0;
#pragma unroll
                    for (int bj = 0; bj < 2; ++bj) { f32x4 v0 = acc[ai][bj][m][0], v1 = acc[ai][bj][m][1];
                        if (mode == 2) { f32x2 a = gelu_pk((f32x2){v0[0], v0[1]}), b = gelu_pk((f32x2){v0[2], v0[3]}), c = gelu_pk((f32x2){v1[0], v1[1]}), d = gelu_pk((f32x2){v1[2], v1[3]});
                            v0 = (f32x4){a.x, a.y, b.x, b.y}; v1 = (f32x4){c.x, c.y, d.x, d.y}; }
                        else if (do_silu) {
#pragma unroll
                            for (int j = 0; j < 4; ++j) { v0[j] = silu_f(v0[j]); v1[j] = silu_f(v1[j]); } }
                        u32x4 w; w.x = cvt_pk_bf16(v0[0], v0[1]); w.y = cvt_pk_bf16(v0[2], v0[3]); w.z = cvt_pk_bf16(v1[0], v1[1]); w.w = cvt_pk_bf16(v1[2], v1[3]);
                        *(u32x4*)(rowp + bj * 128) = w; } }
        } else {
            const int row0 = u.pm * 256 + wr * 64 + fr, col0 = u.pn * 256 + wc * 32 + 4 * fq;
            const int b = ctx ? 4 : b0 + (u.pm * 256) / SEQ;
            const float* gp = gate + (size_t)b * 6144 + col0;
            f32x4 gv[2][2];
#pragma unroll
            for (int bj = 0; bj < 2; ++bj)
#pragma unroll
                for (int n = 0; n < 2; ++n) gv[bj][n] = *(const f32x4*)(gp + bj * 128 + n * 16);
#pragma unroll
            for (int ai = 0; ai < 2; ++ai)
#pragma unroll
                for (int m = 0; m < 4; ++m) { const size_t off = (size_t)(row0 + ai * 128 + m * 16) * DM + col0;
#pragma unroll
                    for (int bj = 0; bj < 2; ++bj)
#pragma unroll
                        for (int n = 0; n < 2; ++n) { const f32x4 h4 = *(const f32x4*)(hin + off + bj * 128 + n * 16);
                            *(f32x4*)(out + off + bj * 128 + n * 16) = h4 * ALPHA_F + gv[bj][n] * acc[ai][bj][m][n]; } }
        }
    }
};
struct GemmJob { const bf16_t* A; const bf16_t* Bt; int lda, M, N, K; EpiAny e; };
constexpr int EPI_LDS_OFF = 131072;
struct EpiLds {
    int kind0;
    __device__ __forceinline__ bool perm() const { return kind0 == 0; }
    __device__ __forceinline__ void operator()(const f32x4 (&acc)[2][2][4][2], const pg8::Unit& u, int wr, int wc, int fr, int fq) const {
        extern __shared__ __attribute__((aligned(16))) unsigned char smem_e[];
        const EpiAny e = *(const EpiAny*)(smem_e + EPI_LDS_OFF);
        e(acc, u, wr, wc, fr, fq);
    }
};
__device__ __forceinline__ void gemm_call(unsigned char* smem, const GemmJob& j) {
    __syncthreads();
    if (tidx() == 0) *(EpiAny*)(smem + EPI_LDS_OFF) = j.e;
    __syncthreads();
    pg8::Gemm g; g.A = j.A; g.Bt = j.Bt; g.M = j.M; g.N = j.N; g.K = j.K; g.lda = j.lda;
    pg8::StaticOrder S; S.init(j.M, j.N, (int)gridDim.x, bidx());
    EpiLds el; el.kind0 = j.e.kind;
    pg8::gemm_phase<EpiLds>((PG8_LAS unsigned char*)smem, g, S, el);
}

__device__ void transpose_cvt(const float* src, bf16_t* dst, int nmat, int K, int N, int ffn_perm, float* tile  ) {
    const int tid = tidx(), tk = K / 64, tn = N / 64, per = tk * tn, total = nmat * per;
    for (int u = bidx(); u < total; u += gridDim.x) {
        const int mi = u / per, r = u % per, kt = r / tn, ntl = r % tn;
        const float* s = src + (size_t)mi * K * N + (size_t)(kt * 64) * N + ntl * 64;
#pragma unroll
        for (int i = 0; i < 2; ++i) { const int row = (tid >> 4) + 32 * i, c4 = (tid & 15) * 4; const f32x4 v = *(const f32x4*)(s + (size_t)row * N + c4);
            tile[row * 65 + c4 + 0] = v[0]; tile[row * 65 + c4 + 1] = v[1]; tile[row * 65 + c4 + 2] = v[2]; tile[row * 65 + c4 + 3] = v[3]; }
        __syncthreads();
        { const int n = tid >> 3, k8 = (tid & 7) * 8; int ng = ntl * 64 + n;
          if (ffn_perm) ng = ng < DFF ? ((ng >> 7) * 256 + (ng & 127)) : ((((ng - DFF) >> 7) * 256) + 128 + ((ng - DFF) & 127));
          u32x4 w; w.x = cvt_pk_bf16(tile[(k8 + 0) * 65 + n], tile[(k8 + 1) * 65 + n]); w.y = cvt_pk_bf16(tile[(k8 + 2) * 65 + n], tile[(k8 + 3) * 65 + n]);
          w.z = cvt_pk_bf16(tile[(k8 + 4) * 65 + n], tile[(k8 + 5) * 65 + n]); w.w = cvt_pk_bf16(tile[(k8 + 6) * 65 + n], tile[(k8 + 7) * 65 + n]);
          *(u32x4*)(dst + (size_t)mi * K * N + (size_t)ng * K + kt * 64 + k8) = w; }
        __syncthreads();
    }
}
__device__ void phase0(const Params& p, unsigned char* smem) {
    const int tid = tidx();
    unsigned char* ws = p.ws;
    float* mod = (float*)(ws + OFF_MOD);
    {
        float* sc = (float*)smem; float* red = sc + 5 * 1024;
        const float* c = p.in[1]; const float* cctx = p.in[3]; const float* ada_w = p.in[4]; const float* ada_b = p.in[5];
        for (int i = tid; i < 5 * 1024; i += 512) { const float v = i < 4096 ? c[i] : cctx[i - 4096]; sc[i] = silu_f(v); }
        __syncthreads();
        for (int u = bidx(); u < 256; u += gridDim.x) {
            const int l = u >> 6, col0 = (u & 63) * 96, cq = tid % 24, kp = tid / 24;
            float acc[5][4];
#pragma unroll
            for (int r = 0; r < 5; ++r)
#pragma unroll
                for (int e = 0; e < 4; ++e) acc[r][e] = 0.f;
            if (kp < 21) {
                for (int k = kp; k < 1024; k += 21) { const f32x4 w = *(const f32x4*)(ada_w + ((size_t)l * 1024 + k) * 6144 + col0 + cq * 4);
#pragma unroll
                    for (int r = 0; r < 5; ++r) { const float s = sc[r * 1024 + k];
#pragma unroll
                        for (int e = 0; e < 4; ++e) acc[r][e] += s * w[e]; } }
#pragma unroll
                for (int r = 0; r < 5; ++r)
#pragma unroll
                    for (int e = 0; e < 4; ++e) red[(kp * 5 + r) * 96 + cq * 4 + e] = acc[r][e];
            }
            __syncthreads();
            if (tid < 480) { const int r = tid / 96, cc = tid % 96; float s = ada_b[l * 6144 + col0 + cc];
                for (int k2 = 0; k2 < 21; ++k2) s += red[(k2 * 5 + r) * 96 + cc];
                mod[((size_t)l * 5 + r) * 6144 + col0 + cc] = s; }
            __syncthreads();
        }
    }
    if (bidx() == 0) {
        const float* hg_lb = p.in[9]; float* lbs = (float*)(ws + OFF_LBS);
        for (int i = tid; i < 2048; i += 512) { const int dir = i >> 10, k = i & 1023; const float a0 = hg_lb[(dir * 2 + 0) * 1024 + k], a1 = hg_lb[(dir * 2 + 1) * 1024 + k];
            lbs[(dir * 2 + 0) * 1024 + k] = 0.f; lbs[(dir * 2 + 1) * 1024 + k] = 1.0f / (1.0f + expf(a0 - a1)); }
    }
    {
        const float* s = p.in[15]; bf16_t* d = (bf16_t*)(ws + OFF_WS_B);
        for (int i = bidx() * 512 + tid; i < 2 * 8 * 128 * 128 / 4; i += gridDim.x * 512) { const f32x4 v = *(const f32x4*)(s + (size_t)i * 4); u32x2 w; w.x = cvt_pk_bf16(v[0], v[1]); w.y = cvt_pk_bf16(v[2], v[3]); *(u32x2*)(d + (size_t)i * 4) = w; }
    }
    __syncthreads();
    float* tile = (float*)smem;
    transpose_cvt(p.in[8], (bf16_t*)(ws + OFF_WT_HGIN), 2, DM, HGIN, 0, tile);
    transpose_cvt(p.in[11], (bf16_t*)(ws + OFF_WT_HGOUT), 2, DM, DM, 0, tile);
    transpose_cvt(p.in[12], (bf16_t*)(ws + OFF_WT_SGIN), 2, DM, SGIN, 0, tile);
    transpose_cvt(p.in[17], (bf16_t*)(ws + OFF_WT_SGOUT), 2, SGW, DM, 0, tile);
    transpose_cvt(p.in[18], (bf16_t*)(ws + OFF_WT_UP), 4, DM, UPW, 1, tile);
    transpose_cvt(p.in[21], (bf16_t*)(ws + OFF_WT_DOWN), 4, DFF, DM, 0, tile);
}

__device__ void ln_mod(const float* src, float* hdst, bf16_t* mdst, const float* lng, const float* lnb, bool do_ln,
                       const float* shift, const float* scale, int nrows, int rows_per_b, int b0) {
    const int lane = tidx() & 63, gw = bidx() * 8 + (tidx() >> 6), nw = gridDim.x * 8;
    for (int row = gw; row < nrows; row += nw) {
        const float* s = src + (size_t)row * DM; f32x4 x[4];
#pragma unroll
        for (int i = 0; i < 4; ++i) x[i] = *(const f32x4*)(s + i * 256 + lane * 4);
        if (do_ln) {
            float sm = 0.f;
#pragma unroll
            for (int i = 0; i < 4; ++i) sm += (x[i][0] + x[i][1]) + (x[i][2] + x[i][3]);
#pragma unroll
            for (int o = 32; o >= 1; o >>= 1) sm += __shfl_xor(sm, o);
            const float mean = sm * (1.0f / 1024.0f); float q = 0.f;
#pragma unroll
            for (int i = 0; i < 4; ++i) { const f32x4 d = x[i] - mean; q += (d[0] * d[0] + d[1] * d[1]) + (d[2] * d[2] + d[3] * d[3]); }
#pragma unroll
            for (int o = 32; o >= 1; o >>= 1) q += __shfl_xor(q, o);
            const float rstd = rsqrtf(q * (1.0f / 1024.0f) + 1e-5f);
#pragma unroll
            for (int i = 0; i < 4; ++i) { const f32x4 g4 = *(const f32x4*)(lng + i * 256 + lane * 4), b4 = *(const f32x4*)(lnb + i * 256 + lane * 4);
                x[i] = (x[i] - mean) * rstd * g4 + b4; *(f32x4*)(hdst + (size_t)row * DM + i * 256 + lane * 4) = x[i]; }
        }
        if (mdst) {
            const int b = b0 + row / rows_per_b; const float* sh = shift + (size_t)b * 6144; const float* scl = scale + (size_t)b * 6144;
#pragma unroll
            for (int i = 0; i < 4; ++i) { const f32x4 s4 = *(const f32x4*)(sh + i * 256 + lane * 4), c4 = *(const f32x4*)(scl + i * 256 + lane * 4);
                const f32x4 y = x[i] * (c4 + 1.0f) + s4; u32x2 w; w.x = cvt_pk_bf16(y[0], y[1]); w.y = cvt_pk_bf16(y[2], y[3]);
                *(u32x2*)(mdst + (size_t)row * DM + i * 256 + lane * 4) = w; }
        }
    }
}

__device__ __forceinline__ void tile_mma_128(const bf16_t* la, const bf16_t* lb, f32x4 (&acc)[8], int w, int fr, int fq) {
#pragma unroll
    for (int kk = 0; kk < 4; ++kk) {
        const bf16x8 a = *(const bf16x8*)(la + (16 * w + fr) * LDP + kk * 32 + fq * 8);
#pragma unroll
        for (int nb = 0; nb < 8; ++nb) { const bf16x8 b = *(const bf16x8*)(lb + (16 * nb + fr) * LDP + kk * 32 + fq * 8);
            acc[nb] = __builtin_amdgcn_mfma_f32_16x16x32_bf16(b, a, acc[nb], 0, 0, 0); }
    }
}

__device__ void scan_unit(unsigned char* smem, bf16_t* Z, int T, int h, const float* lbf, const float* lbb, bf16_t* OL, float* Uf, float* Ub, float* Df, float* Db) {
    float* Qs = (float*)smem; float* Fs = Qs + 2048; float* Ks = Fs + 2048; float* Vs = Ks + 2048; float* OP = Vs + 2048;
    const int tid = tidx(), d = tid & 127, kq = tid >> 7, ttl = tid >> 5, k4 = (tid & 31) * 4;
    for (int dir = 0; dir < 2; ++dir) {
        const int zcol = (dir ? 4096 : 3072) + h * 128;
        const float* lb = (dir ? lbb : lbf) + h * 128;
        const f32x4 lbv = *(const f32x4*)(lb + k4);
        float S[32];
#pragma unroll
        for (int i = 0; i < 32; ++i) S[i] = 0.f;
        float P = 1.f;
#pragma unroll 1
        for (int st = 0; st < T / 16; ++st) {
            __syncthreads();
            {   const int pos = st * 16 + ttl, tok = dir ? (T - 1 - pos) : pos;
                const bf16_t* zr = Z + (size_t)tok * HGIN;
                const u32x2 q2 = *(const u32x2*)(zr + h * 128 + k4), f2 = *(const u32x2*)(zr + zcol + k4), v2 = *(const u32x2*)(zr + 2048 + h * 128 + k4);
                const float zf[4] = {bflo(f2.x), bfhi(f2.x), bflo(f2.y), bfhi(f2.y)};
                f32x4 fv, kv;
#pragma unroll
                for (int e = 0; e < 4; ++e) { const float f = lbv[e] + (1.0f - lbv[e]) * sigmoid_f(zf[e]); fv[e] = f; kv[e] = 1.0f - f; }
                *(f32x4*)(Fs + ttl * 128 + k4) = fv; *(f32x4*)(Ks + ttl * 128 + k4) = kv;
                *(f32x4*)(Qs + ttl * 128 + k4) = (f32x4){bflo(q2.x), bfhi(q2.x), bflo(q2.y), bfhi(q2.y)};
                *(f32x4*)(Vs + ttl * 128 + k4) = (f32x4){bflo(v2.x), bfhi(v2.x), bflo(v2.y), bfhi(v2.y)};
            }
            __syncthreads();
            if (tid < 128) {
#pragma unroll 1
                for (int tt = 0; tt < 16; ++tt) { P *= Fs[tt * 128 + tid]; const float qg = Qs[tt * 128 + tid] * P;
                    const int pos = st * 16 + tt, tok = dir ? (T - 1 - pos) : pos; Z[(size_t)tok * HGIN + zcol + tid] = f2bf(qg); }
            }
#pragma unroll 1
            for (int tt = 0; tt < 16; ++tt) {
                const float v = Vs[tt * 128 + d]; float o = 0.f;
                const f32x4* F4 = (const f32x4*)(Fs + tt * 128 + kq * 32); const f32x4* K4 = (const f32x4*)(Ks + tt * 128 + kq * 32); const f32x4* Q4 = (const f32x4*)(Qs + tt * 128 + kq * 32);
#pragma unroll
                for (int i4 = 0; i4 < 8; ++i4) { const f32x4 f = F4[i4], k = K4[i4], q = Q4[i4];
#pragma unroll
                    for (int e = 0; e < 4; ++e) { S[i4 * 4 + e] = f[e] * S[i4 * 4 + e] + k[e] * v; o += q[e] * S[i4 * 4 + e]; } }
                OP[(kq * 16 + tt) * 128 + d] = o;
            }
            __syncthreads();
            {   const f32x4 s = *(const f32x4*)(OP + (0 * 16 + ttl) * 128 + k4) + *(const f32x4*)(OP + (1 * 16 + ttl) * 128 + k4) + *(const f32x4*)(OP + (2 * 16 + ttl) * 128 + k4) + *(const f32x4*)(OP + (3 * 16 + ttl) * 128 + k4);
                const int pos = st * 16 + ttl, tok = dir ? (T - 1 - pos) : pos;
                bf16_t* op = OL + (size_t)tok * DM + h * 128 + k4; f32x4 r = s;
                if (dir) { const u32x2 pv = *(const u32x2*)op; r[0] += bflo(pv.x); r[1] += bfhi(pv.x); r[2] += bflo(pv.y); r[3] += bfhi(pv.y); }
                u32x2 w; w.x = cvt_pk_bf16(r[0], r[1]); w.y = cvt_pk_bf16(r[2], r[3]); *(u32x2*)op = w;
            }
        }
        float* U = dir ? Ub : Uf;
#pragma unroll
        for (int i = 0; i < 32; ++i) U[(kq * 32 + i) * 128 + d] = S[i];
        if (tid < 128) (dir ? Db : Df)[tid] = P;
    }
    __syncthreads();
}
__device__ void scan_pass2(float* U, const float* Dk, const float* Uctx, int s) {
    const int gt = bidx() * 512 + tidx(), nt = gridDim.x * 512;
    for (int e4 = gt; e4 < 32 * 4096; e4 += nt) {
        const int seq = e4 >> 12, el = (e4 & 4095) * 4, k = el >> 7, bl = seq >> 4, hd = seq & 15, dir = seq & 1;
        f32x4 cur = *(const f32x4*)(Uctx + (size_t)((s * 2 + bl) * 16 + hd) * 16384 + el);
        for (int jj = 0; jj < 16; ++jj) { const int j = dir ? 15 - jj : jj; float* up = U + ((size_t)seq * 16 + j) * 16384 + el;
            const f32x4 tmp = *(const f32x4*)up; *(f32x4*)up = cur; const float dk = Dk[(seq * 16 + j) * 128 + k]; cur = cur * dk + tmp; }
    }
}
__device__ void scan_pass3_unit(unsigned char* smem, bf16_t* Z, const bf16_t* OL, const float* U, const float* normw, int bl, int h, int tile) {
    bf16_t* la = (bf16_t*)smem; bf16_t* lb = la + 128 * LDP;
    const int tid = tidx(), w = tid >> 6, lane = tid & 63, fr = lane & 15, fq = lane >> 4;
    const int tok0 = bl * SEQ + tile * 128, j = tile >> 2;
    f32x4 acc[8];
#pragma unroll
    for (int nb = 0; nb < 8; ++nb) acc[nb] = (f32x4){0.f, 0.f, 0.f, 0.f};
    for (int dir = 0; dir < 2; ++dir) {
        __syncthreads();
        const int zcol = (dir ? 4096 : 3072) + h * 128;
#pragma unroll
        for (int i = 0; i < 4; ++i) { const int c = tid + 512 * i, r = c >> 4, k8 = (c & 15) * 8;
            *(u32x4*)(la + r * LDP + k8) = *(const u32x4*)(Z + (size_t)(tok0 + r) * HGIN + zcol + k8); }
        const float* Sp = U + ((size_t)((bl * 8 + h) * 2 + dir) * 16 + j) * 16384;
#pragma unroll
        for (int i = 0; i < 8; ++i) { const int c = tid + 512 * i, k = c >> 5, d4 = (c & 31) * 4; const f32x4 v = *(const f32x4*)(Sp + k * 128 + d4);
            lb[(d4 + 0) * LDP + k] = f2bf(v[0]); lb[(d4 + 1) * LDP + k] = f2bf(v[1]); lb[(d4 + 2) * LDP + k] = f2bf(v[2]); lb[(d4 + 3) * LDP + k] = f2bf(v[3]); }
        __syncthreads();
        tile_mma_128(la, lb, acc, w, fr, fq);
    }
    const int tok = tok0 + 16 * w + fr;
    float ss = 0.f;
#pragma unroll
    for (int nb = 0; nb < 8; ++nb) { const u32x2 pv = *(const u32x2*)(OL + (size_t)tok * DM + h * 128 + 16 * nb + 4 * fq);
        acc[nb][0] += bflo(pv.x); acc[nb][1] += bfhi(pv.x); acc[nb][2] += bflo(pv.y); acc[nb][3] += bfhi(pv.y);
        ss += (acc[nb][0] * acc[nb][0] + acc[nb][1] * acc[nb][1]) + (acc[nb][2] * acc[nb][2] + acc[nb][3] * acc[nb][3]); }
    ss += __shfl_xor(ss, 16); ss += __shfl_xor(ss, 32);
    const float rn = rsqrtf(ss * (1.0f / 128.0f) + 1e-6f);
#pragma unroll
    for (int nb = 0; nb < 8; ++nb) { bf16_t* gp = Z + (size_t)tok * HGIN + 1024 + h * 128 + 16 * nb + 4 * fq; const u32x2 gv = *(const u32x2*)gp;
        const f32x4 nw = *(const f32x4*)(normw + 16 * nb + 4 * fq);
        u32x2 wv; wv.x = cvt_pk_bf16(acc[nb][0] * rn * nw[0] * bflo(gv.x), acc[nb][1] * rn * nw[1] * bfhi(gv.x));
        wv.y = cvt_pk_bf16(acc[nb][2] * rn * nw[2] * bflo(gv.y), acc[nb][3] * rn * nw[3] * bfhi(gv.y)); *(u32x2*)gp = wv; }
}
__device__ void ctx_readout(bf16_t* Zc, const bf16_t* OLc, const float* normw) {
    const int lane = tidx() & 63, gw = bidx() * 8 + (tidx() >> 6), nw = gridDim.x * 8;
    for (int row = gw; row < MCTX; row += nw) {
        const bf16_t* op = OLc + (size_t)row * DM + lane * 16; bf16_t* gp = Zc + (size_t)row * HGIN + 1024 + lane * 16;
        const u32x4 o0 = *(const u32x4*)op, o1 = *(const u32x4*)(op + 8);
        float o[16] = {bflo(o0.x), bfhi(o0.x), bflo(o0.y), bfhi(o0.y), bflo(o0.z), bfhi(o0.z), bflo(o0.w), bfhi(o0.w), bflo(o1.x), bfhi(o1.x), bflo(o1.y), bfhi(o1.y), bflo(o1.z), bfhi(o1.z), bflo(o1.w), bfhi(o1.w)};
        float ss = 0.f;
#pragma unroll
        for (int e = 0; e < 16; ++e) ss += o[e] * o[e];
        ss += __shfl_xor(ss, 1); ss += __shfl_xor(ss, 2); ss += __shfl_xor(ss, 4);
        const float rn = rsqrtf(ss * (1.0f / 128.0f) + 1e-6f);
        const u32x4 g0 = *(const u32x4*)gp, g1 = *(const u32x4*)(gp + 8);
        const float g[16] = {bflo(g0.x), bfhi(g0.x), bflo(g0.y), bfhi(g0.y), bflo(g0.z), bfhi(g0.z), bflo(g0.w), bfhi(g0.w), bflo(g1.x), bfhi(g1.x), bflo(g1.y), bfhi(g1.y), bflo(g1.z), bfhi(g1.z), bflo(g1.w), bfhi(g1.w)};
        const float* nwp = normw + (lane & 7) * 16;
#pragma unroll
        for (int e = 0; e < 16; ++e) o[e] = o[e] * rn * nwp[e] * g[e];
        u32x4 w0, w1; w0.x = cvt_pk_bf16(o[0], o[1]); w0.y = cvt_pk_bf16(o[2], o[3]); w0.z = cvt_pk_bf16(o[4], o[5]); w0.w = cvt_pk_bf16(o[6], o[7]);
        w1.x = cvt_pk_bf16(o[8], o[9]); w1.y = cvt_pk_bf16(o[10], o[11]); w1.z = cvt_pk_bf16(o[12], o[13]); w1.w = cvt_pk_bf16(o[14], o[15]);
        *(u32x4*)gp = w0; *(u32x4*)(gp + 8) = w1;
    }
}

__device__ void sgu_mix_unit(unsigned char* smem, bf16_t* Z, int chunk, int gh, const bf16_t* wsb  , const float* bs  , const float* lng, const float* lnb) {
    float* stats = (float*)smem;
    bf16_t* la = (bf16_t*)(smem + 1024); bf16_t* lb = la + 128 * LDP;
    const int tid = tidx(), w = tid >> 6, lane = tid & 63, fr = lane & 15, fq = lane >> 4;
    const int t0 = chunk * 128;
    __syncthreads();
    for (int i = 0; i < 16; ++i) {
        const bf16_t* vr = Z + (size_t)(t0 + 16 * w + i) * SGIN + SGW + lane * 8; float x[48]; float sm = 0.f;
#pragma unroll
        for (int c = 0; c < 6; ++c) { const u32x4 v = *(const u32x4*)(vr + c * 512);
            x[c * 8 + 0] = bflo(v.x); x[c * 8 + 1] = bfhi(v.x); x[c * 8 + 2] = bflo(v.y); x[c * 8 + 3] = bfhi(v.y); x[c * 8 + 4] = bflo(v.z); x[c * 8 + 5] = bfhi(v.z); x[c * 8 + 6] = bflo(v.w); x[c * 8 + 7] = bfhi(v.w); }
#pragma unroll
        for (int e = 0; e < 48; ++e) sm += x[e];
#pragma unroll
        for (int o = 32; o >= 1; o >>= 1) sm += __shfl_xor(sm, o);
        const float mean = sm * (1.0f / 3072.0f); float q = 0.f;
#pragma unroll
        for (int e = 0; e < 48; ++e) { const float dd = x[e] - mean; q += dd * dd; }
#pragma unroll
        for (int o = 32; o >= 1; o >>= 1) q += __shfl_xor(q, o);
        if (lane == 0) { stats[(16 * w + i) * 2] = mean; stats[(16 * w + i) * 2 + 1] = rsqrtf(q * (1.0f / 3072.0f) + 1e-5f); }
    }
    for (int gi = 0; gi < 4; ++gi) {
        const int g = gh * 4 + gi;
        for (int cb = 0; cb < 3; ++cb) {
            __syncthreads();
            if (cb == 0) {
#pragma unroll
                for (int i = 0; i < 4; ++i) { const int c = tid + 512 * i, r = c >> 4, k8 = (c & 15) * 8; *(u32x4*)(la + r * LDP + k8) = *(const u32x4*)(wsb + ((size_t)g * 128 + r) * 128 + k8); }
            }
            const int cg0 = g * 384 + cb * 128;
#pragma unroll
            for (int i = 0; i < 4; ++i) { const int c = tid + 512 * i, q = c >> 4, c8 = (c & 15) * 8;
                const u32x4 v = *(const u32x4*)(Z + (size_t)(t0 + q) * SGIN + SGW + cg0 + c8);
                const float mean = stats[q * 2], rstd = stats[q * 2 + 1];
                const float xv[8] = {bflo(v.x), bfhi(v.x), bflo(v.y), bfhi(v.y), bflo(v.z), bfhi(v.z), bflo(v.w), bfhi(v.w)};
                const f32x4 g0 = *(const f32x4*)(lng + cg0 + c8), g1 = *(const f32x4*)(lng + cg0 + c8 + 4), b0 = *(const f32x4*)(lnb + cg0 + c8), b1 = *(const f32x4*)(lnb + cg0 + c8 + 4);
#pragma unroll
                for (int e = 0; e < 8; ++e) { const float gg = e < 4 ? g0[e & 3] : g1[e & 3], bb = e < 4 ? b0[e & 3] : b1[e & 3];
                    lb[(c8 + e) * LDP + q] = f2bf((xv[e] - mean) * rstd * gg + bb); } }
            __syncthreads();
            f32x4 acc[8];
#pragma unroll
            for (int nb = 0; nb < 8; ++nb) acc[nb] = (f32x4){0.f, 0.f, 0.f, 0.f};
            tile_mma_128(la, lb, acc, w, fr, fq);
            const int pr = 16 * w + fr; const float bias = bs[g * 128 + pr];
#pragma unroll
            for (int nb = 0; nb < 8; ++nb) { bf16_t* up = Z + (size_t)(t0 + pr) * SGIN + cg0 + 16 * nb + 4 * fq; const u32x2 uv = *(const u32x2*)up;
                u32x2 wv; wv.x = cvt_pk_bf16(bflo(uv.x) * (acc[nb][0] + bias), bfhi(uv.x) * (acc[nb][1] + bias)); wv.y = cvt_pk_bf16(bflo(uv.y) * (acc[nb][2] + bias), bfhi(uv.y) * (acc[nb][3] + bias));
                *(u32x2*)up = wv; }
        }
    }
}

__device__ void conv_swiglu(const bf16_t* Z, bf16_t* act, const float* cw, const float* cb, int rows, int row_len) {
    const int gt = bidx() * 512 + tidx(), nt = gridDim.x * 512, total = rows * 352;
    for (int i = gt; i < total; i += nt) {
        const int t = i / 352, j8 = (i % 352) * 8, np = (j8 >> 7) * 256 + (j8 & 127), pos = t % row_len;
        const bool hasL = pos != 0, hasR = pos != row_len - 1;
        const bf16_t* zr = Z + (size_t)t * UPW + np; const u32x4 zero = (u32x4){0u, 0u, 0u, 0u};
        const u32x4 a1 = *(const u32x4*)zr, g1 = *(const u32x4*)(zr + 128);
        const u32x4 a0 = hasL ? *(const u32x4*)(zr - UPW) : zero, g0 = hasL ? *(const u32x4*)(zr - UPW + 128) : zero;
        const u32x4 a2 = hasR ? *(const u32x4*)(zr + UPW) : zero, g2 = hasR ? *(const u32x4*)(zr + UPW + 128) : zero;
        float r[8];
#pragma unroll
        for (int e = 0; e < 8; ++e) { const int j = j8 + e; const unsigned sh = (e & 1) ? 0u : 16u;
            const unsigned wa0 = e < 2 ? a0.x : e < 4 ? a0.y : e < 6 ? a0.z : a0.w, wa1 = e < 2 ? a1.x : e < 4 ? a1.y : e < 6 ? a1.z : a1.w, wa2 = e < 2 ? a2.x : e < 4 ? a2.y : e < 6 ? a2.z : a2.w;
            const unsigned wg0 = e < 2 ? g0.x : e < 4 ? g0.y : e < 6 ? g0.z : g0.w, wg1 = e < 2 ? g1.x : e < 4 ? g1.y : e < 6 ? g1.z : g1.w, wg2 = e < 2 ? g2.x : e < 4 ? g2.y : e < 6 ? g2.z : g2.w;
            const float fa0 = __uint_as_float((wa0 << sh) & 0xffff0000u), fa1 = __uint_as_float((wa1 << sh) & 0xffff0000u), fa2 = __uint_as_float((wa2 << sh) & 0xffff0000u);
            const float fg0 = __uint_as_float((wg0 << sh) & 0xffff0000u), fg1 = __uint_as_float((wg1 << sh) & 0xffff0000u), fg2 = __uint_as_float((wg2 << sh) & 0xffff0000u);
            const float av = cw[j] * fa0 + cw[UPW + j] * fa1 + cw[2 * UPW + j] * fa2 + cb[j];
            const float gv = cw[DFF + j] * fg0 + cw[UPW + DFF + j] * fg1 + cw[2 * UPW + DFF + j] * fg2 + cb[DFF + j];
            r[e] = silu_f(gv) * av; }
        u32x4 w; w.x = cvt_pk_bf16(r[0], r[1]); w.y = cvt_pk_bf16(r[2], r[3]); w.z = cvt_pk_bf16(r[4], r[5]); w.w = cvt_pk_bf16(r[6], r[7]);
        *(u32x4*)(act + (size_t)t * DFF + j8) = w;
    }
}
enum { T_P0 = 0, T_INIT, T_GEMM_IN, T_SCAN1, T_SCAN2, T_SCAN3, T_MIX, T_GEMM_OUT, T_LN1, T_GEMM_UP, T_CONV, T_GEMM_DN, T_LN2 };
constexpr int NPHASES = 2 + 18 + 14 + 18 + 14;
__device__ __forceinline__ void decode_phase(int ph, int& type, int& l, int& s) {
    l = 0; s = 0;
    if (ph == 0) { type = T_P0; return; }
    if (ph == 1) { type = T_INIT; return; }
    int q = ph - 2;
    if (q < 18) l = 0; else if (q < 32) { l = 1; q -= 18; } else if (q < 50) { l = 2; q -= 32; } else { l = 3; q -= 50; }
    const int half = (l & 1) ? 3 : 5, nm = 2 * half;
    if (q < nm) { s = q / half; const int st = q % half;
        if (l & 1) type = st == 0 ? T_GEMM_IN : st == 1 ? T_MIX : T_GEMM_OUT;
        else type = st == 0 ? T_GEMM_IN : st == 1 ? T_SCAN1 : st == 2 ? T_SCAN2 : st == 3 ? T_SCAN3 : T_GEMM_OUT;
        return; }
    q -= nm;
    if (q == 0) { type = T_LN1; return; }
    q -= 1;
    if (q < 6) { s = q / 3; const int st = q % 3; type = st == 0 ? T_GEMM_UP : st == 1 ? T_CONV : T_GEMM_DN; return; }
    type = T_LN2;
}
__global__ __launch_bounds__(512, 2) void fwd_megakernel(Params p) {
    extern __shared__ __attribute__((aligned(16))) unsigned char smem[];
    cg::grid_group grid = cg::this_grid();
    unsigned char* ws = p.ws;
    const int nblk = gridDim.x, bid = bidx();
    for (int ph = 0; ph < NPHASES; ++ph) {
        int type, l, s; decode_phase(ph, type, l, s);
        const float* x = p.in[0]; const float* ctxin = p.in[2];
        float* out = p.out;
        float* mod = (float*)(ws + OFF_MOD); const float* lbs = (const float*)(ws + OFF_LBS);
        bf16_t* hmod = (bf16_t*)(ws + OFF_HMOD); float* hc = (float*)(ws + OFF_HC); bf16_t* hcmod = (bf16_t*)(ws + OFF_HCMOD);
        bf16_t* Zc = (bf16_t*)(ws + OFF_ZC); bf16_t* actc = (bf16_t*)(ws + OFF_ACTC); bf16_t* OLc = (bf16_t*)(ws + OFF_OLC);
        float* Uctx = (float*)(ws + OFF_UCTX); float* Dctx = (float*)(ws + OFF_DCTX);
        unsigned char* big = ws + OFF_BIG;
        const int kind = l & 1, idx = l >> 1;
        const bool has_ctx = l < 2, ctx_state = (l == 0 || l == 2);
        const float* modl = mod + (size_t)l * 5 * 6144;
        bf16_t* Zhg = (bf16_t*)(big + BIG_HG_Z); bf16_t* OL = (bf16_t*)(big + BIG_HG_OL); float* U = (float*)(big + BIG_HG_U); float* Dk = (float*)(big + BIG_HG_D);
        bf16_t* Zb = (bf16_t*)big; bf16_t* act = (bf16_t*)(big + BIG_FF_ACT);
        const float* lbf = lbs + (0 * 2 + idx) * 1024; const float* lbb = lbs + (1 * 2 + idx) * 1024; const float* normw = p.in[10] + idx * 128;
        if (type == T_P0) {

#ifndef NO_P0
phase0(p, smem);
#endif

        } else if (type == T_INIT) {
            ln_mod(x, nullptr, hmod, nullptr, nullptr, false, mod + 0, mod + 1024, MLAT, SEQ, 0);
            ln_mod(ctxin, nullptr, hcmod, nullptr, nullptr, false, mod + 0, mod + 1024, MCTX, 1 << 30, 4);
        } else if (type == T_GEMM_IN || type == T_GEMM_OUT || type == T_GEMM_UP || type == T_GEMM_DN) {
            GemmJob j; j.e.kind = 0; j.e.O = nullptr; j.e.ldc = 0; j.e.mode = 0; j.e.silu_tiles = 0; j.e.hin = nullptr; j.e.out = nullptr; j.e.gate = nullptr; j.e.b0 = 0; j.e.ctx = 0;
            bool do_ctx = false;
            const float* hin = (l == 0) ? x : out; const float* hcin = (l == 0) ? ctxin : hc;
            for (int job = 0; job < 2; ++job) {
                const bool c = job == 1;
                if (type == T_GEMM_IN) {
                    j.A = c ? hcmod : hmod + (size_t)s * SLAB * DM; j.lda = DM; j.K = DM; j.M = c ? MCTX : SLAB; j.e.kind = 0;
                    if (kind == 0) { j.Bt = (const bf16_t*)(ws + OFF_WT_HGIN) + (size_t)idx * HGIN * DM; j.N = HGIN; j.e.O = c ? Zc : Zhg; j.e.ldc = HGIN; j.e.mode = 1; j.e.silu_tiles = 8; do_ctx = (s == 0) && ctx_state; }
                    else { j.Bt = (const bf16_t*)(ws + OFF_WT_SGIN) + (size_t)idx * SGIN * DM; j.N = SGIN; j.e.O = c ? Zc : Zb; j.e.ldc = SGIN; j.e.mode = 2; j.e.silu_tiles = 0; do_ctx = (s == 0) && has_ctx; }
                } else if (type == T_GEMM_OUT) {
                    j.M = c ? MCTX : SLAB; j.N = DM; j.e.kind = 1; j.e.hin = c ? hcin : hin + (size_t)s * SLAB * DM; j.e.out = c ? hc : out + (size_t)s * SLAB * DM; j.e.gate = modl + 2048; j.e.b0 = s * 2; j.e.ctx = c ? 1 : 0;
                    do_ctx = (s == 0) && has_ctx;
                    if (kind == 0) { j.A = (c ? Zc : Zhg) + 1024; j.lda = HGIN; j.K = DM; j.Bt = (const bf16_t*)(ws + OFF_WT_HGOUT) + (size_t)idx * DM * DM; }
                    else { j.A = c ? Zc : Zb; j.lda = SGIN; j.K = SGW; j.Bt = (const bf16_t*)(ws + OFF_WT_SGOUT) + (size_t)idx * DM * SGW; }
                } else if (type == T_GEMM_UP) {
                    j.A = c ? hcmod : hmod + (size_t)s * SLAB * DM; j.lda = DM; j.K = DM; j.M = c ? MCTX : SLAB; j.N = UPW; j.Bt = (const bf16_t*)(ws + OFF_WT_UP) + (size_t)l * UPW * DM;
                    j.e.kind = 0; j.e.O = c ? Zc : Zb; j.e.ldc = UPW; j.e.mode = 0; j.e.silu_tiles = 0; do_ctx = (s == 0) && has_ctx;
                } else {
                    j.A = c ? actc : act; j.lda = DFF; j.K = DFF; j.M = c ? MCTX : SLAB; j.N = DM; j.Bt = (const bf16_t*)(ws + OFF_WT_DOWN) + (size_t)l * DM * DFF;
                    j.e.kind = 1; j.e.hin = c ? hc : out + (size_t)s * SLAB * DM; j.e.out = c ? hc : out + (size_t)s * SLAB * DM; j.e.gate = modl + 5120; j.e.b0 = s * 2; j.e.ctx = c ? 1 : 0; do_ctx = (s == 0) && has_ctx;
                }
                if (c && !do_ctx) break;

#ifndef NO_GEMM
gemm_call(smem, j);
#endif

            }
        } else if (type == T_SCAN1) {
            const int nu = 256 + ((s == 0 && ctx_state) ? 32 : 0);
            for (int u = bid; u < nu; u += nblk) {
                bf16_t* Zp; bf16_t* OLp; float *Uf, *Ub, *Df, *Db; int T, h;
                if (u < 256) { const int bl = u >> 7, sc = u & 15; h = (u >> 4) & 7; const size_t t0 = (size_t)bl * SEQ + sc * 512; const int sq = (bl * 8 + h) * 2; T = 512;
                    Zp = Zhg + t0 * HGIN; OLp = OL + t0 * DM; Uf = U + ((size_t)(sq + 0) * 16 + sc) * 16384; Ub = U + ((size_t)(sq + 1) * 16 + sc) * 16384; Df = Dk + ((sq + 0) * 16 + sc) * 128; Db = Dk + ((sq + 1) * 16 + sc) * 128; }
                else { const int uc = u - 256, b = uc >> 3; h = uc & 7; const int sq = (b * 8 + h) * 2; T = CTXL;
                    Zp = Zc + (size_t)b * CTXL * HGIN; OLp = OLc + (size_t)b * CTXL * DM; Uf = Uctx + (size_t)(sq + 0) * 16384; Ub = Uctx + (size_t)(sq + 1) * 16384; Df = Dctx + (sq + 0) * 128; Db = Dctx + (sq + 1) * 128; }

#ifndef NO_SCAN1
scan_unit(smem, Zp, T, h, lbf, lbb, OLp, Uf, Ub, Df, Db);
#endif

            }
        } else if (type == T_SCAN2) {

#ifndef NO_SCAN2
scan_pass2(U, Dk, Uctx, s);
#endif

        } else if (type == T_SCAN3) {

#ifndef NO_SCAN3
for (int u = bid; u < 1024; u += nblk) scan_pass3_unit(smem, Zhg, OL, U, normw, u >> 9, (u >> 6) & 7, u & 63);
#endif


#ifndef NO_CTXR
            if (s == 0 && l == 0) ctx_readout(Zc, OLc, normw);
#endif

        } else if (type == T_MIX) {
            const bf16_t* wsb = (const bf16_t*)(ws + OFF_WS_B) + (size_t)idx * 8 * 128 * 128; const float* bsv = p.in[16] + idx * 8 * 128;
            const float* slng = p.in[13] + idx * SGW; const float* slnb = p.in[14] + idx * SGW;
            const int nu = 256 + ((s == 0 && has_ctx) ? 16 : 0);
            for (int u = bid; u < nu; u += nblk) { const bool c = u >= 256; const int uu = c ? u - 256 : u;
#ifndef NO_MIX
sgu_mix_unit(smem, c ? Zc : Zb, uu >> 1, uu & 1, wsb, bsv, slng, slnb);
#endif
 }
        } else if (type == T_CONV) {
            const float* cw = p.in[19] + (size_t)l * 3 * UPW; const float* cb = p.in[20] + (size_t)l * UPW;

#ifndef NO_CONV
            conv_swiglu(Zb, act, cw, cb, SLAB, 64);
            if (s == 0 && has_ctx) conv_swiglu(Zc, actc, cw, cb, MCTX, CTXL);
#endif

        } else {
            const int which = type == T_LN1 ? 0 : 1;
            const float* modn = type == T_LN1 ? modl + 3072 : mod + (size_t)(l + 1) * 5 * 6144;
            const bool want_mod = type == T_LN1 || l < 3;
            const float* ln_g = p.in[6] + (l * 2 + which) * DM; const float* ln_b = p.in[7] + (l * 2 + which) * DM;
            ln_mod(out, out, want_mod ? hmod : nullptr, ln_g, ln_b, true, modn + 0, modn + 1024, MLAT, SEQ, 0);
            if (has_ctx) ln_mod(hc, hc, hcmod, ln_g, ln_b, true, modn + 0, modn + 1024, MCTX, 1 << 30, 4);
        }
        if (ph + 1 < NPHASES) grid.sync();
    }
}

extern "C" void kernel_launch(void* const* d_in, const int* in_sizes, int n_in, void* d_out, int out_size, void* d_ws, size_t ws_size, hipStream_t stream) {
    static int grid_blocks = 0;
    if (!grid_blocks) {
        int dev = 0, cus = 0, per_cu = 0;
        hipGetDevice(&dev);
        hipDeviceGetAttribute(&cus, hipDeviceAttributeMultiprocessorCount, dev);
        hipFuncSetAttribute((const void*)fwd_megakernel, hipFuncAttributeMaxDynamicSharedMemorySize, LDS_BYTES);
        hipOccupancyMaxActiveBlocksPerMultiprocessor(&per_cu, (const void*)fwd_megakernel, 512, LDS_BYTES);
        if (per_cu < 1) per_cu = 1;
        grid_blocks = cus * per_cu;
        (void)hipGetLastError();
    }
    if (n_in != 22 || ws_size < WS_END) { fprintf(stderr, "kernel_launch: unexpected inputs (n_in %d, ws %zu < %zu)\n", n_in, ws_size, (size_t)WS_END); return; }
    Params p{};
    for (int i = 0; i < 22; ++i) p.in[i] = (const float*)d_in[i];
    p.out = (float*)d_out; p.ws = (unsigned char*)d_ws;
    void* args[] = {&p};
    hipError_t e = hipLaunchCooperativeKernel((const void*)fwd_megakernel, dim3(grid_blocks), dim3(512), args, LDS_BYTES, stream);
    if (e != hipSuccess) fprintf(stderr, "cooperative launch failed: %s (grid %d)\n", hipGetErrorString(e), grid_blocks);
}
```

```cpp
#include <hip/hip_runtime.h>
#include <hip/hip_cooperative_groups.h>
#include <cstdio>
namespace cg = cooperative_groups;

typedef unsigned short bf16_t;
typedef short bf16x8 __attribute__((ext_vector_type(8)));
typedef float f32x4 __attribute__((ext_vector_type(4)));
typedef float f32x2 __attribute__((ext_vector_type(2)));
typedef unsigned u32x4 __attribute__((ext_vector_type(4)));
typedef unsigned u32x2 __attribute__((ext_vector_type(2)));

__device__ __forceinline__ unsigned cvt_pk_bf16(float lo, float hi) { unsigned r; asm volatile("v_cvt_pk_bf16_f32 %0, %1, %2" : "=v"(r) : "v"(lo), "v"(hi)); return r; }
__device__ __forceinline__ bf16_t f2bf(float f) { return (bf16_t)(cvt_pk_bf16(f, 0.f) & 0xffffu); }
__device__ __forceinline__ float bf2f(bf16_t b) { return __uint_as_float(((unsigned)b) << 16); }
__device__ __forceinline__ float bflo(unsigned w) { return __uint_as_float(w << 16); }
__device__ __forceinline__ float bfhi(unsigned w) { return __uint_as_float(w & 0xffff0000u); }
__device__ __forceinline__ float silu_f(float v) { return v * __builtin_amdgcn_rcpf(1.0f + __expf(-v)); }
__device__ __forceinline__ float sigmoid_f(float v) { return __builtin_amdgcn_rcpf(1.0f + __expf(-v)); }
__device__ __forceinline__ f32x2 gelu_pk(f32x2 v) {
    const f32x2 av = __builtin_elementwise_abs(v), d = av * 0.2316418882f + 1.0f;
    f32x2 t; t.x = __builtin_amdgcn_rcpf(d.x); t.y = __builtin_amdgcn_rcpf(d.y);
    f32x2 q = t * 0.5307027145f + (-0.7265760135f); q = q * t + 0.7107068705f; q = q * t + (-0.142248368f); q = q * t + 0.127414796f; q = q * t;
    const f32x2 s = (v * v) * (-0.72134752044f);
    f32x2 e; e.x = __builtin_amdgcn_exp2f(s.x); e.y = __builtin_amdgcn_exp2f(s.y);
    const f32x2 m = v * (q * e), r = v - m;
    f32x2 o; o.x = v.x < 0.f ? m.x : r.x; o.y = v.y < 0.f ? m.y : r.y; return o;
}

__device__ __forceinline__ int tidx() { int t = threadIdx.x; asm volatile("" : "+v"(t)); return t; }
__device__ __forceinline__ int bidx() { int b = blockIdx.x; asm volatile("" : "+s"(b)); return b; }


#define XB_TMO      128
#define XB_XCNT(j)  (256  + 64 * (j))
#define XB_XSUB(j)  (1280 + 64 * (j))
#define XB_XGEN(j)  (2304 + 64 * (j))
#define XB_TOP      3328
#define XB_TOPGEN   3392
#define XCD_BAR_WORDS 3456
#define XB_SPIN_CAP (1u << 20)
#define XLAS __attribute__((address_space(3)))
__device__ __forceinline__ unsigned xb_ld(unsigned* p)              { return __hip_atomic_load(p, __ATOMIC_RELAXED, __HIP_MEMORY_SCOPE_AGENT); }
__device__ __forceinline__ unsigned xb_add(unsigned* p, unsigned v) { return __hip_atomic_fetch_add(p, v, __ATOMIC_RELAXED, __HIP_MEMORY_SCOPE_AGENT); }
__device__ __forceinline__ unsigned xb_xcc_id() { return (unsigned)__builtin_amdgcn_s_getreg((3 << 11) | 20) & 0xFu; }
#define XB_SPIN(cond, bar) do { unsigned _sp = 0; while (cond) { __builtin_amdgcn_s_sleep(1); \
    if ((++_sp & 255u) == 0u) { if (xb_ld(&(bar)[XB_TMO])) break; if (_sp > XB_SPIN_CAP) { atomicAdd(&(bar)[XB_TMO], 1u); break; } } } } while (0)
struct XcdBarrier { unsigned* bar; unsigned x; volatile XLAS unsigned* st; };
__device__ __forceinline__ XcdBarrier xcd_barrier_post(unsigned* bar, volatile XLAS unsigned* st) {
    XcdBarrier b; b.bar = bar; b.x = xb_xcc_id(); b.st = st;
    if (threadIdx.x == 0) (void)xb_add(&bar[XB_XCNT(b.x)], 1u);
    return b;
}
__device__ __forceinline__ void xcd_barrier_complete(unsigned* bar, unsigned x, unsigned& nloc, unsigned& nx) {
    const unsigned G = gridDim.x * gridDim.y * gridDim.z;
    unsigned sum, cnt, mine, sp = 0u;
    for (;;) {
        sum = 0u; cnt = 0u; mine = 0u;
#pragma unroll
        for (unsigned j = 0; j < 16; ++j) { const unsigned c = xb_ld(&bar[XB_XCNT(j)]); sum += c; cnt += (c > 0u) ? 1u : 0u; mine = (j == x) ? c : mine; }
        if (sum == G) break;
        __builtin_amdgcn_s_sleep(1);
        if ((++sp & 255u) == 0u) { if (xb_ld(&bar[XB_TMO])) break; if (sp > XB_SPIN_CAP) { atomicAdd(&bar[XB_TMO], 1u); break; } }
    }
    nloc = mine > 0u ? mine : 1u; nx = cnt > 0u ? cnt : 1u;
}
__device__ __forceinline__ void xcd_barrier(const XcdBarrier& b) {
    asm volatile("s_waitcnt vmcnt(0)" ::: "memory");
    __syncthreads();
    if (threadIdx.x == 0) {
        unsigned* bar = b.bar;
        __builtin_amdgcn_s_waitcnt(0);
        unsigned nloc = b.st[0], nx = b.st[1];
        if (nloc == 0u) { xcd_barrier_complete(bar, b.x, nloc, nx); b.st[0] = nloc; b.st[1] = nx; }
        const unsigned old = xb_add(&bar[XB_XSUB(b.x)], 1u);
        const unsigned gen = old / nloc;
        if (old + 1u == (gen + 1u) * nloc) {
            __builtin_amdgcn_fence(__ATOMIC_RELEASE, "agent");
            asm volatile("s_waitcnt vmcnt(0)" ::: "memory");
            const unsigned og = xb_add(&bar[XB_TOP], 1u);
            const unsigned tg = og / nx;
            if (og + 1u == (tg + 1u) * nx) xb_add(&bar[XB_TOPGEN], 1u);
            else XB_SPIN(xb_ld(&bar[XB_TOPGEN]) == tg, bar);
            __builtin_amdgcn_fence(__ATOMIC_ACQUIRE, "agent");
            xb_add(&bar[XB_XGEN(b.x)], 1u);
            asm volatile("s_waitcnt vmcnt(0)" ::: "memory");
        } else {
            XB_SPIN(xb_ld(&bar[XB_XGEN(b.x)]) == gen, bar);
            __builtin_amdgcn_fence(__ATOMIC_ACQUIRE, "agent");
            asm volatile("s_waitcnt vmcnt(0)" ::: "memory");
        }
    }
    __syncthreads();
}

constexpr int DM = 1024, NB = 4, SEQ = 8192, CTXL = 256, MLAT = NB * SEQ, MCTX = NB * CTXL;
constexpr int HGIN = 5120, SGW = 3072, SGIN = 6144, DFF = 2816, UPW = 5632;
constexpr int SLAB = 16384;
constexpr float ALPHA_F = 1.6817928305074292f;
constexpr int LDP = 136;

constexpr size_t al256(size_t x) { return (x + 255) & ~(size_t)255; }
constexpr size_t OFF_WT_HGIN = 0;
constexpr size_t OFF_WT_HGOUT = OFF_WT_HGIN + al256((size_t)2 * HGIN * DM * 2);
constexpr size_t OFF_WT_SGIN = OFF_WT_HGOUT + al256((size_t)2 * DM * DM * 2);
constexpr size_t OFF_WT_SGOUT = OFF_WT_SGIN + al256((size_t)2 * SGIN * DM * 2);
constexpr size_t OFF_WT_UP = OFF_WT_SGOUT + al256((size_t)2 * DM * SGW * 2);
constexpr size_t OFF_WT_DOWN = OFF_WT_UP + al256((size_t)4 * UPW * DM * 2);
constexpr size_t OFF_WS_B = OFF_WT_DOWN + al256((size_t)4 * DM * DFF * 2);
constexpr size_t OFF_MOD = OFF_WS_B + al256((size_t)2 * 8 * 128 * 128 * 2);
constexpr size_t OFF_LBS = OFF_MOD + al256((size_t)4 * 5 * 6144 * 4);
constexpr size_t OFF_HMOD = OFF_LBS + al256((size_t)2 * 2 * 1024 * 4);
constexpr size_t OFF_HC = OFF_HMOD + al256((size_t)MLAT * DM * 2);
constexpr size_t OFF_HCMOD = OFF_HC + al256((size_t)MCTX * DM * 4);
constexpr size_t OFF_ZC = OFF_HCMOD + al256((size_t)MCTX * DM * 2);
constexpr size_t OFF_ACTC = OFF_ZC + al256((size_t)MCTX * SGIN * 2);
constexpr size_t OFF_OLC = OFF_ACTC + al256((size_t)MCTX * DFF * 2);
constexpr size_t OFF_UCTX = OFF_OLC + al256((size_t)MCTX * DM * 2);
constexpr size_t OFF_DCTX = OFF_UCTX + al256((size_t)NB * 8 * 2 * 16384 * 4);
constexpr size_t OFF_BAR = OFF_DCTX + al256((size_t)NB * 8 * 2 * 128 * 4);
constexpr size_t OFF_BIG = OFF_BAR + al256((size_t)XCD_BAR_WORDS * 4);
constexpr size_t BIG_HG_Z = 0;
constexpr size_t BIG_HG_OL = BIG_HG_Z + (size_t)SLAB * HGIN * 2;
constexpr size_t BIG_HG_U = BIG_HG_OL + (size_t)SLAB * DM * 2;
constexpr size_t BIG_HG_D = BIG_HG_U + (size_t)32 * 16 * 16384 * 4;
constexpr size_t BIG_HG_END = BIG_HG_D + (size_t)32 * 16 * 128 * 4;
constexpr size_t BIG_FF_ACT = (size_t)SLAB * UPW * 2;
constexpr size_t BIG_FF_END = BIG_FF_ACT + (size_t)SLAB * DFF * 2;
constexpr size_t BIG_SG_END = (size_t)SLAB * SGIN * 2;
constexpr size_t BIG_BYTES = BIG_FF_END > BIG_HG_END ? (BIG_FF_END > BIG_SG_END ? BIG_FF_END : BIG_SG_END) : (BIG_HG_END > BIG_SG_END ? BIG_HG_END : BIG_SG_END);
constexpr size_t WS_END = OFF_BIG + BIG_BYTES;
static_assert(WS_END <= (size_t)536870912, "workspace map exceeds the guaranteed 512 MiB");
constexpr int LDS_BYTES = 144 * 1024;

struct Params { const float* in[22]; float* out; unsigned char* ws; };
namespace pg8 {
#define PG8_LAS __attribute__((address_space(3)))
constexpr int BM = 256, BK = 64, HALF = 128, HTB = HALF * BK * 2, STAGE_BYTES = 8 * HTB, NXCD = 8, WGM = 8;
__host__ __device__ __forceinline__ int lds_byte(int r, int c) { const int st = (r >> 4) * 2 + (c >> 5), rr = r & 15, cc = c & 31, ob = rr * 64 + cc * 2; return st * 1024 + (ob ^ (((ob >> 9) & 1) << 5)); }
__host__ __device__ __forceinline__ void stage_rc(int b, int& R, int& C) { const int st = b / 1024, sb = b % 1024, swz = sb ^ (((sb >> 9) & 1) << 5); R = (st >> 1) * 16 + swz / 64; C = (st & 1) * 32 + (swz % 64) / 2; }
__host__ __device__ __forceinline__ int perm32(int rho) { const int n = rho >> 4, i = rho & 15; return 8 * (i >> 2) + 4 * n + (i & 3); }
struct Unit { int pm, pn; };
struct Gemm { const bf16_t* A; const bf16_t* Bt; int M, N, K, lda; };
struct StaticOrder {
    int nM, nN, nwg, G, c;
    __device__ void init(int M, int N, int G_, int c_) { nM = M / BM; nN = N / BM; nwg = nM * nN; G = G_; c = c_; }
    __device__ bool next(int i, Unit& u) const {
        const long L = (long)i * G + c; if (L >= nwg) return false;
        int wgid = (int)L; { const int q = nwg / NXCD, r = nwg % NXCD, xcd = wgid % NXCD, off = wgid / NXCD; wgid = (xcd < r ? xcd * (q + 1) : r * (q + 1) + (xcd - r) * q) + off; }
        const int nig = WGM * nN, gid = wgid / nig, fm = gid * WGM, gsz = (nM - fm) < WGM ? (nM - fm) : WGM;
        u.pm = fm + ((wgid % nig) % gsz); u.pn = (wgid % nig) / gsz; return true;
    }
};
template <class Epi>
__device__ __forceinline__ void gemm_phase(PG8_LAS unsigned char* lds, const Gemm g, const StaticOrder& S, const Epi& E) {
    const bool perm = E.perm();
    const int tid = tidx(), wid = __builtin_amdgcn_readfirstlane(tid >> 6), lane = tid & 63, wr = wid >> 2, wc = wid & 3, fr = lane & 15, fq = lane >> 4;
    const int K = g.K, nt = K / BK, lda = g.lda;
    unsigned voffA[2], voffB[2];
#pragma unroll
    for (int i = 0; i < 2; ++i) { int R, C; stage_rc(tid * 16 + i * 8192, R, C); const int Rb = perm ? ((R & ~31) + perm32(R & 31)) : R;
        voffA[i] = (unsigned)(R * lda + C) * 2u; voffB[i] = (unsigned)(Rb * K + C) * 2u; }
    const size_t kstep = (size_t)(BK * 2);
    const size_t hstepA = (size_t)HALF * lda * 2, hstepB = (size_t)HALF * K * 2;
    const size_t tstepA = 2 * hstepA, tstepB = 2 * hstepB;
    const unsigned ldsw = (unsigned)wid * 1024u;
    const int aoff = lds_byte(wr * 64 + fr, fq * 8), boff = lds_byte(wc * 32 + fr, fq * 8);
#define PG8_SA(b, h) (((b) * 2 + (h)) * HTB)
#define PG8_SB(b, h) ((4 + (b) * 2 + (h)) * HTB)
#define PG8_STAGE(bufoff, gbase, voff) do { _Pragma("unroll") for (int _i = 0; _i < 2; ++_i) \
        __builtin_amdgcn_global_load_lds((const unsigned*)((const char*)(gbase) + (voff)[_i]), (PG8_LAS unsigned*)(lds + (bufoff) + ldsw + _i * 8192), 16, 0, 0); } while (0)
#define PG8_LDA(dst, b, h) do { _Pragma("unroll") for (int m = 0; m < 4; ++m) _Pragma("unroll") for (int k = 0; k < 2; ++k) dst[m][k] = *(const PG8_LAS bf16x8*)(lds + PG8_SA(b, h) + aoff + m * 2048 + k * 1024); } while (0)
#define PG8_LDB(dst, b, h) do { _Pragma("unroll") for (int n = 0; n < 2; ++n) _Pragma("unroll") for (int k = 0; k < 2; ++k) dst[n][k] = *(const PG8_LAS bf16x8*)(lds + PG8_SB(b, h) + boff + n * 2048 + k * 1024); } while (0)
#define PG8_MMA(ai, bj, At, Bt) do { __builtin_amdgcn_s_setprio(1); _Pragma("unroll") for (int m = 0; m < 4; ++m) _Pragma("unroll") for (int n = 0; n < 2; ++n) _Pragma("unroll") for (int k = 0; k < 2; ++k) \
        acc[ai][bj][m][n] = __builtin_amdgcn_mfma_f32_16x16x32_bf16(Bt[n][k], At[m][k], acc[ai][bj][m][n], 0, 0, 0); __builtin_amdgcn_s_setprio(0); } while (0)
#define PG8_WAIT_V(n) asm volatile("s_waitcnt vmcnt(" #n ")" ::: "memory")
#define PG8_WAIT_L(n) asm volatile("s_waitcnt lgkmcnt(" #n ")" ::: "memory")
#define PG8_BAR __builtin_amdgcn_s_barrier()
#define PG8_SCHED __builtin_amdgcn_sched_barrier(0)
    Unit cur, nxt; int ui = 0;
    if (!S.next(0, cur)) return;
    f32x4 acc[2][2][4][2];
#pragma unroll
    for (int a = 0; a < 2; ++a)
#pragma unroll
        for (int b = 0; b < 2; ++b)
#pragma unroll
            for (int m = 0; m < 4; ++m)
#pragma unroll
                for (int n = 0; n < 2; ++n) acc[a][b][m][n] = (f32x4){0.f, 0.f, 0.f, 0.f};
    bf16x8 At[4][2], B0[2][2], B1[2][2];
    const char* cA = (const char*)g.A + (size_t)cur.pm * tstepA; const char* cB = (const char*)g.Bt + (size_t)cur.pn * tstepB;
    PG8_STAGE(PG8_SB(0, 0), cB, voffB); PG8_STAGE(PG8_SA(0, 0), cA, voffA); PG8_STAGE(PG8_SB(0, 1), cB + hstepB, voffB); PG8_STAGE(PG8_SA(0, 1), cA + hstepA, voffA);
    if (wr == 1) PG8_BAR;
    PG8_WAIT_V(4); PG8_BAR;
    PG8_STAGE(PG8_SB(1, 0), cB + kstep, voffB); PG8_STAGE(PG8_SA(1, 0), cA + kstep, voffA); PG8_STAGE(PG8_SB(1, 1), cB + hstepB + kstep, voffB);
    PG8_WAIT_V(6); PG8_BAR;
    for (;;) {
        const bool has_next = S.next(ui + 1, nxt);
        const char* nA = has_next ? (const char*)g.A + (size_t)nxt.pm * tstepA : cA; const char* nB = has_next ? (const char*)g.Bt + (size_t)nxt.pn * tstepB : cB;
        for (int t = 0; t < nt; t += 2) {
            const bool last = (t == nt - 2);
            const char* a1 = cA + (size_t)(t + 1) * kstep;
            const char* a2 = last ? nA : cA + (size_t)(t + 2) * kstep; const char* b2 = last ? nB : cB + (size_t)(t + 2) * kstep;
            const char* a3 = a2 + kstep; const char* b3 = b2 + kstep;
            PG8_LDB(B0, 0, 0); PG8_SCHED; PG8_LDA(At, 0, 0); PG8_STAGE(PG8_SA(1, 1), a1 + hstepA, voffA);
            PG8_WAIT_L(8); PG8_BAR; PG8_WAIT_L(0); PG8_MMA(0, 0, At, B0); PG8_BAR; PG8_SCHED;
            PG8_LDB(B1, 0, 1); PG8_STAGE(PG8_SB(0, 0), b2, voffB);
            PG8_BAR; PG8_WAIT_L(0); PG8_MMA(0, 1, At, B1); PG8_BAR;
            PG8_LDA(At, 0, 1); PG8_STAGE(PG8_SA(0, 0), a2, voffA);
            PG8_BAR; PG8_WAIT_L(0); PG8_MMA(1, 0, At, B0); PG8_BAR; PG8_SCHED;
            PG8_STAGE(PG8_SB(0, 1), b2 + hstepB, voffB);
            PG8_WAIT_V(6); PG8_BAR; PG8_MMA(1, 1, At, B1); PG8_BAR;
            PG8_LDB(B0, 1, 0); PG8_SCHED; PG8_LDA(At, 1, 0); PG8_STAGE(PG8_SA(0, 1), a2 + hstepA, voffA);
            PG8_WAIT_L(8); PG8_BAR; PG8_WAIT_L(0); PG8_MMA(0, 0, At, B0); PG8_BAR; PG8_SCHED;
            PG8_LDB(B1, 1, 1); PG8_STAGE(PG8_SB(1, 0), b3, voffB);
            PG8_BAR; PG8_WAIT_L(0); PG8_MMA(0, 1, At, B1); PG8_BAR;
            PG8_LDA(At, 1, 1); PG8_STAGE(PG8_SA(1, 0), a3, voffA);
            PG8_BAR; PG8_WAIT_L(0); PG8_MMA(1, 0, At, B0); PG8_BAR; PG8_SCHED;
            PG8_STAGE(PG8_SB(1, 1), b3 + hstepB, voffB);
            PG8_WAIT_V(6); PG8_BAR; PG8_MMA(1, 1, At, B1); PG8_BAR;
        }
        E(acc, cur, wr, wc, fr, fq);
        if (!has_next) break;
#pragma unroll
        for (int a = 0; a < 2; ++a)
#pragma unroll
            for (int b = 0; b < 2; ++b)
#pragma unroll
                for (int m = 0; m < 4; ++m)
#pragma unroll
                    for (int n = 0; n < 2; ++n) acc[a][b][m][n] = (f32x4){0.f, 0.f, 0.f, 0.f};
        cur = nxt; cA = nA; cB = nB; ++ui;
    }
    PG8_WAIT_V(0);
    if (wr == 0) PG8_BAR;
    PG8_BAR;
#undef PG8_SA
#undef PG8_SB
#undef PG8_STAGE
#undef PG8_LDA
#undef PG8_LDB
#undef PG8_MMA
#undef PG8_WAIT_V
#undef PG8_WAIT_L
#undef PG8_BAR
#undef PG8_SCHED
}
}
struct EpiAny {
    int kind;
    bf16_t* O; int ldc; int mode; int silu_tiles;
    const float* hin; float* out; const float* gate; int b0; int ctx;
    __device__ __forceinline__ bool perm() const { return kind == 0; }
    __device__ __forceinline__ void operator()(const f32x4 (&acc)[2][2][4][2], const pg8::Unit& u, int wr, int wc, int fr, int fq) const {
        if (kind == 0) {
            const int row0 = u.pm * 256 + wr * 64 + fr, col0 = u.pn * 256 + wc * 32 + 8 * fq;
            const bool do_silu = (mode == 1) && (u.pn < silu_tiles);
#pragma unroll
            for (int ai = 0; ai < 2; ++ai)
#pragma unroll
                for (int m = 0; m < 4; ++m) { bf16_t* rowp = O + (size_t)(row0 + ai * 128 + m * 16) * ldc + col0;
#pragma unroll
                    for (int bj = 0; bj < 2; ++bj) { f32x4 v0 = acc[ai][bj][m][0], v1 = acc[ai][bj][m][1];
                        if (mode == 2) { f32x2 a = gelu_pk((f32x2){v0[0], v0[1]}), b = gelu_pk((f32x2){v0[2], v0[3]}), c = gelu_pk((f32x2){v1[0], v1[1]}), d = gelu_pk((f32x2){v1[2], v1[3]});
                            v0 = (f32x4){a.x, a.y, b.x, b.y}; v1 = (f32x4){c.x, c.y, d.x, d.y}; }
                        else if (do_silu) {
#pragma unroll
                            for (int j = 0; j < 4; ++j) { v0[j] = silu_f(v0[j]); v1[j] = silu_f(v1[j]); } }
                        u32x4 w; w.x = cvt_pk_bf16(v0[0], v0[1]); w.y = cvt_pk_bf16(v0[2], v0[3]); w.z = cvt_pk_bf16(v1[0], v1[1]); w.w = cvt_pk_bf16(v1[2], v1[3]);
                        *(u32x4*)(rowp + bj * 128) = w; } }
        } else {
            const int row0 = u.pm * 256 + wr * 64 + fr, col0 = u.pn * 256 + wc * 32 + 4 * fq;
            const int b = ctx ? 4 : b0 + (u.pm * 256) / SEQ;
            const float* gp = gate + (size_t)b * 6144 + col0;
            f32x4 gv[2][2];
#pragma unroll
            for (int bj = 0; bj < 2; ++bj)
#pragma unroll
                for (int n = 0; n < 2; ++n) gv[bj][n] = *(const f32x4*)(gp + bj * 128 + n * 16);
#pragma unroll
            for (int ai = 0; ai < 2; ++ai)
#pragma unroll
                for (int m = 0; m < 4; ++m) { const size_t off = (size_t)(row0 + ai * 128 + m * 16) * DM + col0;
#pragma unroll
                    for (int bj = 0; bj < 2; ++bj)
#pragma unroll
                        for (int n = 0; n < 2; ++n) { const f32x4 h4 = *(const f32x4*)(hin + off + bj * 128 + n * 16);
                            *(f32x4*)(out + off + bj * 128 + n * 16) = h4 * ALPHA_F + gv[bj][n] * acc[ai][bj][m][n]; } }
        }
    }
};
struct GemmJob { const bf16_t* A; const bf16_t* Bt; int lda, M, N, K; EpiAny e; };
constexpr int EPI_LDS_OFF = 131072;
struct EpiLds {
    int kind0;
    __device__ __forceinline__ bool perm() const { return kind0 == 0; }
    __device__ __forceinline__ void operator()(const f32x4 (&acc)[2][2][4][2], const pg8::Unit& u, int wr, int wc, int fr, int fq) const {
        extern __shared__ __attribute__((aligned(16))) unsigned char smem_e[];
        const EpiAny e = *(const EpiAny*)(smem_e + EPI_LDS_OFF);
        e(acc, u, wr, wc, fr, fq);
    }
};
__device__ __forceinline__ void gemm_call(unsigned char* smem, const GemmJob& j) {
    __syncthreads();
    if (tidx() == 0) *(EpiAny*)(smem + EPI_LDS_OFF) = j.e;
    __syncthreads();
    pg8::Gemm g; g.A = j.A; g.Bt = j.Bt; g.M = j.M; g.N = j.N; g.K = j.K; g.lda = j.lda;
    pg8::StaticOrder S; S.init(j.M, j.N, (int)gridDim.x, bidx());
    EpiLds el; el.kind0 = j.e.kind;
    pg8::gemm_phase<EpiLds>((PG8_LAS unsigned char*)smem, g, S, el);
}

__device__ void transpose_cvt(const float* src, bf16_t* dst, int nmat, int K, int N, int ffn_perm, float* tile  ) {
    const int tid = tidx(), tk = K / 64, tn = N / 64, per = tk * tn, total = nmat * per;
    for (int u = bidx(); u < total; u += gridDim.x) {
        const int mi = u / per, r = u % per, kt = r / tn, ntl = r % tn;
        const float* s = src + (size_t)mi * K * N + (size_t)(kt * 64) * N + ntl * 64;
#pragma unroll
        for (int i = 0; i < 2; ++i) { const int row = (tid >> 4) + 32 * i, c4 = (tid & 15) * 4; const f32x4 v = *(const f32x4*)(s + (size_t)row * N + c4);
            tile[row * 65 + c4 + 0] = v[0]; tile[row * 65 + c4 + 1] = v[1]; tile[row * 65 + c4 + 2] = v[2]; tile[row * 65 + c4 + 3] = v[3]; }
        __syncthreads();
        { const int n = tid >> 3, k8 = (tid & 7) * 8; int ng = ntl * 64 + n;
          if (ffn_perm) ng = ng < DFF ? ((ng >> 7) * 256 + (ng & 127)) : ((((ng - DFF) >> 7) * 256) + 128 + ((ng - DFF) & 127));
          u32x4 w; w.x = cvt_pk_bf16(tile[(k8 + 0) * 65 + n], tile[(k8 + 1) * 65 + n]); w.y = cvt_pk_bf16(tile[(k8 + 2) * 65 + n], tile[(k8 + 3) * 65 + n]);
          w.z = cvt_pk_bf16(tile[(k8 + 4) * 65 + n], tile[(k8 + 5) * 65 + n]); w.w = cvt_pk_bf16(tile[(k8 + 6) * 65 + n], tile[(k8 + 7) * 65 + n]);
          *(u32x4*)(dst + (size_t)mi * K * N + (size_t)ng * K + kt * 64 + k8) = w; }
        __syncthreads();
    }
}
__device__ void phase0(const Params& p, unsigned char* smem) {
    const int tid = tidx();
    unsigned char* ws = p.ws;
    float* mod = (float*)(ws + OFF_MOD);
    {
        float* sc = (float*)smem; float* red = sc + 5 * 1024;
        const float* c = p.in[1]; const float* cctx = p.in[3]; const float* ada_w = p.in[4]; const float* ada_b = p.in[5];
        for (int i = tid; i < 5 * 1024; i += 512) { const float v = i < 4096 ? c[i] : cctx[i - 4096]; sc[i] = silu_f(v); }
        __syncthreads();
        for (int u = bidx(); u < 256; u += gridDim.x) {
            const int l = u >> 6, col0 = (u & 63) * 96, cq = tid % 24, kp = tid / 24;
            float acc[5][4];
#pragma unroll
            for (int r = 0; r < 5; ++r)
#pragma unroll
                for (int e = 0; e < 4; ++e) acc[r][e] = 0.f;
            if (kp < 21) {
                for (int k = kp; k < 1024; k += 21) { const f32x4 w = *(const f32x4*)(ada_w + ((size_t)l * 1024 + k) * 6144 + col0 + cq * 4);
#pragma unroll
                    for (int r = 0; r < 5; ++r) { const float s = sc[r * 1024 + k];
#pragma unroll
                        for (int e = 0; e < 4; ++e) acc[r][e] += s * w[e]; } }
#pragma unroll
                for (int r = 0; r < 5; ++r)
#pragma unroll
                    for (int e = 0; e < 4; ++e) red[(kp * 5 + r) * 96 + cq * 4 + e] = acc[r][e];
            }
            __syncthreads();
            if (tid < 480) { const int r = tid / 96, cc = tid % 96; float s = ada_b[l * 6144 + col0 + cc];
                for (int k2 = 0; k2 < 21; ++k2) s += red[(k2 * 5 + r) * 96 + cc];
                mod[((size_t)l * 5 + r) * 6144 + col0 + cc] = s; }
            __syncthreads();
        }
    }
    if (bidx() == 0) {
        const float* hg_lb = p.in[9]; float* lbs = (float*)(ws + OFF_LBS);
        for (int i = tid; i < 2048; i += 512) { const int dir = i >> 10, k = i & 1023; const float a0 = hg_lb[(dir * 2 + 0) * 1024 + k], a1 = hg_lb[(dir * 2 + 1) * 1024 + k];
            lbs[(dir * 2 + 0) * 1024 + k] = 0.f; lbs[(dir * 2 + 1) * 1024 + k] = 1.0f / (1.0f + expf(a0 - a1)); }
    }
    {
        const float* s = p.in[15]; bf16_t* d = (bf16_t*)(ws + OFF_WS_B);
        for (int i = bidx() * 512 + tid; i < 2 * 8 * 128 * 128 / 4; i += gridDim.x * 512) { const f32x4 v = *(const f32x4*)(s + (size_t)i * 4); u32x2 w; w.x = cvt_pk_bf16(v[0], v[1]); w.y = cvt_pk_bf16(v[2], v[3]); *(u32x2*)(d + (size_t)i * 4) = w; }
    }
    __syncthreads();
    float* tile = (float*)smem;
    transpose_cvt(p.in[8], (bf16_t*)(ws + OFF_WT_HGIN), 2, DM, HGIN, 0, tile);
    transpose_cvt(p.in[11], (bf16_t*)(ws + OFF_WT_HGOUT), 2, DM, DM, 0, tile);
    transpose_cvt(p.in[12], (bf16_t*)(ws + OFF_WT_SGIN), 2, DM, SGIN, 0, tile);
    transpose_cvt(p.in[17], (bf16_t*)(ws + OFF_WT_SGOUT), 2, SGW, DM, 0, tile);
    transpose_cvt(p.in[18], (bf16_t*)(ws + OFF_WT_UP), 4, DM, UPW, 1, tile);
    transpose_cvt(p.in[21], (bf16_t*)(ws + OFF_WT_DOWN), 4, DFF, DM, 0, tile);
}

__device__ void ln_mod(const float* src, float* hdst, bf16_t* mdst, const float* lng, const float* lnb, bool do_ln,
                       const float* shift, const float* scale, int nrows, int rows_per_b, int b0) {
    const int lane = tidx() & 63, gw = bidx() * 8 + (tidx() >> 6), nw = gridDim.x * 8;
    for (int row = gw; row < nrows; row += nw) {
        const float* s = src + (size_t)row * DM; f32x4 x[4];
#pragma unroll
        for (int i = 0; i < 4; ++i) x[i] = *(const f32x4*)(s + i * 256 + lane * 4);
        if (do_ln) {
            float sm = 0.f;
#pragma unroll
            for (int i = 0; i < 4; ++i) sm += (x[i][0] + x[i][1]) + (x[i][2] + x[i][3]);
#pragma unroll
            for (int o = 32; o >= 1; o >>= 1) sm += __shfl_xor(sm, o);
            const float mean = sm * (1.0f / 1024.0f); float q = 0.f;
#pragma unroll
            for (int i = 0; i < 4; ++i) { const f32x4 d = x[i] - mean; q += (d[0] * d[0] + d[1] * d[1]) + (d[2] * d[2] + d[3] * d[3]); }
#pragma unroll
            for (int o = 32; o >= 1; o >>= 1) q += __shfl_xor(q, o);
            const float rstd = rsqrtf(q * (1.0f / 1024.0f) + 1e-5f);
#pragma unroll
            for (int i = 0; i < 4; ++i) { const f32x4 g4 = *(const f32x4*)(lng + i * 256 + lane * 4), b4 = *(const f32x4*)(lnb + i * 256 + lane * 4);
                x[i] = (x[i] - mean) * rstd * g4 + b4; *(f32x4*)(hdst + (size_t)row * DM + i * 256 + lane * 4) = x[i]; }
        }
        if (mdst) {
            const int b = b0 + row / rows_per_b; const float* sh = shift + (size_t)b * 6144; const float* scl = scale + (size_t)b * 6144;
#pragma unroll
            for (int i = 0; i < 4; ++i) { const f32x4 s4 = *(const f32x4*)(sh + i * 256 + lane * 4), c4 = *(const f32x4*)(scl + i * 256 + lane * 4);
                const f32x4 y = x[i] * (c4 + 1.0f) + s4; u32x2 w; w.x = cvt_pk_bf16(y[0], y[1]); w.y = cvt_pk_bf16(y[2], y[3]);
                *(u32x2*)(mdst + (size_t)row * DM + i * 256 + lane * 4) = w; }
        }
    }
}

__device__ __forceinline__ void tile_mma_128(const bf16_t* la, const bf16_t* lb, f32x4 (&acc)[8], int w, int fr, int fq) {
#pragma unroll
    for (int kk = 0; kk < 4; ++kk) {
        const bf16x8 a = *(const bf16x8*)(la + (16 * w + fr) * LDP + kk * 32 + fq * 8);
#pragma unroll
        for (int nb = 0; nb < 8; ++nb) { const bf16x8 b = *(const bf16x8*)(lb + (16 * nb + fr) * LDP + kk * 32 + fq * 8);
            acc[nb] = __builtin_amdgcn_mfma_f32_16x16x32_bf16(b, a, acc[nb], 0, 0, 0); }
    }
}

__device__ void scan_unit(unsigned char* smem, bf16_t* Z, int T, int h, const float* lbf, const float* lbb, bf16_t* OL, float* Uf, float* Ub, float* Df, float* Db) {
    float* Qs = (float*)smem; float* Fs = Qs + 2048; float* Ks = Fs + 2048; float* Vs = Ks + 2048; float* OP = Vs + 2048;
    const int tid = tidx(), d = tid & 127, kq = tid >> 7, ttl = tid >> 5, k4 = (tid & 31) * 4;
    for (int dir = 0; dir < 2; ++dir) {
        const int zcol = (dir ? 4096 : 3072) + h * 128;
        const float* lb = (dir ? lbb : lbf) + h * 128;
        const f32x4 lbv = *(const f32x4*)(lb + k4);
        float S[32];
#pragma unroll
        for (int i = 0; i < 32; ++i) S[i] = 0.f;
        float P = 1.f;
#pragma unroll 1
        for (int st = 0; st < T / 16; ++st) {
            __syncthreads();
            {   const int pos = st * 16 + ttl, tok = dir ? (T - 1 - pos) : pos;
                const bf16_t* zr = Z + (size_t)tok * HGIN;
                const u32x2 q2 = *(const u32x2*)(zr + h * 128 + k4), f2 = *(const u32x2*)(zr + zcol + k4), v2 = *(const u32x2*)(zr + 2048 + h * 128 + k4);
                const float zf[4] = {bflo(f2.x), bfhi(f2.x), bflo(f2.y), bfhi(f2.y)};
                f32x4 fv, kv;
#pragma unroll
                for (int e = 0; e < 4; ++e) { const float f = lbv[e] + (1.0f - lbv[e]) * sigmoid_f(zf[e]); fv[e] = f; kv[e] = 1.0f - f; }
                *(f32x4*)(Fs + ttl * 128 + k4) = fv; *(f32x4*)(Ks + ttl * 128 + k4) = kv;
                *(f32x4*)(Qs + ttl * 128 + k4) = (f32x4){bflo(q2.x), bfhi(q2.x), bflo(q2.y), bfhi(q2.y)};
                *(f32x4*)(Vs + ttl * 128 + k4) = (f32x4){bflo(v2.x), bfhi(v2.x), bflo(v2.y), bfhi(v2.y)};
            }
            __syncthreads();
            if (tid < 128) {
#pragma unroll 1
                for (int tt = 0; tt < 16; ++tt) { P *= Fs[tt * 128 + tid]; const float qg = Qs[tt * 128 + tid] * P;
                    const int pos = st * 16 + tt, tok = dir ? (T - 1 - pos) : pos; Z[(size_t)tok * HGIN + zcol + tid] = f2bf(qg); }
            }
#pragma unroll 1
            for (int tt = 0; tt < 16; ++tt) {
                const float v = Vs[tt * 128 + d]; float o = 0.f;
                const f32x4* F4 = (const f32x4*)(Fs + tt * 128 + kq * 32); const f32x4* K4 = (const f32x4*)(Ks + tt * 128 + kq * 32); const f32x4* Q4 = (const f32x4*)(Qs + tt * 128 + kq * 32);
#pragma unroll
                for (int i4 = 0; i4 < 8; ++i4) { const f32x4 f = F4[i4], k = K4[i4], q = Q4[i4];
#pragma unroll
                    for (int e = 0; e < 4; ++e) { S[i4 * 4 + e] = f[e] * S[i4 * 4 + e] + k[e] * v; o += q[e] * S[i4 * 4 + e]; } }
                OP[(kq * 16 + tt) * 128 + d] = o;
            }
            __syncthreads();
            {   const f32x4 s = *(const f32x4*)(OP + (0 * 16 + ttl) * 128 + k4) + *(const f32x4*)(OP + (1 * 16 + ttl) * 128 + k4) + *(const f32x4*)(OP + (2 * 16 + ttl) * 128 + k4) + *(const f32x4*)(OP + (3 * 16 + ttl) * 128 + k4);
                const int pos = st * 16 + ttl, tok = dir ? (T - 1 - pos) : pos;
                bf16_t* op = OL + (size_t)tok * DM + h * 128 + k4; f32x4 r = s;
                if (dir) { const u32x2 pv = *(const u32x2*)op; r[0] += bflo(pv.x); r[1] += bfhi(pv.x); r[2] += bflo(pv.y); r[3] += bfhi(pv.y); }
                u32x2 w; w.x = cvt_pk_bf16(r[0], r[1]); w.y = cvt_pk_bf16(r[2], r[3]); *(u32x2*)op = w;
            }
        }
        float* U = dir ? Ub : Uf;
#pragma unroll
        for (int i = 0; i < 32; ++i) U[(kq * 32 + i) * 128 + d] = S[i];
        if (tid < 128) (dir ? Db : Df)[tid] = P;
    }
    __syncthreads();
}
__device__ void scan_pass2(float* U, const float* Dk, const float* Uctx, int s) {
    const int gt = bidx() * 512 + tidx(), nt = gridDim.x * 512;
    for (int e4 = gt; e4 < 32 * 4096; e4 += nt) {
        const int seq = e4 >> 12, el = (e4 & 4095) * 4, k = el >> 7, bl = seq >> 4, hd = seq & 15, dir = seq & 1;
        f32x4 cur = *(const f32x4*)(Uctx + (size_t)((s * 2 + bl) * 16 + hd) * 16384 + el);
        for (int jj = 0; jj < 16; ++jj) { const int j = dir ? 15 - jj : jj; float* up = U + ((size_t)seq * 16 + j) * 16384 + el;
            const f32x4 tmp = *(const f32x4*)up; *(f32x4*)up = cur; const float dk = Dk[(seq * 16 + j) * 128 + k]; cur = cur * dk + tmp; }
    }
}
__device__ void scan_pass3_unit(unsigned char* smem, bf16_t* Z, const bf16_t* OL, const float* U, const float* normw, int bl, int h, int tile) {
    bf16_t* la = (bf16_t*)smem; bf16_t* lb = la + 128 * LDP;
    const int tid = tidx(), w = tid >> 6, lane = tid & 63, fr = lane & 15, fq = lane >> 4;
    const int tok0 = bl * SEQ + tile * 128, j = tile >> 2;
    f32x4 acc[8];
#pragma unroll
    for (int nb = 0; nb < 8; ++nb) acc[nb] = (f32x4){0.f, 0.f, 0.f, 0.f};
    for (int dir = 0; dir < 2; ++dir) {
        __syncthreads();
        const int zcol = (dir ? 4096 : 3072) + h * 128;
#pragma unroll
        for (int i = 0; i < 4; ++i) { const int c = tid + 512 * i, r = c >> 4, k8 = (c & 15) * 8;
            *(u32x4*)(la + r * LDP + k8) = *(const u32x4*)(Z + (size_t)(tok0 + r) * HGIN + zcol + k8); }
        const float* Sp = U + ((size_t)((bl * 8 + h) * 2 + dir) * 16 + j) * 16384;
#pragma unroll
        for (int i = 0; i < 8; ++i) { const int c = tid + 512 * i, k = c >> 5, d4 = (c & 31) * 4; const f32x4 v = *(const f32x4*)(Sp + k * 128 + d4);
            lb[(d4 + 0) * LDP + k] = f2bf(v[0]); lb[(d4 + 1) * LDP + k] = f2bf(v[1]); lb[(d4 + 2) * LDP + k] = f2bf(v[2]); lb[(d4 + 3) * LDP + k] = f2bf(v[3]); }
        __syncthreads();
        tile_mma_128(la, lb, acc, w, fr, fq);
    }
    const int tok = tok0 + 16 * w + fr;
    float ss = 0.f;
#pragma unroll
    for (int nb = 0; nb < 8; ++nb) { const u32x2 pv = *(const u32x2*)(OL + (size_t)tok * DM + h * 128 + 16 * nb + 4 * fq);
        acc[nb][0] += bflo(pv.x); acc[nb][1] += bfhi(pv.x); acc[nb][2] += bflo(pv.y); acc[nb][3] += bfhi(pv.y);
        ss += (acc[nb][0] * acc[nb][0] + acc[nb][1] * acc[nb][1]) + (acc[nb][2] * acc[nb][2] + acc[nb][3] * acc[nb][3]); }
    ss += __shfl_xor(ss, 16); ss += __shfl_xor(ss, 32);
    const float rn = rsqrtf(ss * (1.0f / 128.0f) + 1e-6f);
#pragma unroll
    for (int nb = 0; nb < 8; ++nb) { bf16_t* gp = Z + (size_t)tok * HGIN + 1024 + h * 128 + 16 * nb + 4 * fq; const u32x2 gv = *(const u32x2*)gp;
        const f32x4 nw = *(const f32x4*)(normw + 16 * nb + 4 * fq);
        u32x2 wv; wv.x = cvt_pk_bf16(acc[nb][0] * rn * nw[0] * bflo(gv.x), acc[nb][1] * rn * nw[1] * bfhi(gv.x));
        wv.y = cvt_pk_bf16(acc[nb][2] * rn * nw[2] * bflo(gv.y), acc[nb][3] * rn * nw[3] * bfhi(gv.y)); *(u32x2*)gp = wv; }
}
__device__ void ctx_readout(bf16_t* Zc, const bf16_t* OLc, const float* normw) {
    const int lane = tidx() & 63, gw = bidx() * 8 + (tidx() >> 6), nw = gridDim.x * 8;
    for (int row = gw; row < MCTX; row += nw) {
        const bf16_t* op = OLc + (size_t)row * DM + lane * 16; bf16_t* gp = Zc + (size_t)row * HGIN + 1024 + lane * 16;
        const u32x4 o0 = *(const u32x4*)op, o1 = *(const u32x4*)(op + 8);
        float o[16] = {bflo(o0.x), bfhi(o0.x), bflo(o0.y), bfhi(o0.y), bflo(o0.z), bfhi(o0.z), bflo(o0.w), bfhi(o0.w), bflo(o1.x), bfhi(o1.x), bflo(o1.y), bfhi(o1.y), bflo(o1.z), bfhi(o1.z), bflo(o1.w), bfhi(o1.w)};
        float ss = 0.f;
#pragma unroll
        for (int e = 0; e < 16; ++e) ss += o[e] * o[e];
        ss += __shfl_xor(ss, 1); ss += __shfl_xor(ss, 2); ss += __shfl_xor(ss, 4);
        const float rn = rsqrtf(ss * (1.0f / 128.0f) + 1e-6f);
        const u32x4 g0 = *(const u32x4*)gp, g1 = *(const u32x4*)(gp + 8);
        const float g[16] = {bflo(g0.x), bfhi(g0.x), bflo(g0.y), bfhi(g0.y), bflo(g0.z), bfhi(g0.z), bflo(g0.w), bfhi(g0.w), bflo(g1.x), bfhi(g1.x), bflo(g1.y), bfhi(g1.y), bflo(g1.z), bfhi(g1.z), bflo(g1.w), bfhi(g1.w)};
        const float* nwp = normw + (lane & 7) * 16;
#pragma unroll
        for (int e = 0; e < 16; ++e) o[e] = o[e] * rn * nwp[e] * g[e];
        u32x4 w0, w1; w0.x = cvt_pk_bf16(o[0], o[1]); w0.y = cvt_pk_bf16(o[2], o[3]); w0.z = cvt_pk_bf16(o[4], o[5]); w0.w = cvt_pk_bf16(o[6], o[7]);
        w1.x = cvt_pk_bf16(o[8], o[9]); w1.y = cvt_pk_bf16(o[10], o[11]); w1.z = cvt_pk_bf16(o[12], o[13]); w1.w = cvt_pk_bf16(o[14], o[15]);
        *(u32x4*)gp = w0; *(u32x4*)(gp + 8) = w1;
    }
}

__device__ void sgu_mix_unit(unsigned char* smem, bf16_t* Z, int chunk, int gh, const bf16_t* wsb  , const float* bs  , const float* lng, const float* lnb) {
    float* stats = (float*)smem;
    bf16_t* la = (bf16_t*)(smem + 1024); bf16_t* lb = la + 128 * LDP;
    const int tid = tidx(), w = tid >> 6, lane = tid & 63, fr = lane & 15, fq = lane >> 4;
    const int t0 = chunk * 128;
    __syncthreads();
    for (int i = 0; i < 16; ++i) {
        const bf16_t* vr = Z + (size_t)(t0 + 16 * w + i) * SGIN + SGW + lane * 8; float x[48]; float sm = 0.f;
#pragma unroll
        for (int c = 0; c < 6; ++c) { const u32x4 v = *(const u32x4*)(vr + c * 512);
            x[c * 8 + 0] = bflo(v.x); x[c * 8 + 1] = bfhi(v.x); x[c * 8 + 2] = bflo(v.y); x[c * 8 + 3] = bfhi(v.y); x[c * 8 + 4] = bflo(v.z); x[c * 8 + 5] = bfhi(v.z); x[c * 8 + 6] = bflo(v.w); x[c * 8 + 7] = bfhi(v.w); }
#pragma unroll
        for (int e = 0; e < 48; ++e) sm += x[e];
#pragma unroll
        for (int o = 32; o >= 1; o >>= 1) sm += __shfl_xor(sm, o);
        const float mean = sm * (1.0f / 3072.0f); float q = 0.f;
#pragma unroll
        for (int e = 0; e < 48; ++e) { const float dd = x[e] - mean; q += dd * dd; }
#pragma unroll
        for (int o = 32; o >= 1; o >>= 1) q += __shfl_xor(q, o);
        if (lane == 0) { stats[(16 * w + i) * 2] = mean; stats[(16 * w + i) * 2 + 1] = rsqrtf(q * (1.0f / 3072.0f) + 1e-5f); }
    }
    for (int gi = 0; gi < 4; ++gi) {
        const int g = gh * 4 + gi;
        for (int cb = 0; cb < 3; ++cb) {
            __syncthreads();
            if (cb == 0) {
#pragma unroll
                for (int i = 0; i < 4; ++i) { const int c = tid + 512 * i, r = c >> 4, k8 = (c & 15) * 8; *(u32x4*)(la + r * LDP + k8) = *(const u32x4*)(wsb + ((size_t)g * 128 + r) * 128 + k8); }
            }
            const int cg0 = g * 384 + cb * 128;
#pragma unroll
            for (int i = 0; i < 4; ++i) { const int c = tid + 512 * i, q = c >> 4, c8 = (c & 15) * 8;
                const u32x4 v = *(const u32x4*)(Z + (size_t)(t0 + q) * SGIN + SGW + cg0 + c8);
                const float mean = stats[q * 2], rstd = stats[q * 2 + 1];
                const float xv[8] = {bflo(v.x), bfhi(v.x), bflo(v.y), bfhi(v.y), bflo(v.z), bfhi(v.z), bflo(v.w), bfhi(v.w)};
                const f32x4 g0 = *(const f32x4*)(lng + cg0 + c8), g1 = *(const f32x4*)(lng + cg0 + c8 + 4), b0 = *(const f32x4*)(lnb + cg0 + c8), b1 = *(const f32x4*)(lnb + cg0 + c8 + 4);
#pragma unroll
                for (int e = 0; e < 8; ++e) { const float gg = e < 4 ? g0[e & 3] : g1[e & 3], bb = e < 4 ? b0[e & 3] : b1[e & 3];
                    lb[(c8 + e) * LDP + q] = f2bf((xv[e] - mean) * rstd * gg + bb); } }
            __syncthreads();
            f32x4 acc[8];
#pragma unroll
            for (int nb = 0; nb < 8; ++nb) acc[nb] = (f32x4){0.f, 0.f, 0.f, 0.f};
            tile_mma_128(la, lb, acc, w, fr, fq);
            const int pr = 16 * w + fr; const float bias = bs[g * 128 + pr];
#pragma unroll
            for (int nb = 0; nb < 8; ++nb) { bf16_t* up = Z + (size_t)(t0 + pr) * SGIN + cg0 + 16 * nb + 4 * fq; const u32x2 uv = *(const u32x2*)up;
                u32x2 wv; wv.x = cvt_pk_bf16(bflo(uv.x) * (acc[nb][0] + bias), bfhi(uv.x) * (acc[nb][1] + bias)); wv.y = cvt_pk_bf16(bflo(uv.y) * (acc[nb][2] + bias), bfhi(uv.y) * (acc[nb][3] + bias));
                *(u32x2*)up = wv; }
        }
    }
}

__device__ void conv_swiglu(const bf16_t* Z, bf16_t* act, const float* cw, const float* cb, int rows, int row_len) {
    const int gt = bidx() * 512 + tidx(), nt = gridDim.x * 512, total = rows * 352;
    for (int i = gt; i < total; i += nt) {
        const int t = i / 352, j8 = (i % 352) * 8, np = (j8 >> 7) * 256 + (j8 & 127), pos = t % row_len;
        const bool hasL = pos != 0, hasR = pos != row_len - 1;
        const bf16_t* zr = Z + (size_t)t * UPW + np; const u32x4 zero = (u32x4){0u, 0u, 0u, 0u};
        const u32x4 a1 = *(const u32x4*)zr, g1 = *(const u32x4*)(zr + 128);
        const u32x4 a0 = hasL ? *(const u32x4*)(zr - UPW) : zero, g0 = hasL ? *(const u32x4*)(zr - UPW + 128) : zero;
        const u32x4 a2 = hasR ? *(const u32x4*)(zr + UPW) : zero, g2 = hasR ? *(const u32x4*)(zr + UPW + 128) : zero;
        float r[8];
#pragma unroll
        for (int e = 0; e < 8; ++e) { const int j = j8 + e; const unsigned sh = (e & 1) ? 0u : 16u;
            const unsigned wa0 = e < 2 ? a0.x : e < 4 ? a0.y : e < 6 ? a0.z : a0.w, wa1 = e < 2 ? a1.x : e < 4 ? a1.y : e < 6 ? a1.z : a1.w, wa2 = e < 2 ? a2.x : e < 4 ? a2.y : e < 6 ? a2.z : a2.w;
            const unsigned wg0 = e < 2 ? g0.x : e < 4 ? g0.y : e < 6 ? g0.z : g0.w, wg1 = e < 2 ? g1.x : e < 4 ? g1.y : e < 6 ? g1.z : g1.w, wg2 = e < 2 ? g2.x : e < 4 ? g2.y : e < 6 ? g2.z : g2.w;
            const float fa0 = __uint_as_float((wa0 << sh) & 0xffff0000u), fa1 = __uint_as_float((wa1 << sh) & 0xffff0000u), fa2 = __uint_as_float((wa2 << sh) & 0xffff0000u);
            const float fg0 = __uint_as_float((wg0 << sh) & 0xffff0000u), fg1 = __uint_as_float((wg1 << sh) & 0xffff0000u), fg2 = __uint_as_float((wg2 << sh) & 0xffff0000u);
            const float av = cw[j] * fa0 + cw[UPW + j] * fa1 + cw[2 * UPW + j] * fa2 + cb[j];
            const float gv = cw[DFF + j] * fg0 + cw[UPW + DFF + j] * fg1 + cw[2 * UPW + DFF + j] * fg2 + cb[DFF + j];
            r[e] = silu_f(gv) * av; }
        u32x4 w; w.x = cvt_pk_bf16(r[0], r[1]); w.y = cvt_pk_bf16(r[2], r[3]); w.z = cvt_pk_bf16(r[4], r[5]); w.w = cvt_pk_bf16(r[6], r[7]);
        *(u32x4*)(act + (size_t)t * DFF + j8) = w;
    }
}
enum { T_P0 = 0, T_INIT, T_GEMM_IN, T_SCAN1, T_SCAN2, T_SCAN3, T_MIX, T_GEMM_OUT, T_LN1, T_GEMM_UP, T_CONV, T_GEMM_DN, T_LN2 };
constexpr int NPHASES = 2 + 18 + 14 + 18 + 14;
__device__ __forceinline__ void decode_phase(int ph, int& type, int& l, int& s) {
    l = 0; s = 0;
    if (ph == 0) { type = T_P0; return; }
    if (ph == 1) { type = T_INIT; return; }
    int q = ph - 2;
    if (q < 18) l = 0; else if (q < 32) { l = 1; q -= 18; } else if (q < 50) { l = 2; q -= 32; } else { l = 3; q -= 50; }
    const int half = (l & 1) ? 3 : 5, nm = 2 * half;
    if (q < nm) { s = q / half; const int st = q % half;
        if (l & 1) type = st == 0 ? T_GEMM_IN : st == 1 ? T_MIX : T_GEMM_OUT;
        else type = st == 0 ? T_GEMM_IN : st == 1 ? T_SCAN1 : st == 2 ? T_SCAN2 : st == 3 ? T_SCAN3 : T_GEMM_OUT;
        return; }
    q -= nm;
    if (q == 0) { type = T_LN1; return; }
    q -= 1;
    if (q < 6) { s = q / 3; const int st = q % 3; type = st == 0 ? T_GEMM_UP : st == 1 ? T_CONV : T_GEMM_DN; return; }
    type = T_LN2;
}
__global__ __launch_bounds__(512, 2) void fwd_megakernel(Params p) {
    extern __shared__ __attribute__((aligned(16))) unsigned char smem[];
    cg::grid_group grid = cg::this_grid();
    unsigned char* ws = p.ws;
    const int nblk = gridDim.x, bid = bidx();
    volatile XLAS unsigned* xst = (volatile XLAS unsigned*)((XLAS unsigned char*)smem + 131072 + 256);
    if (threadIdx.x == 0) { xst[0] = 0u; xst[1] = 0u; xst[2] = 0u; xst[3] = 0u; }
    __syncthreads();
    const XcdBarrier xb = xcd_barrier_post((unsigned*)(ws + OFF_BAR), xst);
    for (int ph = 0; ph < NPHASES; ++ph) {
        int type, l, s; decode_phase(ph, type, l, s);
        const float* x = p.in[0]; const float* ctxin = p.in[2];
        float* out = p.out;
        float* mod = (float*)(ws + OFF_MOD); const float* lbs = (const float*)(ws + OFF_LBS);
        bf16_t* hmod = (bf16_t*)(ws + OFF_HMOD); float* hc = (float*)(ws + OFF_HC); bf16_t* hcmod = (bf16_t*)(ws + OFF_HCMOD);
        bf16_t* Zc = (bf16_t*)(ws + OFF_ZC); bf16_t* actc = (bf16_t*)(ws + OFF_ACTC); bf16_t* OLc = (bf16_t*)(ws + OFF_OLC);
        float* Uctx = (float*)(ws + OFF_UCTX); float* Dctx = (float*)(ws + OFF_DCTX);
        unsigned char* big = ws + OFF_BIG;
        const int kind = l & 1, idx = l >> 1;
        const bool has_ctx = l < 2, ctx_state = (l == 0 || l == 2);
        const float* modl = mod + (size_t)l * 5 * 6144;
        bf16_t* Zhg = (bf16_t*)(big + BIG_HG_Z); bf16_t* OL = (bf16_t*)(big + BIG_HG_OL); float* U = (float*)(big + BIG_HG_U); float* Dk = (float*)(big + BIG_HG_D);
        bf16_t* Zb = (bf16_t*)big; bf16_t* act = (bf16_t*)(big + BIG_FF_ACT);
        const float* lbf = lbs + (0 * 2 + idx) * 1024; const float* lbb = lbs + (1 * 2 + idx) * 1024; const float* normw = p.in[10] + idx * 128;
        if (type == T_P0) {

#ifndef NO_P0
phase0(p, smem);
#endif

        } else if (type == T_INIT) {
            ln_mod(x, nullptr, hmod, nullptr, nullptr, false, mod + 0, mod + 1024, MLAT, SEQ, 0);
            ln_mod(ctxin, nullptr, hcmod, nullptr, nullptr, false, mod + 0, mod + 1024, MCTX, 1 << 30, 4);
        } else if (type == T_GEMM_IN || type == T_GEMM_OUT || type == T_GEMM_UP || type == T_GEMM_DN) {
            GemmJob j; j.e.kind = 0; j.e.O = nullptr; j.e.ldc = 0; j.e.mode = 0; j.e.silu_tiles = 0; j.e.hin = nullptr; j.e.out = nullptr; j.e.gate = nullptr; j.e.b0 = 0; j.e.ctx = 0;
            bool do_ctx = false;
            const float* hin = (l == 0) ? x : out; const float* hcin = (l == 0) ? ctxin : hc;
            for (int job = 0; job < 2; ++job) {
                const bool c = job == 1;
                if (type == T_GEMM_IN) {
                    j.A = c ? hcmod : hmod + (size_t)s * SLAB * DM; j.lda = DM; j.K = DM; j.M = c ? MCTX : SLAB; j.e.kind = 0;
                    if (kind == 0) { j.Bt = (const bf16_t*)(ws + OFF_WT_HGIN) + (size_t)idx * HGIN * DM; j.N = HGIN; j.e.O = c ? Zc : Zhg; j.e.ldc = HGIN; j.e.mode = 1; j.e.silu_tiles = 8; do_ctx = (s == 0) && ctx_state; }
                    else { j.Bt = (const bf16_t*)(ws + OFF_WT_SGIN) + (size_t)idx * SGIN * DM; j.N = SGIN; j.e.O = c ? Zc : Zb; j.e.ldc = SGIN; j.e.mode = 2; j.e.silu_tiles = 0; do_ctx = (s == 0) && has_ctx; }
                } else if (type == T_GEMM_OUT) {
                    j.M = c ? MCTX : SLAB; j.N = DM; j.e.kind = 1; j.e.hin = c ? hcin : hin + (size_t)s * SLAB * DM; j.e.out = c ? hc : out + (size_t)s * SLAB * DM; j.e.gate = modl + 2048; j.e.b0 = s * 2; j.e.ctx = c ? 1 : 0;
                    do_ctx = (s == 0) && has_ctx;
                    if (kind == 0) { j.A = (c ? Zc : Zhg) + 1024; j.lda = HGIN; j.K = DM; j.Bt = (const bf16_t*)(ws + OFF_WT_HGOUT) + (size_t)idx * DM * DM; }
                    else { j.A = c ? Zc : Zb; j.lda = SGIN; j.K = SGW; j.Bt = (const bf16_t*)(ws + OFF_WT_SGOUT) + (size_t)idx * DM * SGW; }
                } else if (type == T_GEMM_UP) {
                    j.A = c ? hcmod : hmod + (size_t)s * SLAB * DM; j.lda = DM; j.K = DM; j.M = c ? MCTX : SLAB; j.N = UPW; j.Bt = (const bf16_t*)(ws + OFF_WT_UP) + (size_t)l * UPW * DM;
                    j.e.kind = 0; j.e.O = c ? Zc : Zb; j.e.ldc = UPW; j.e.mode = 0; j.e.silu_tiles = 0; do_ctx = (s == 0) && has_ctx;
                } else {
                    j.A = c ? actc : act; j.lda = DFF; j.K = DFF; j.M = c ? MCTX : SLAB; j.N = DM; j.Bt = (const bf16_t*)(ws + OFF_WT_DOWN) + (size_t)l * DM * DFF;
                    j.e.kind = 1; j.e.hin = c ? hc : out + (size_t)s * SLAB * DM; j.e.out = c ? hc : out + (size_t)s * SLAB * DM; j.e.gate = modl + 5120; j.e.b0 = s * 2; j.e.ctx = c ? 1 : 0; do_ctx = (s == 0) && has_ctx;
                }
                if (c && !do_ctx) break;

#ifndef NO_GEMM
gemm_call(smem, j);
#endif

            }
        } else if (type == T_SCAN1) {
            const int nu = 256 + ((s == 0 && ctx_state) ? 32 : 0);
            for (int u = bid; u < nu; u += nblk) {
                bf16_t* Zp; bf16_t* OLp; float *Uf, *Ub, *Df, *Db; int T, h;
                if (u < 256) { const int bl = u >> 7, sc = u & 15; h = (u >> 4) & 7; const size_t t0 = (size_t)bl * SEQ + sc * 512; const int sq = (bl * 8 + h) * 2; T = 512;
                    Zp = Zhg + t0 * HGIN; OLp = OL + t0 * DM; Uf = U + ((size_t)(sq + 0) * 16 + sc) * 16384; Ub = U + ((size_t)(sq + 1) * 16 + sc) * 16384; Df = Dk + ((sq + 0) * 16 + sc) * 128; Db = Dk + ((sq + 1) * 16 + sc) * 128; }
                else { const int uc = u - 256, b = uc >> 3; h = uc & 7; const int sq = (b * 8 + h) * 2; T = CTXL;
                    Zp = Zc + (size_t)b * CTXL * HGIN; OLp = OLc + (size_t)b * CTXL * DM; Uf = Uctx + (size_t)(sq + 0) * 16384; Ub = Uctx + (size_t)(sq + 1) * 16384; Df = Dctx + (sq + 0) * 128; Db = Dctx + (sq + 1) * 128; }

#ifndef NO_SCAN1
scan_unit(smem, Zp, T, h, lbf, lbb, OLp, Uf, Ub, Df, Db);
#endif

            }
        } else if (type == T_SCAN2) {

#ifndef NO_SCAN2
scan_pass2(U, Dk, Uctx, s);
#endif

        } else if (type == T_SCAN3) {

#ifndef NO_SCAN3
for (int u = bid; u < 1024; u += nblk) scan_pass3_unit(smem, Zhg, OL, U, normw, u >> 9, (u >> 6) & 7, u & 63);
#endif


#ifndef NO_CTXR
            if (s == 0 && l == 0) ctx_readout(Zc, OLc, normw);
#endif

        } else if (type == T_MIX) {
            const bf16_t* wsb = (const bf16_t*)(ws + OFF_WS_B) + (size_t)idx * 8 * 128 * 128; const float* bsv = p.in[16] + idx * 8 * 128;
            const float* slng = p.in[13] + idx * SGW; const float* slnb = p.in[14] + idx * SGW;
            const int nu = 256 + ((s == 0 && has_ctx) ? 16 : 0);
            for (int u = bid; u < nu; u += nblk) { const bool c = u >= 256; const int uu = c ? u - 256 : u;
#ifndef NO_MIX
sgu_mix_unit(smem, c ? Zc : Zb, uu >> 1, uu & 1, wsb, bsv, slng, slnb);
#endif
 }
        } else if (type == T_CONV) {
            const float* cw = p.in[19] + (size_t)l * 3 * UPW; const float* cb = p.in[20] + (size_t)l * UPW;

#ifndef NO_CONV
            conv_swiglu(Zb, act, cw, cb, SLAB, 64);
            if (s == 0 && has_ctx) conv_swiglu(Zc, actc, cw, cb, MCTX, CTXL);
#endif

        } else {
            const int which = type == T_LN1 ? 0 : 1;
            const float* modn = type == T_LN1 ? modl + 3072 : mod + (size_t)(l + 1) * 5 * 6144;
            const bool want_mod = type == T_LN1 || l < 3;
            const float* ln_g = p.in[6] + (l * 2 + which) * DM; const float* ln_b = p.in[7] + (l * 2 + which) * DM;
            ln_mod(out, out, want_mod ? hmod : nullptr, ln_g, ln_b, true, modn + 0, modn + 1024, MLAT, SEQ, 0);
            if (has_ctx) ln_mod(hc, hc, hcmod, ln_g, ln_b, true, modn + 0, modn + 1024, MCTX, 1 << 30, 4);
        }
        if (ph == 0) grid.sync(); else if (ph + 1 < NPHASES) xcd_barrier(xb);
    }
}

extern "C" void kernel_launch(void* const* d_in, const int* in_sizes, int n_in, void* d_out, int out_size, void* d_ws, size_t ws_size, hipStream_t stream) {
    static int grid_blocks = 0;
    if (!grid_blocks) {
        int dev = 0, cus = 0, per_cu = 0;
        hipGetDevice(&dev);
        hipDeviceGetAttribute(&cus, hipDeviceAttributeMultiprocessorCount, dev);
        hipFuncSetAttribute((const void*)fwd_megakernel, hipFuncAttributeMaxDynamicSharedMemorySize, LDS_BYTES);
        hipOccupancyMaxActiveBlocksPerMultiprocessor(&per_cu, (const void*)fwd_megakernel, 512, LDS_BYTES);
        if (per_cu < 1) per_cu = 1;
        grid_blocks = cus * per_cu;
        (void)hipGetLastError();
    }
    if (n_in != 22 || ws_size < WS_END) { fprintf(stderr, "kernel_launch: unexpected inputs (n_in %d, ws %zu < %zu)\n", n_in, ws_size, (size_t)WS_END); return; }
    (void)hipMemsetAsync((unsigned char*)d_ws + OFF_BAR, 0, (size_t)XCD_BAR_WORDS * 4, stream);
    Params p{};
    for (int i = 0; i < 22; ++i) p.in[i] = (const float*)d_in[i];
    p.out = (float*)d_out; p.ws = (unsigned char*)d_ws;
    void* args[] = {&p};
    hipError_t e = hipLaunchCooperativeKernel((const void*)fwd_megakernel, dim3(grid_blocks), dim3(512), args, LDS_BYTES, stream);
    if (e != hipSuccess) fprintf(stderr, "cooperative launch failed: %s (grid %d)\n", hipGetErrorString(e), grid_blocks);
}
```

```cpp
#include <hip/hip_runtime.h>
#include <hip/hip_cooperative_groups.h>
#include <cstdio>
namespace cg = cooperative_groups;

typedef unsigned short bf16_t;
typedef short bf16x8 __attribute__((ext_vector_type(8)));
typedef float f32x4 __attribute__((ext_vector_type(4)));
typedef float f32x2 __attribute__((ext_vector_type(2)));
typedef unsigned u32x4 __attribute__((ext_vector_type(4)));
typedef unsigned u32x2 __attribute__((ext_vector_type(2)));

__device__ __forceinline__ unsigned cvt_pk_bf16(float lo, float hi) { unsigned r; asm volatile("v_cvt_pk_bf16_f32 %0, %1, %2" : "=v"(r) : "v"(lo), "v"(hi)); return r; }
__device__ __forceinline__ bf16_t f2bf(float f) { return (bf16_t)(cvt_pk_bf16(f, 0.f) & 0xffffu); }
__device__ __forceinline__ float bf2f(bf16_t b) { return __uint_as_float(((unsigned)b) << 16); }
__device__ __forceinline__ float bflo(unsigned w) { return __uint_as_float(w << 16); }
__device__ __forceinline__ float bfhi(unsigned w) { return __uint_as_float(w & 0xffff0000u); }
__device__ __forceinline__ float silu_f(float v) { return v * __builtin_amdgcn_rcpf(1.0f + __expf(-v)); }
__device__ __forceinline__ float sigmoid_f(float v) { return __builtin_amdgcn_rcpf(1.0f + __expf(-v)); }
__device__ __forceinline__ f32x2 gelu_pk(f32x2 v) {
    const f32x2 av = __builtin_elementwise_abs(v), d = av * 0.2316418882f + 1.0f;
    f32x2 t; t.x = __builtin_amdgcn_rcpf(d.x); t.y = __builtin_amdgcn_rcpf(d.y);
    f32x2 q = t * 0.5307027145f + (-0.7265760135f); q = q * t + 0.7107068705f; q = q * t + (-0.142248368f); q = q * t + 0.127414796f; q = q * t;
    const f32x2 s = (v * v) * (-0.72134752044f);
    f32x2 e; e.x = __builtin_amdgcn_exp2f(s.x); e.y = __builtin_amdgcn_exp2f(s.y);
    const f32x2 m = v * (q * e), r = v - m;
    f32x2 o; o.x = v.x < 0.f ? m.x : r.x; o.y = v.y < 0.f ? m.y : r.y; return o;
}

constexpr int WTAB_OFF = 131072 + 512;
__device__ __forceinline__ int hw_slot() { return (int)(__builtin_amdgcn_s_getreg((5 << 11) | 4) & 0x3fu); }
__device__ __forceinline__ int tidx() {
    extern __shared__ __attribute__((aligned(16))) unsigned char smem_t[];
    const int w = *(volatile __attribute__((address_space(3))) int*)((__attribute__((address_space(3))) unsigned char*)smem_t + WTAB_OFF + 4 * hw_slot());
    int lane; asm volatile("v_mbcnt_lo_u32_b32 %0, -1, 0\n\tv_mbcnt_hi_u32_b32 %0, -1, %0" : "=v"(lane));
    return __builtin_amdgcn_readfirstlane(w) * 64 + lane; }
__device__ __forceinline__ int bidx() { int b = blockIdx.x; asm volatile("" : "+s"(b)); return b; }


#define XB_TMO      128
#define XB_XCNT(j)  (256  + 64 * (j))
#define XB_XSUB(j)  (1280 + 64 * (j))
#define XB_XGEN(j)  (2304 + 64 * (j))
#define XB_TOP      3328
#define XB_TOPGEN   3392
#define XCD_BAR_WORDS 3456
#define XB_SPIN_CAP (1u << 20)
#define XLAS __attribute__((address_space(3)))
__device__ __forceinline__ unsigned xb_ld(unsigned* p)              { return __hip_atomic_load(p, __ATOMIC_RELAXED, __HIP_MEMORY_SCOPE_AGENT); }
__device__ __forceinline__ unsigned xb_add(unsigned* p, unsigned v) { return __hip_atomic_fetch_add(p, v, __ATOMIC_RELAXED, __HIP_MEMORY_SCOPE_AGENT); }
__device__ __forceinline__ unsigned xb_xcc_id() { return (unsigned)__builtin_amdgcn_s_getreg((3 << 11) | 20) & 0xFu; }
#define XB_SPIN(cond, bar) do { unsigned _sp = 0; while (cond) { __builtin_amdgcn_s_sleep(1); \
    if ((++_sp & 255u) == 0u) { if (xb_ld(&(bar)[XB_TMO])) break; if (_sp > XB_SPIN_CAP) { atomicAdd(&(bar)[XB_TMO], 1u); break; } } } } while (0)
struct XcdBarrier { unsigned* bar; unsigned x; volatile XLAS unsigned* st; };
__device__ __forceinline__ XcdBarrier xcd_barrier_post(unsigned* bar, volatile XLAS unsigned* st) {
    XcdBarrier b; b.bar = bar; b.x = xb_xcc_id(); b.st = st;
    if (threadIdx.x == 0) (void)xb_add(&bar[XB_XCNT(b.x)], 1u);
    return b;
}
__device__ __forceinline__ void xcd_barrier_complete(unsigned* bar, unsigned x, unsigned& nloc, unsigned& nx) {
    const unsigned G = gridDim.x * gridDim.y * gridDim.z;
    unsigned sum, cnt, mine, sp = 0u;
    for (;;) {
        sum = 0u; cnt = 0u; mine = 0u;
#pragma unroll
        for (unsigned j = 0; j < 16; ++j) { const unsigned c = xb_ld(&bar[XB_XCNT(j)]); sum += c; cnt += (c > 0u) ? 1u : 0u; mine = (j == x) ? c : mine; }
        if (sum == G) break;
        __builtin_amdgcn_s_sleep(1);
        if ((++sp & 255u) == 0u) { if (xb_ld(&bar[XB_TMO])) break; if (sp > XB_SPIN_CAP) { atomicAdd(&bar[XB_TMO], 1u); break; } }
    }
    nloc = mine > 0u ? mine : 1u; nx = cnt > 0u ? cnt : 1u;
}
__device__ __forceinline__ void xcd_barrier(const XcdBarrier& b) {
    asm volatile("s_waitcnt vmcnt(0)" ::: "memory");
    __syncthreads();
    if (tidx() == 0) {
        unsigned* bar = b.bar; asm volatile("" : "+s"(bar));
        __builtin_amdgcn_s_waitcnt(0);
        unsigned nloc = b.st[0], nx = b.st[1];
        if (nloc == 0u) { xcd_barrier_complete(bar, b.x, nloc, nx); b.st[0] = nloc; b.st[1] = nx; }
        const unsigned old = xb_add(&bar[XB_XSUB(b.x)], 1u);
        const unsigned gen = old / nloc;
        if (old + 1u == (gen + 1u) * nloc) {
            __builtin_amdgcn_fence(__ATOMIC_RELEASE, "agent");
            asm volatile("s_waitcnt vmcnt(0)" ::: "memory");
            const unsigned og = xb_add(&bar[XB_TOP], 1u);
            const unsigned tg = og / nx;
            if (og + 1u == (tg + 1u) * nx) xb_add(&bar[XB_TOPGEN], 1u);
            else XB_SPIN(xb_ld(&bar[XB_TOPGEN]) == tg, bar);
            __builtin_amdgcn_fence(__ATOMIC_ACQUIRE, "agent");
            xb_add(&bar[XB_XGEN(b.x)], 1u);
            asm volatile("s_waitcnt vmcnt(0)" ::: "memory");
        } else {
            XB_SPIN(xb_ld(&bar[XB_XGEN(b.x)]) == gen, bar);
            __builtin_amdgcn_fence(__ATOMIC_ACQUIRE, "agent");
            asm volatile("s_waitcnt vmcnt(0)" ::: "memory");
        }
    }
    __syncthreads();
}

__device__ __forceinline__ float shx(float v, int o, int lane) { return __int_as_float(__builtin_amdgcn_ds_bpermute((lane ^ o) << 2, __float_as_int(v))); }
__device__ __forceinline__ float opq(float c) { asm volatile("" : "+s"(c)); return c; }

constexpr int DM = 1024, NB = 4, SEQ = 8192, CTXL = 256, MLAT = NB * SEQ, MCTX = NB * CTXL;
constexpr int HGIN = 5120, SGW = 3072, SGIN = 6144, DFF = 2816, UPW = 5632;
constexpr int SLAB = 16384;
constexpr float ALPHA_F = 1.6817928305074292f;
constexpr int LDP = 136;

constexpr size_t al256(size_t x) { return (x + 255) & ~(size_t)255; }
constexpr size_t OFF_WT_HGIN = 0;
constexpr size_t OFF_WT_HGOUT = OFF_WT_HGIN + al256((size_t)2 * HGIN * DM * 2);
constexpr size_t OFF_WT_SGIN = OFF_WT_HGOUT + al256((size_t)2 * DM * DM * 2);
constexpr size_t OFF_WT_SGOUT = OFF_WT_SGIN + al256((size_t)2 * SGIN * DM * 2);
constexpr size_t OFF_WT_UP = OFF_WT_SGOUT + al256((size_t)2 * DM * SGW * 2);
constexpr size_t OFF_WT_DOWN = OFF_WT_UP + al256((size_t)4 * UPW * DM * 2);
constexpr size_t OFF_WS_B = OFF_WT_DOWN + al256((size_t)4 * DM * DFF * 2);
constexpr size_t OFF_MOD = OFF_WS_B + al256((size_t)2 * 8 * 128 * 128 * 2);
constexpr size_t OFF_LBS = OFF_MOD + al256((size_t)4 * 5 * 6144 * 4);
constexpr size_t OFF_HMOD = OFF_LBS + al256((size_t)2 * 2 * 1024 * 4);
constexpr size_t OFF_HC = OFF_HMOD + al256((size_t)MLAT * DM * 2);
constexpr size_t OFF_HCMOD = OFF_HC + al256((size_t)MCTX * DM * 4);
constexpr size_t OFF_ZC = OFF_HCMOD + al256((size_t)MCTX * DM * 2);
constexpr size_t OFF_ACTC = OFF_ZC + al256((size_t)MCTX * SGIN * 2);
constexpr size_t OFF_OLC = OFF_ACTC + al256((size_t)MCTX * DFF * 2);
constexpr size_t OFF_UCTX = OFF_OLC + al256((size_t)MCTX * DM * 2);
constexpr size_t OFF_DCTX = OFF_UCTX + al256((size_t)NB * 8 * 2 * 16384 * 4);
constexpr size_t OFF_BAR = OFF_DCTX + al256((size_t)NB * 8 * 2 * 128 * 4);
constexpr size_t OFF_BIG = OFF_BAR + al256((size_t)XCD_BAR_WORDS * 4);
constexpr size_t BIG_HG_Z = 0;
constexpr size_t BIG_HG_OL = BIG_HG_Z + (size_t)SLAB * HGIN * 2;
constexpr size_t BIG_HG_U = BIG_HG_OL + (size_t)SLAB * DM * 2;
constexpr size_t BIG_HG_D = BIG_HG_U + (size_t)32 * 16 * 16384 * 4;
constexpr size_t BIG_HG_END = BIG_HG_D + (size_t)32 * 16 * 128 * 4;
constexpr size_t BIG_FF_ACT = (size_t)SLAB * UPW * 2;
constexpr size_t BIG_FF_END = BIG_FF_ACT + (size_t)SLAB * DFF * 2;
constexpr size_t BIG_SG_END = (size_t)SLAB * SGIN * 2;
constexpr size_t BIG_BYTES = BIG_FF_END > BIG_HG_END ? (BIG_FF_END > BIG_SG_END ? BIG_FF_END : BIG_SG_END) : (BIG_HG_END > BIG_SG_END ? BIG_HG_END : BIG_SG_END);
constexpr size_t WS_END = OFF_BIG + BIG_BYTES;
static_assert(WS_END <= (size_t)536870912, "workspace map exceeds the guaranteed 512 MiB");
constexpr int LDS_BYTES = 144 * 1024;

struct Params { const float* in[22]; float* out; unsigned char* ws; };
namespace pg8 {
#define PG8_LAS __attribute__((address_space(3)))
constexpr int BM = 256, BK = 64, HALF = 128, HTB = HALF * BK * 2, STAGE_BYTES = 8 * HTB, NXCD = 8, WGM = 8;
__host__ __device__ __forceinline__ int lds_byte(int r, int c) { const int st = (r >> 4) * 2 + (c >> 5), rr = r & 15, cc = c & 31, ob = rr * 64 + cc * 2; return st * 1024 + (ob ^ (((ob >> 9) & 1) << 5)); }
__host__ __device__ __forceinline__ void stage_rc(int b, int& R, int& C) { const int st = b / 1024, sb = b % 1024, swz = sb ^ (((sb >> 9) & 1) << 5); R = (st >> 1) * 16 + swz / 64; C = (st & 1) * 32 + (swz % 64) / 2; }
__host__ __device__ __forceinline__ int perm32(int rho) { const int n = rho >> 4, i = rho & 15; return 8 * (i >> 2) + 4 * n + (i & 3); }
struct Unit { int pm, pn; };
struct Gemm { const bf16_t* A; const bf16_t* Bt; int M, N, K, lda; };
struct StaticOrder {
    int nM, nN, nwg, G, c;
    __device__ void init(int M, int N, int G_, int c_) { nM = M / BM; nN = N / BM; nwg = nM * nN; G = G_; c = c_; }
    __device__ bool next(int i, Unit& u) const {
        const long L = (long)i * G + c; if (L >= nwg) return false;
        int wgid = (int)L; { const int q = nwg / NXCD, r = nwg % NXCD, xcd = wgid % NXCD, off = wgid / NXCD; wgid = (xcd < r ? xcd * (q + 1) : r * (q + 1) + (xcd - r) * q) + off; }
        const int nig = WGM * nN, gid = wgid / nig, fm = gid * WGM, gsz = (nM - fm) < WGM ? (nM - fm) : WGM;
        u.pm = fm + ((wgid % nig) % gsz); u.pn = (wgid % nig) / gsz; return true;
    }
};
template <class Epi>
__device__ __forceinline__ void gemm_phase(PG8_LAS unsigned char* lds, const Gemm g, const StaticOrder& S, const Epi& E) {
    const bool perm = E.perm();
    const int tid = tidx(), wid = __builtin_amdgcn_readfirstlane(tid >> 6), lane = tid & 63, wr = wid >> 2, wc = wid & 3, fr = lane & 15, fq = lane >> 4;
    const int K = g.K, nt = K / BK, lda = g.lda;
    unsigned voffA, voffB;
    { int R, C; stage_rc(tid * 16, R, C); const int Rb = perm ? ((R & ~31) + perm32(R & 31)) : R;
        voffA = (unsigned)(R * lda + C) * 2u; voffB = (unsigned)(Rb * K + C) * 2u; }
    const size_t r64A = (size_t)64 * lda * 2, r64B = (size_t)64 * K * 2;
    const size_t kstep = (size_t)(BK * 2);
    const size_t hstepA = (size_t)HALF * lda * 2, hstepB = (size_t)HALF * K * 2;
    const size_t tstepA = 2 * hstepA, tstepB = 2 * hstepB;
    const unsigned ldsw = (unsigned)wid * 1024u;
    const int aoff = lds_byte(wr * 64 + fr, fq * 8), boff = lds_byte(wc * 32 + fr, fq * 8);
#define PG8_SA(b, h) (((b) * 2 + (h)) * HTB)
#define PG8_SB(b, h) ((4 + (b) * 2 + (h)) * HTB)
#define PG8_R64_voffA r64A
#define PG8_R64_voffB r64B
#define PG8_R64(v) PG8_R64_##v
#define PG8_STAGE(bufoff, gbase, voff) do { _Pragma("unroll") for (int _i = 0; _i < 2; ++_i) \
        __builtin_amdgcn_global_load_lds((const unsigned*)((const char*)(gbase) + (size_t)_i * PG8_R64(voff) + (voff)), (PG8_LAS unsigned*)(lds + (bufoff) + ldsw + _i * 8192), 16, 0, 0); } while (0)
#define PG8_LDA(dst, b, h) do { _Pragma("unroll") for (int m = 0; m < 4; ++m) _Pragma("unroll") for (int k = 0; k < 2; ++k) dst[m][k] = *(const PG8_LAS bf16x8*)(lds + PG8_SA(b, h) + aoff + m * 2048 + k * 1024); } while (0)
#define PG8_LDB(dst, b, h) do { _Pragma("unroll") for (int n = 0; n < 2; ++n) _Pragma("unroll") for (int k = 0; k < 2; ++k) dst[n][k] = *(const PG8_LAS bf16x8*)(lds + PG8_SB(b, h) + boff + n * 2048 + k * 1024); } while (0)
#define PG8_MMA(ai, bj, At, Bt) do { __builtin_amdgcn_s_setprio(1); _Pragma("unroll") for (int m = 0; m < 4; ++m) _Pragma("unroll") for (int n = 0; n < 2; ++n) _Pragma("unroll") for (int k = 0; k < 2; ++k) \
        acc[ai][bj][m][n] = __builtin_amdgcn_mfma_f32_16x16x32_bf16(Bt[n][k], At[m][k], acc[ai][bj][m][n], 0, 0, 0); __builtin_amdgcn_s_setprio(0); } while (0)
#define PG8_WAIT_V(n) asm volatile("s_waitcnt vmcnt(" #n ")" ::: "memory")
#define PG8_WAIT_L(n) asm volatile("s_waitcnt lgkmcnt(" #n ")" ::: "memory")
#define PG8_BAR __builtin_amdgcn_s_barrier()
#define PG8_SCHED __builtin_amdgcn_sched_barrier(0)
    Unit cur, nxt; int ui = 0;
    if (!S.next(0, cur)) return;
    f32x4 acc[2][2][4][2];
#pragma unroll
    for (int a = 0; a < 2; ++a)
#pragma unroll
        for (int b = 0; b < 2; ++b)
#pragma unroll
            for (int m = 0; m < 4; ++m)
#pragma unroll
                for (int n = 0; n < 2; ++n) acc[a][b][m][n] = (f32x4){0.f, 0.f, 0.f, 0.f};
    bf16x8 At[4][2], B0[2][2], B1[2][2];
    const char* cA = (const char*)g.A + (size_t)cur.pm * tstepA; const char* cB = (const char*)g.Bt + (size_t)cur.pn * tstepB;
    PG8_STAGE(PG8_SB(0, 0), cB, voffB); PG8_STAGE(PG8_SA(0, 0), cA, voffA); PG8_STAGE(PG8_SB(0, 1), cB + hstepB, voffB); PG8_STAGE(PG8_SA(0, 1), cA + hstepA, voffA);
    if (wr == 1) PG8_BAR;
    PG8_WAIT_V(4); PG8_BAR;
    PG8_STAGE(PG8_SB(1, 0), cB + kstep, voffB); PG8_STAGE(PG8_SA(1, 0), cA + kstep, voffA); PG8_STAGE(PG8_SB(1, 1), cB + hstepB + kstep, voffB);
    PG8_WAIT_V(6); PG8_BAR;
    for (;;) {
        const bool has_next = S.next(ui + 1, nxt);
        const char* nA = has_next ? (const char*)g.A + (size_t)nxt.pm * tstepA : cA; const char* nB = has_next ? (const char*)g.Bt + (size_t)nxt.pn * tstepB : cB;
        for (int t = 0; t < nt; t += 2) {
            const bool last = (t == nt - 2);
            const char* a1 = cA + (size_t)(t + 1) * kstep;
            const char* a2 = last ? nA : cA + (size_t)(t + 2) * kstep; const char* b2 = last ? nB : cB + (size_t)(t + 2) * kstep;
            const char* a3 = a2 + kstep; const char* b3 = b2 + kstep;
            PG8_LDB(B0, 0, 0); PG8_SCHED; PG8_LDA(At, 0, 0); PG8_STAGE(PG8_SA(1, 1), a1 + hstepA, voffA);
            PG8_WAIT_L(8); PG8_BAR; PG8_WAIT_L(0); PG8_MMA(0, 0, At, B0); PG8_BAR; PG8_SCHED;
            PG8_LDB(B1, 0, 1); PG8_STAGE(PG8_SB(0, 0), b2, voffB);
            PG8_BAR; PG8_WAIT_L(0); PG8_MMA(0, 1, At, B1); PG8_BAR;
            PG8_LDA(At, 0, 1); PG8_STAGE(PG8_SA(0, 0), a2, voffA);
            PG8_BAR; PG8_WAIT_L(0); PG8_MMA(1, 0, At, B0); PG8_BAR; PG8_SCHED;
            PG8_STAGE(PG8_SB(0, 1), b2 + hstepB, voffB);
            PG8_WAIT_V(6); PG8_BAR; PG8_MMA(1, 1, At, B1); PG8_BAR;
            PG8_LDB(B0, 1, 0); PG8_SCHED; PG8_LDA(At, 1, 0); PG8_STAGE(PG8_SA(0, 1), a2 + hstepA, voffA);
            PG8_WAIT_L(8); PG8_BAR; PG8_WAIT_L(0); PG8_MMA(0, 0, At, B0); PG8_BAR; PG8_SCHED;
            PG8_LDB(B1, 1, 1); PG8_STAGE(PG8_SB(1, 0), b3, voffB);
            PG8_BAR; PG8_WAIT_L(0); PG8_MMA(0, 1, At, B1); PG8_BAR;
            PG8_LDA(At, 1, 1); PG8_STAGE(PG8_SA(1, 0), a3, voffA);
            PG8_BAR; PG8_WAIT_L(0); PG8_MMA(1, 0, At, B0); PG8_BAR; PG8_SCHED;
            PG8_STAGE(PG8_SB(1, 1), b3 + hstepB, voffB);
            PG8_WAIT_V(6); PG8_BAR; PG8_MMA(1, 1, At, B1); PG8_BAR;
        }
        E(acc, cur, wr, wc, fr, fq);
        if (!has_next) break;
#pragma unroll
        for (int a = 0; a < 2; ++a)
#pragma unroll
            for (int b = 0; b < 2; ++b)
#pragma unroll
                for (int m = 0; m < 4; ++m)
#pragma unroll
                    for (int n = 0; n < 2; ++n) acc[a][b][m][n] = (f32x4){0.f, 0.f, 0.f, 0.f};
        cur = nxt; cA = nA; cB = nB; ++ui;
    }
    PG8_WAIT_V(0);
    if (wr == 0) PG8_BAR;
    PG8_BAR;
#undef PG8_SA
#undef PG8_SB
#undef PG8_STAGE
#undef PG8_LDA
#undef PG8_LDB
#undef PG8_MMA
#undef PG8_WAIT_V
#undef PG8_WAIT_L
#undef PG8_BAR
#undef PG8_SCHED
}
}
struct EpiAny {
    int kind;
    bf16_t* O; int ldc; int mode; int silu_tiles;
    const float* hin; float* out; const float* gate; int b0; int ctx;
    __device__ __forceinline__ bool perm() const { return kind != 1; }
    __device__ __forceinline__ void operator()(const f32x4 (&acc)[2][2][4][2], const pg8::Unit& u, int wr, int wc, int fr, int fq) const {
        if (kind == 0) {
            const int row0 = u.pm * 256 + wr * 64 + fr, col0 = u.pn * 256 + wc * 32 + 8 * fq;
            const bool do_silu = (mode == 1) && (u.pn < silu_tiles);
#pragma unroll
            for (int ai = 0; ai < 2; ++ai)
#pragma unroll
                for (int m = 0; m < 4; ++m) { bf16_t* rowp = O + (size_t)(row0 + ai * 128 + m * 16) * ldc + col0;
#pragma unroll
                    for (int bj = 0; bj < 2; ++bj) { f32x4 v0 = acc[ai][bj][m][0], v1 = acc[ai][bj][m][1];
                        if (mode == 2) { f32x2 a = gelu_pk((f32x2){v0[0], v0[1]}), b = gelu_pk((f32x2){v0[2], v0[3]}), c = gelu_pk((f32x2){v1[0], v1[1]}), d = gelu_pk((f32x2){v1[2], v1[3]});
                            v0 = (f32x4){a.x, a.y, b.x, b.y}; v1 = (f32x4){c.x, c.y, d.x, d.y}; }
                        else if (do_silu) {
#pragma unroll
                            for (int j = 0; j < 4; ++j) { v0[j] = silu_f(v0[j]); v1[j] = silu_f(v1[j]); } }
                        u32x4 w; w.x = cvt_pk_bf16(v0[0], v0[1]); w.y = cvt_pk_bf16(v0[2], v0[3]); w.z = cvt_pk_bf16(v1[0], v1[1]); w.w = cvt_pk_bf16(v1[2], v1[3]);
                        *(u32x4*)(rowp + bj * 128) = w; } }
        } else if (kind == 2) {
            const float* cw = hin; const float* cb = gate;
            const bool first = fr == 0, lastl = fr == 15;
#pragma unroll 1
            for (int n = 0; n < 2; ++n) {
                const int j0 = u.pn * 128 + wc * 32 + 8 * fq + 4 * n;
                f32x4 wa[3], wg[3], ba, bg;
#pragma unroll
                for (int k = 0; k < 3; ++k) { wa[k] = *(const f32x4*)(cw + k * UPW + j0); wg[k] = *(const f32x4*)(cw + k * UPW + DFF + j0); }
                ba = *(const f32x4*)(cb + j0); bg = *(const f32x4*)(cb + DFF + j0);
#pragma unroll
                for (int ai = 0; ai < 2; ++ai) {
                    float res[4][4];
#pragma unroll
                    for (int e = 0; e < 4; ++e) {
                        float ya[4], yg[4];
#pragma unroll
                        for (int m = 0; m < 4; ++m) { ya[m] = n == 0 ? acc[ai][0][m][0][e] : acc[ai][0][m][1][e]; yg[m] = n == 0 ? acc[ai][1][m][0][e] : acc[ai][1][m][1][e]; }
#pragma unroll
                        for (int m = 0; m < 4; ++m) {
                            const float pa = m > 0 ? ya[m - 1] : 0.f, na = m < 3 ? ya[m + 1] : 0.f, pg = m > 0 ? yg[m - 1] : 0.f, ng = m < 3 ? yg[m + 1] : 0.f;
                            const float la = __int_as_float(__builtin_amdgcn_update_dpp(0, __float_as_int(lastl ? pa : ya[m]), 0x121, 0xf, 0xf, false));
                            const float ra = __int_as_float(__builtin_amdgcn_update_dpp(0, __float_as_int(first ? na : ya[m]), 0x12F, 0xf, 0xf, false));
                            const float lg = __int_as_float(__builtin_amdgcn_update_dpp(0, __float_as_int(lastl ? pg : yg[m]), 0x121, 0xf, 0xf, false));
                            const float rg = __int_as_float(__builtin_amdgcn_update_dpp(0, __float_as_int(first ? ng : yg[m]), 0x12F, 0xf, 0xf, false));
                            const float av = wa[0][e] * la + wa[1][e] * ya[m] + wa[2][e] * ra + ba[e];
                            const float gv = wg[0][e] * lg + wg[1][e] * yg[m] + wg[2][e] * rg + bg[e];
                            res[m][e] = silu_f(gv) * av;
                        }
                    }
#pragma unroll
                    for (int m = 0; m < 4; ++m) { u32x2 w; w.x = cvt_pk_bf16(res[m][0], res[m][1]); w.y = cvt_pk_bf16(res[m][2], res[m][3]);
                        *(u32x2*)(O + (size_t)(u.pm * 256 + ai * 128 + wr * 64 + m * 16 + fr) * ldc + j0) = w; }
                }
            }
        } else {
            const int row0 = u.pm * 256 + wr * 64 + fr, col0 = u.pn * 256 + wc * 32 + 4 * fq;
            const int b = ctx ? 4 : b0 + (u.pm * 256) / SEQ;
            const float* gp = gate + (size_t)b * 6144 + col0;
            f32x4 gv[2][2];
#pragma unroll
            for (int bj = 0; bj < 2; ++bj)
#pragma unroll
                for (int n = 0; n < 2; ++n) gv[bj][n] = *(const f32x4*)(gp + bj * 128 + n * 16);
#pragma unroll
            for (int ai = 0; ai < 2; ++ai)
#pragma unroll
                for (int m = 0; m < 4; ++m) { const size_t off = (size_t)(row0 + ai * 128 + m * 16) * DM + col0;
#pragma unroll
                    for (int bj = 0; bj < 2; ++bj)
#pragma unroll
                        for (int n = 0; n < 2; ++n) { const f32x4 h4 = *(const f32x4*)(hin + off + bj * 128 + n * 16);
                            *(f32x4*)(out + off + bj * 128 + n * 16) = h4 * ALPHA_F + gv[bj][n] * acc[ai][bj][m][n]; } }
        }
    }
};
struct GemmJob { const bf16_t* A; const bf16_t* Bt; int lda, M, N, K; EpiAny e; };
constexpr int EPI_LDS_OFF = 131072;
struct EpiLds {
    int kind0;
    __device__ __forceinline__ bool perm() const { return kind0 != 1; }
    __device__ __forceinline__ void operator()(const f32x4 (&acc)[2][2][4][2], const pg8::Unit& u, int wr, int wc, int fr, int fq) const {
        extern __shared__ __attribute__((aligned(16))) unsigned char smem_e[];
        const EpiAny e = *(const EpiAny*)(smem_e + EPI_LDS_OFF);
        e(acc, u, wr, wc, fr, fq);
    }
};
__device__ __forceinline__ void gemm_call(unsigned char* smem, const GemmJob& j) {
    __syncthreads();
    if (tidx() == 0) *(EpiAny*)(smem + EPI_LDS_OFF) = j.e;
    __syncthreads();
    pg8::Gemm g; g.A = j.A; g.Bt = j.Bt; g.M = j.M; g.N = j.N; g.K = j.K; g.lda = j.lda;
    pg8::StaticOrder S; S.init(j.M, j.N, (int)gridDim.x, bidx());
    EpiLds el; el.kind0 = j.e.kind;
    pg8::gemm_phase<EpiLds>((PG8_LAS unsigned char*)smem, g, S, el);
}

__device__ void transpose_cvt(const float* src, bf16_t* dst, int nmat, int K, int N, int ffn_perm, float* tile  ) {
    const int tid = tidx(), tk = K / 64, tn = N / 64, per = tk * tn, total = nmat * per;
    for (int u = bidx(); u < total; u += gridDim.x) {
        const int mi = u / per, r = u % per, kt = r / tn, ntl = r % tn;
        const float* s = src + (size_t)mi * K * N + (size_t)(kt * 64) * N + ntl * 64;
#pragma unroll
        for (int i = 0; i < 2; ++i) { const int row = (tid >> 4) + 32 * i, c4 = (tid & 15) * 4; const f32x4 v = *(const f32x4*)(s + (size_t)row * N + c4);
            tile[row * 65 + c4 + 0] = v[0]; tile[row * 65 + c4 + 1] = v[1]; tile[row * 65 + c4 + 2] = v[2]; tile[row * 65 + c4 + 3] = v[3]; }
        __syncthreads();
        { const int n = tid >> 3, k8 = (tid & 7) * 8; int ng = ntl * 64 + n;
          if (ffn_perm) ng = ng < DFF ? ((ng >> 7) * 256 + (ng & 127)) : ((((ng - DFF) >> 7) * 256) + 128 + ((ng - DFF) & 127));
          u32x4 w; w.x = cvt_pk_bf16(tile[(k8 + 0) * 65 + n], tile[(k8 + 1) * 65 + n]); w.y = cvt_pk_bf16(tile[(k8 + 2) * 65 + n], tile[(k8 + 3) * 65 + n]);
          w.z = cvt_pk_bf16(tile[(k8 + 4) * 65 + n], tile[(k8 + 5) * 65 + n]); w.w = cvt_pk_bf16(tile[(k8 + 6) * 65 + n], tile[(k8 + 7) * 65 + n]);
          *(u32x4*)(dst + (size_t)mi * K * N + (size_t)ng * K + kt * 64 + k8) = w; }
        __syncthreads();
    }
}
__device__ void phase0(const Params& p, unsigned char* smem) {
    const int tid = tidx();
    unsigned char* ws = p.ws;
    float* mod = (float*)(ws + OFF_MOD);
    {
        float* sc = (float*)smem; float* red = sc + 5 * 1024;
        const float* c = p.in[1]; const float* cctx = p.in[3]; const float* ada_w = p.in[4]; const float* ada_b = p.in[5];
        for (int i = tid; i < 5 * 1024; i += 512) { const float v = i < 4096 ? c[i] : cctx[i - 4096]; sc[i] = silu_f(v); }
        __syncthreads();
        for (int u = bidx(); u < 256; u += gridDim.x) {
            const int l = u >> 6, col0 = (u & 63) * 96, cq = tid % 24, kp = tid / 24;
            float acc[5][4];
#pragma unroll
            for (int r = 0; r < 5; ++r)
#pragma unroll
                for (int e = 0; e < 4; ++e) acc[r][e] = 0.f;
            if (kp < 21) {
                for (int k = kp; k < 1024; k += 21) { const f32x4 w = *(const f32x4*)(ada_w + ((size_t)l * 1024 + k) * 6144 + col0 + cq * 4);
#pragma unroll
                    for (int r = 0; r < 5; ++r) { const float s = sc[r * 1024 + k];
#pragma unroll
                        for (int e = 0; e < 4; ++e) acc[r][e] += s * w[e]; } }
#pragma unroll
                for (int r = 0; r < 5; ++r)
#pragma unroll
                    for (int e = 0; e < 4; ++e) red[(kp * 5 + r) * 96 + cq * 4 + e] = acc[r][e];
            }
            __syncthreads();
            if (tid < 480) { const int r = tid / 96, cc = tid % 96; float s = ada_b[l * 6144 + col0 + cc];
                for (int k2 = 0; k2 < 21; ++k2) s += red[(k2 * 5 + r) * 96 + cc];
                mod[((size_t)l * 5 + r) * 6144 + col0 + cc] = s; }
            __syncthreads();
        }
    }
    if (bidx() == 0) {
        const float* hg_lb = p.in[9]; float* lbs = (float*)(ws + OFF_LBS);
        for (int i = tid; i < 2048; i += 512) { const int dir = i >> 10, k = i & 1023; const float a0 = hg_lb[(dir * 2 + 0) * 1024 + k], a1 = hg_lb[(dir * 2 + 1) * 1024 + k];
            lbs[(dir * 2 + 0) * 1024 + k] = 0.f; lbs[(dir * 2 + 1) * 1024 + k] = 1.0f / (1.0f + expf(a0 - a1)); }
    }
    {
        const float* s = p.in[15]; bf16_t* d = (bf16_t*)(ws + OFF_WS_B);
        for (int i = bidx() * 512 + tid; i < 2 * 8 * 128 * 128 / 4; i += gridDim.x * 512) { const f32x4 v = *(const f32x4*)(s + (size_t)i * 4); u32x2 w; w.x = cvt_pk_bf16(v[0], v[1]); w.y = cvt_pk_bf16(v[2], v[3]); *(u32x2*)(d + (size_t)i * 4) = w; }
    }
    __syncthreads();
    float* tile = (float*)smem;
    transpose_cvt(p.in[8], (bf16_t*)(ws + OFF_WT_HGIN), 2, DM, HGIN, 0, tile);
    transpose_cvt(p.in[11], (bf16_t*)(ws + OFF_WT_HGOUT), 2, DM, DM, 0, tile);
    transpose_cvt(p.in[12], (bf16_t*)(ws + OFF_WT_SGIN), 2, DM, SGIN, 0, tile);
    transpose_cvt(p.in[17], (bf16_t*)(ws + OFF_WT_SGOUT), 2, SGW, DM, 0, tile);
    transpose_cvt(p.in[18], (bf16_t*)(ws + OFF_WT_UP), 4, DM, UPW, 1, tile);
    transpose_cvt(p.in[21], (bf16_t*)(ws + OFF_WT_DOWN), 4, DFF, DM, 0, tile);
}

__device__ void ln_mod(const float* src, float* hdst, bf16_t* mdst, const float* lng, const float* lnb, bool do_ln,
                       const float* shift, const float* scale, int nrows, int rows_per_b, int b0) {
    const int lane = tidx() & 63, gw = bidx() * 8 + (tidx() >> 6), nw = gridDim.x * 8;
    for (int row = gw; row < nrows; row += nw) {
        const float* s = src + (size_t)row * DM; f32x4 x[4];
#pragma unroll
        for (int i = 0; i < 4; ++i) x[i] = *(const f32x4*)(s + i * 256 + lane * 4);
        if (do_ln) {
            float sm = 0.f;
#pragma unroll
            for (int i = 0; i < 4; ++i) sm += (x[i][0] + x[i][1]) + (x[i][2] + x[i][3]);
#pragma unroll
            for (int o = 32; o >= 1; o >>= 1) sm += shx(sm, o, lane);
            const float mean = sm * (1.0f / 1024.0f); float q = 0.f;
#pragma unroll
            for (int i = 0; i < 4; ++i) { const f32x4 d = x[i] - mean; q += (d[0] * d[0] + d[1] * d[1]) + (d[2] * d[2] + d[3] * d[3]); }
#pragma unroll
            for (int o = 32; o >= 1; o >>= 1) q += shx(q, o, lane);
            const float rstd = rsqrtf(q * (1.0f / 1024.0f) + opq(1e-5f));
#pragma unroll
            for (int i = 0; i < 4; ++i) { const f32x4 g4 = *(const f32x4*)(lng + i * 256 + lane * 4), b4 = *(const f32x4*)(lnb + i * 256 + lane * 4);
                x[i] = (x[i] - mean) * rstd * g4 + b4; *(f32x4*)(hdst + (size_t)row * DM + i * 256 + lane * 4) = x[i]; }
        }
        if (mdst) {
            const int b = b0 + row / rows_per_b; const float* sh = shift + (size_t)b * 6144; const float* scl = scale + (size_t)b * 6144;
#pragma unroll
            for (int i = 0; i < 4; ++i) { const f32x4 s4 = *(const f32x4*)(sh + i * 256 + lane * 4), c4 = *(const f32x4*)(scl + i * 256 + lane * 4);
                const f32x4 y = x[i] * (c4 + 1.0f) + s4; u32x2 w; w.x = cvt_pk_bf16(y[0], y[1]); w.y = cvt_pk_bf16(y[2], y[3]);
                *(u32x2*)(mdst + (size_t)row * DM + i * 256 + lane * 4) = w; }
        }
    }
}

__device__ __forceinline__ void tile_mma_128(const bf16_t* la, const bf16_t* lb, f32x4 (&acc)[8], int w, int fr, int fq) {
#pragma unroll
    for (int kk = 0; kk < 4; ++kk) {
        const bf16x8 a = *(const bf16x8*)(la + (16 * w + fr) * LDP + kk * 32 + fq * 8);
#pragma unroll
        for (int nb = 0; nb < 8; ++nb) { const bf16x8 b = *(const bf16x8*)(lb + (16 * nb + fr) * LDP + kk * 32 + fq * 8);
            acc[nb] = __builtin_amdgcn_mfma_f32_16x16x32_bf16(b, a, acc[nb], 0, 0, 0); }
    }
}

__device__ void scan_unit(unsigned char* smem, bf16_t* Z, int T, int h, const float* lbf, const float* lbb, bf16_t* OL, float* Uf, float* Ub, float* Df, float* Db) {
    float* Qs = (float*)smem; float* Fs = Qs + 2048; float* Ks = Fs + 2048; float* Vs = Ks + 2048; float* OP = Vs + 2048;
    const int tid = tidx(), d = tid & 127, kq = tid >> 7, ttl = tid >> 5, k4 = (tid & 31) * 4;
    for (int dir = 0; dir < 2; ++dir) {
        const int zcol = (dir ? 4096 : 3072) + h * 128;
        const float* lb = (dir ? lbb : lbf) + h * 128;
        const f32x4 lbv = *(const f32x4*)(lb + k4);
        float S[32];
#pragma unroll
        for (int i = 0; i < 32; ++i) S[i] = 0.f;
        float P = 1.f;
#pragma unroll 1
        for (int st = 0; st < T / 16; ++st) {
            __syncthreads();
            {   const int pos = st * 16 + ttl, tok = dir ? (T - 1 - pos) : pos;
                const bf16_t* zr = Z + (size_t)tok * HGIN;
                const u32x2 q2 = *(const u32x2*)(zr + h * 128 + k4), f2 = *(const u32x2*)(zr + zcol + k4), v2 = *(const u32x2*)(zr + 2048 + h * 128 + k4);
                const float zf[4] = {bflo(f2.x), bfhi(f2.x), bflo(f2.y), bfhi(f2.y)};
                f32x4 fv, kv;
#pragma unroll
                for (int e = 0; e < 4; ++e) { const float f = lbv[e] + (1.0f - lbv[e]) * sigmoid_f(zf[e]); fv[e] = f; kv[e] = 1.0f - f; }
                *(f32x4*)(Fs + ttl * 128 + k4) = fv; *(f32x4*)(Ks + ttl * 128 + k4) = kv;
                *(f32x4*)(Qs + ttl * 128 + k4) = (f32x4){bflo(q2.x), bfhi(q2.x), bflo(q2.y), bfhi(q2.y)};
                *(f32x4*)(Vs + ttl * 128 + k4) = (f32x4){bflo(v2.x), bfhi(v2.x), bflo(v2.y), bfhi(v2.y)};
            }
            __syncthreads();
            if (tid < 128) {
#pragma unroll 1
                for (int tt = 0; tt < 16; ++tt) { P *= Fs[tt * 128 + tid]; const float qg = Qs[tt * 128 + tid] * P;
                    const int pos = st * 16 + tt, tok = dir ? (T - 1 - pos) : pos; Z[(size_t)tok * HGIN + zcol + tid] = f2bf(qg); }
            }
#pragma unroll 1
            for (int tt = 0; tt < 16; ++tt) {
                const float v = Vs[tt * 128 + d]; float o = 0.f;
                const f32x4* F4 = (const f32x4*)(Fs + tt * 128 + kq * 32); const f32x4* K4 = (const f32x4*)(Ks + tt * 128 + kq * 32); const f32x4* Q4 = (const f32x4*)(Qs + tt * 128 + kq * 32);
#pragma unroll
                for (int i4 = 0; i4 < 8; ++i4) { const f32x4 f = F4[i4], k = K4[i4], q = Q4[i4];
#pragma unroll
                    for (int e = 0; e < 4; ++e) { S[i4 * 4 + e] = f[e] * S[i4 * 4 + e] + k[e] * v; o += q[e] * S[i4 * 4 + e]; } }
                OP[(kq * 16 + tt) * 128 + d] = o;
            }
            __syncthreads();
            {   const f32x4 s = *(const f32x4*)(OP + (0 * 16 + ttl) * 128 + k4) + *(const f32x4*)(OP + (1 * 16 + ttl) * 128 + k4) + *(const f32x4*)(OP + (2 * 16 + ttl) * 128 + k4) + *(const f32x4*)(OP + (3 * 16 + ttl) * 128 + k4);
                const int pos = st * 16 + ttl, tok = dir ? (T - 1 - pos) : pos;
                bf16_t* op = OL + (size_t)tok * DM + h * 128 + k4; f32x4 r = s;
                if (dir) { const u32x2 pv = *(const u32x2*)op; r[0] += bflo(pv.x); r[1] += bfhi(pv.x); r[2] += bflo(pv.y); r[3] += bfhi(pv.y); }
                u32x2 w; w.x = cvt_pk_bf16(r[0], r[1]); w.y = cvt_pk_bf16(r[2], r[3]); *(u32x2*)op = w;
            }
        }
        float* U = dir ? Ub : Uf;
#pragma unroll
        for (int i = 0; i < 32; ++i) U[(kq * 32 + i) * 128 + d] = S[i];
        if (tid < 128) (dir ? Db : Df)[tid] = P;
    }
    __syncthreads();
}
__device__ void scan_pass2(float* U, const float* Dk, const float* Uctx, int s) {
    const int gt = bidx() * 512 + tidx(), nt = gridDim.x * 512;
    for (int e4 = gt; e4 < 32 * 4096; e4 += nt) {
        const int seq = e4 >> 12, el = (e4 & 4095) * 4, k = el >> 7, bl = seq >> 4, hd = seq & 15, dir = seq & 1;
        f32x4 cur = *(const f32x4*)(Uctx + (size_t)((s * 2 + bl) * 16 + hd) * 16384 + el);
        for (int jj = 0; jj < 16; ++jj) { const int j = dir ? 15 - jj : jj; float* up = U + ((size_t)seq * 16 + j) * 16384 + el;
            const f32x4 tmp = *(const f32x4*)up; *(f32x4*)up = cur; const float dk = Dk[(seq * 16 + j) * 128 + k]; cur = cur * dk + tmp; }
    }
}
__device__ void scan_pass3_unit(unsigned char* smem, bf16_t* Z, const bf16_t* OL, const float* U, const float* normw, int bl, int h, int tile) {
    bf16_t* la = (bf16_t*)smem; bf16_t* lb = la + 128 * LDP;
    const int tid = tidx(), w = tid >> 6, lane = tid & 63, fr = lane & 15, fq = lane >> 4;
    const int tok0 = bl * SEQ + tile * 128, j = tile >> 2;
    f32x4 acc[8];
#pragma unroll
    for (int nb = 0; nb < 8; ++nb) acc[nb] = (f32x4){0.f, 0.f, 0.f, 0.f};
    for (int dir = 0; dir < 2; ++dir) {
        __syncthreads();
        const int zcol = (dir ? 4096 : 3072) + h * 128;
#pragma unroll
        for (int i = 0; i < 4; ++i) { const int c = tid + 512 * i, r = c >> 4, k8 = (c & 15) * 8;
            *(u32x4*)(la + r * LDP + k8) = *(const u32x4*)(Z + (size_t)(tok0 + r) * HGIN + zcol + k8); }
        const float* Sp = U + ((size_t)((bl * 8 + h) * 2 + dir) * 16 + j) * 16384;
#pragma unroll
        for (int i = 0; i < 8; ++i) { const int c = tid + 512 * i, k = c >> 5, d4 = (c & 31) * 4; const f32x4 v = *(const f32x4*)(Sp + k * 128 + d4);
            lb[(d4 + 0) * LDP + k] = f2bf(v[0]); lb[(d4 + 1) * LDP + k] = f2bf(v[1]); lb[(d4 + 2) * LDP + k] = f2bf(v[2]); lb[(d4 + 3) * LDP + k] = f2bf(v[3]); }
        __syncthreads();
        tile_mma_128(la, lb, acc, w, fr, fq);
    }
    const int tok = tok0 + 16 * w + fr;
    float ss = 0.f;
#pragma unroll
    for (int nb = 0; nb < 8; ++nb) { const u32x2 pv = *(const u32x2*)(OL + (size_t)tok * DM + h * 128 + 16 * nb + 4 * fq);
        acc[nb][0] += bflo(pv.x); acc[nb][1] += bfhi(pv.x); acc[nb][2] += bflo(pv.y); acc[nb][3] += bfhi(pv.y);
        ss += (acc[nb][0] * acc[nb][0] + acc[nb][1] * acc[nb][1]) + (acc[nb][2] * acc[nb][2] + acc[nb][3] * acc[nb][3]); }
    ss += shx(ss, 16, lane); ss += shx(ss, 32, lane);
    const float rn = rsqrtf(ss * (1.0f / 128.0f) + opq(1e-6f));
#pragma unroll
    for (int nb = 0; nb < 8; ++nb) { bf16_t* gp = Z + (size_t)tok * HGIN + 1024 + h * 128 + 16 * nb + 4 * fq; const u32x2 gv = *(const u32x2*)gp;
        const f32x4 nw = *(const f32x4*)(normw + 16 * nb + 4 * fq);
        u32x2 wv; wv.x = cvt_pk_bf16(acc[nb][0] * rn * nw[0] * bflo(gv.x), acc[nb][1] * rn * nw[1] * bfhi(gv.x));
        wv.y = cvt_pk_bf16(acc[nb][2] * rn * nw[2] * bflo(gv.y), acc[nb][3] * rn * nw[3] * bfhi(gv.y)); *(u32x2*)gp = wv; }
}
__device__ void ctx_readout(bf16_t* Zc, const bf16_t* OLc, const float* normw) {
    const int lane = tidx() & 63, gw = bidx() * 8 + (tidx() >> 6), nw = gridDim.x * 8;
    for (int row = gw; row < MCTX; row += nw) {
        const bf16_t* op = OLc + (size_t)row * DM + lane * 16; bf16_t* gp = Zc + (size_t)row * HGIN + 1024 + lane * 16;
        const u32x4 o0 = *(const u32x4*)op, o1 = *(const u32x4*)(op + 8);
        float o[16] = {bflo(o0.x), bfhi(o0.x), bflo(o0.y), bfhi(o0.y), bflo(o0.z), bfhi(o0.z), bflo(o0.w), bfhi(o0.w), bflo(o1.x), bfhi(o1.x), bflo(o1.y), bfhi(o1.y), bflo(o1.z), bfhi(o1.z), bflo(o1.w), bfhi(o1.w)};
        float ss = 0.f;
#pragma unroll
        for (int e = 0; e < 16; ++e) ss += o[e] * o[e];
        ss += shx(ss, 1, lane); ss += shx(ss, 2, lane); ss += shx(ss, 4, lane);
        const float rn = rsqrtf(ss * (1.0f / 128.0f) + opq(1e-6f));
        const u32x4 g0 = *(const u32x4*)gp, g1 = *(const u32x4*)(gp + 8);
        const float g[16] = {bflo(g0.x), bfhi(g0.x), bflo(g0.y), bfhi(g0.y), bflo(g0.z), bfhi(g0.z), bflo(g0.w), bfhi(g0.w), bflo(g1.x), bfhi(g1.x), bflo(g1.y), bfhi(g1.y), bflo(g1.z), bfhi(g1.z), bflo(g1.w), bfhi(g1.w)};
        const float* nwp = normw + (lane & 7) * 16;
#pragma unroll
        for (int e = 0; e < 16; ++e) o[e] = o[e] * rn * nwp[e] * g[e];
        u32x4 w0, w1; w0.x = cvt_pk_bf16(o[0], o[1]); w0.y = cvt_pk_bf16(o[2], o[3]); w0.z = cvt_pk_bf16(o[4], o[5]); w0.w = cvt_pk_bf16(o[6], o[7]);
        w1.x = cvt_pk_bf16(o[8], o[9]); w1.y = cvt_pk_bf16(o[10], o[11]); w1.z = cvt_pk_bf16(o[12], o[13]); w1.w = cvt_pk_bf16(o[14], o[15]);
        *(u32x4*)gp = w0; *(u32x4*)(gp + 8) = w1;
    }
}

__device__ void sgu_mix_unit(unsigned char* smem, bf16_t* Z, int chunk, int gh, const bf16_t* wsb  , const float* bs  , const float* lng, const float* lnb) {
    float* stats = (float*)smem;
    bf16_t* la = (bf16_t*)(smem + 1024); bf16_t* lb = la + 128 * LDP;
    const int tid = tidx(), w = tid >> 6, lane = tid & 63, fr = lane & 15, fq = lane >> 4;
    const int t0 = chunk * 128;
    __syncthreads();
    for (int i = 0; i < 16; ++i) {
        const bf16_t* vr = Z + (size_t)(t0 + 16 * w + i) * SGIN + SGW + lane * 8; float x[48]; float sm = 0.f;
#pragma unroll
        for (int c = 0; c < 6; ++c) { const u32x4 v = *(const u32x4*)(vr + c * 512);
            x[c * 8 + 0] = bflo(v.x); x[c * 8 + 1] = bfhi(v.x); x[c * 8 + 2] = bflo(v.y); x[c * 8 + 3] = bfhi(v.y); x[c * 8 + 4] = bflo(v.z); x[c * 8 + 5] = bfhi(v.z); x[c * 8 + 6] = bflo(v.w); x[c * 8 + 7] = bfhi(v.w); }
#pragma unroll
        for (int e = 0; e < 48; ++e) sm += x[e];
#pragma unroll
        for (int o = 32; o >= 1; o >>= 1) sm += shx(sm, o, lane);
        const float mean = sm * (1.0f / 3072.0f); float q = 0.f;
#pragma unroll
        for (int e = 0; e < 48; ++e) { const float dd = x[e] - mean; q += dd * dd; }
#pragma unroll
        for (int o = 32; o >= 1; o >>= 1) q += shx(q, o, lane);
        if (lane == 0) { stats[(16 * w + i) * 2] = mean; stats[(16 * w + i) * 2 + 1] = rsqrtf(q * (1.0f / 3072.0f) + opq(1e-5f)); }
    }
    for (int gi = 0; gi < 4; ++gi) {
        const int g = gh * 4 + gi;
        for (int cb = 0; cb < 3; ++cb) {
            __syncthreads();
            if (cb == 0) {
#pragma unroll
                for (int i = 0; i < 4; ++i) { const int c = tid + 512 * i, r = c >> 4, k8 = (c & 15) * 8; *(u32x4*)(la + r * LDP + k8) = *(const u32x4*)(wsb + ((size_t)g * 128 + r) * 128 + k8); }
            }
            const int cg0 = g * 384 + cb * 128;
#pragma unroll
            for (int i = 0; i < 4; ++i) { const int c = tid + 512 * i, q = c >> 4, c8 = (c & 15) * 8;
                const u32x4 v = *(const u32x4*)(Z + (size_t)(t0 + q) * SGIN + SGW + cg0 + c8);
                const float mean = stats[q * 2], rstd = stats[q * 2 + 1];
                const float xv[8] = {bflo(v.x), bfhi(v.x), bflo(v.y), bfhi(v.y), bflo(v.z), bfhi(v.z), bflo(v.w), bfhi(v.w)};
                const f32x4 g0 = *(const f32x4*)(lng + cg0 + c8), g1 = *(const f32x4*)(lng + cg0 + c8 + 4), b0 = *(const f32x4*)(lnb + cg0 + c8), b1 = *(const f32x4*)(lnb + cg0 + c8 + 4);
#pragma unroll
                for (int e = 0; e < 8; ++e) { const float gg = e < 4 ? g0[e & 3] : g1[e & 3], bb = e < 4 ? b0[e & 3] : b1[e & 3];
                    lb[(c8 + e) * LDP + q] = f2bf((xv[e] - mean) * rstd * gg + bb); } }
            __syncthreads();
            f32x4 acc[8];
#pragma unroll
            for (int nb = 0; nb < 8; ++nb) acc[nb] = (f32x4){0.f, 0.f, 0.f, 0.f};
            tile_mma_128(la, lb, acc, w, fr, fq);
            const int pr = 16 * w + fr; const float bias = bs[g * 128 + pr];
#pragma unroll
            for (int nb = 0; nb < 8; ++nb) { bf16_t* up = Z + (size_t)(t0 + pr) * SGIN + cg0 + 16 * nb + 4 * fq; const u32x2 uv = *(const u32x2*)up;
                u32x2 wv; wv.x = cvt_pk_bf16(bflo(uv.x) * (acc[nb][0] + bias), bfhi(uv.x) * (acc[nb][1] + bias)); wv.y = cvt_pk_bf16(bflo(uv.y) * (acc[nb][2] + bias), bfhi(uv.y) * (acc[nb][3] + bias));
                *(u32x2*)up = wv; }
        }
    }
}

__device__ void conv_swiglu(const bf16_t* Z, bf16_t* act, const float* cw, const float* cb, int rows, int row_len) {
    const int gt = bidx() * 512 + tidx(), nt = gridDim.x * 512, total = rows * 352;
    for (int i = gt; i < total; i += nt) {
        const int t = i / 352, j8 = (i % 352) * 8, np = (j8 >> 7) * 256 + (j8 & 127), pos = t % row_len;
        const bool hasL = pos != 0, hasR = pos != row_len - 1;
        const bf16_t* zr = Z + (size_t)t * UPW + np; const u32x4 zero = (u32x4){0u, 0u, 0u, 0u};
        const u32x4 a1 = *(const u32x4*)zr, g1 = *(const u32x4*)(zr + 128);
        const u32x4 a0 = hasL ? *(const u32x4*)(zr - UPW) : zero, g0 = hasL ? *(const u32x4*)(zr - UPW + 128) : zero;
        const u32x4 a2 = hasR ? *(const u32x4*)(zr + UPW) : zero, g2 = hasR ? *(const u32x4*)(zr + UPW + 128) : zero;
        float r[8];
#pragma unroll
        for (int e = 0; e < 8; ++e) { const int j = j8 + e; const unsigned sh = (e & 1) ? 0u : 16u;
            const unsigned wa0 = e < 2 ? a0.x : e < 4 ? a0.y : e < 6 ? a0.z : a0.w, wa1 = e < 2 ? a1.x : e < 4 ? a1.y : e < 6 ? a1.z : a1.w, wa2 = e < 2 ? a2.x : e < 4 ? a2.y : e < 6 ? a2.z : a2.w;
            const unsigned wg0 = e < 2 ? g0.x : e < 4 ? g0.y : e < 6 ? g0.z : g0.w, wg1 = e < 2 ? g1.x : e < 4 ? g1.y : e < 6 ? g1.z : g1.w, wg2 = e < 2 ? g2.x : e < 4 ? g2.y : e < 6 ? g2.z : g2.w;
            const float fa0 = __uint_as_float((wa0 << sh) & 0xffff0000u), fa1 = __uint_as_float((wa1 << sh) & 0xffff0000u), fa2 = __uint_as_float((wa2 << sh) & 0xffff0000u);
            const float fg0 = __uint_as_float((wg0 << sh) & 0xffff0000u), fg1 = __uint_as_float((wg1 << sh) & 0xffff0000u), fg2 = __uint_as_float((wg2 << sh) & 0xffff0000u);
            const float av = cw[j] * fa0 + cw[UPW + j] * fa1 + cw[2 * UPW + j] * fa2 + cb[j];
            const float gv = cw[DFF + j] * fg0 + cw[UPW + DFF + j] * fg1 + cw[2 * UPW + DFF + j] * fg2 + cb[DFF + j];
            r[e] = silu_f(gv) * av; }
        u32x4 w; w.x = cvt_pk_bf16(r[0], r[1]); w.y = cvt_pk_bf16(r[2], r[3]); w.z = cvt_pk_bf16(r[4], r[5]); w.w = cvt_pk_bf16(r[6], r[7]);
        *(u32x4*)(act + (size_t)t * DFF + j8) = w;
    }
}
enum { T_NONE = 0, T_P0, T_INIT, T_GEMM_IN, T_SCAN1, T_SCAN2, T_SCAN3, T_MIX, T_GEMM_OUT, T_LN1, T_GEMM_UP, T_CONV, T_GEMM_DN, T_LN2, T_READOUT };
constexpr int NPHASES = 2 + 14 + 10 + 14 + 10;
__device__ __forceinline__ void decode_phase(int ph, int& type, int& l, int& s) {
    l = 0; s = 0;
    if (ph == 0) { type = T_P0; return; }
    if (ph == 1) { type = T_INIT; return; }
    int q = ph - 2;
    if (q < 14) l = 0; else if (q < 24) { l = 1; q -= 14; } else if (q < 38) { l = 2; q -= 24; } else { l = 3; q -= 38; }
    const int half = (l & 1) ? 3 : 5, nm = 2 * half;
    if (q < nm) { s = q / half; const int st = q % half;
        if (l & 1) type = st == 0 ? T_GEMM_IN : st == 1 ? T_MIX : T_GEMM_OUT;
        else type = st == 0 ? T_GEMM_IN : st == 1 ? T_SCAN1 : st == 2 ? T_SCAN2 : st == 3 ? T_SCAN3 : T_GEMM_OUT;
        return; }
    q -= nm;
    type = q == 0 ? T_LN1 : q == 1 ? T_GEMM_UP : q == 2 ? T_GEMM_DN : T_LN2;
}
__device__ __forceinline__ void decode_ctx(int ph, int& type, int& l) {
    const int c = ph - 2; type = T_NONE; l = 0;
    if (c < 0 || c > 18) return;
    if (c < 9) { l = 0; type = c == 0 ? T_GEMM_IN : c == 1 ? T_SCAN1 : c == 2 ? T_READOUT : c == 3 ? T_GEMM_OUT : c == 4 ? T_LN1 : c == 5 ? T_GEMM_UP : c == 6 ? T_CONV : c == 7 ? T_GEMM_DN : T_LN2; }
    else if (c < 17) { const int d = c - 9; l = 1; type = d == 0 ? T_GEMM_IN : d == 1 ? T_MIX : d == 2 ? T_GEMM_OUT : d == 3 ? T_LN1 : d == 4 ? T_GEMM_UP : d == 5 ? T_CONV : d == 6 ? T_GEMM_DN : T_LN2; }
    else { l = 2; type = c == 17 ? T_GEMM_IN : T_SCAN1; }
}
__device__ __forceinline__ bool is_gemm(int t) { return t == T_GEMM_IN || t == T_GEMM_OUT || t == T_GEMM_UP || t == T_GEMM_DN; }
__global__ __launch_bounds__(512, 2) void fwd_megakernel(Params p) {
    extern __shared__ __attribute__((aligned(16))) unsigned char smem[];
    { cg::grid_group grid = cg::this_grid(); grid.sync(); }
    unsigned char* ws0 = p.ws;
    const int nblk = gridDim.x, bid = bidx();
    unsigned char* ws = ws0;
    volatile XLAS unsigned* xst = (volatile XLAS unsigned*)((XLAS unsigned char*)smem + 131072 + 256);
    if (threadIdx.x == 0) { xst[0] = 0u; xst[1] = 0u; xst[2] = 0u; xst[3] = 0u; }
    if ((threadIdx.x & 63) == 0) *(volatile XLAS int*)((XLAS unsigned char*)smem + WTAB_OFF + 4 * hw_slot()) = (int)(threadIdx.x >> 6);
    __syncthreads();
    const XcdBarrier xb = xcd_barrier_post((unsigned*)(ws + OFF_BAR), xst);
    for (int ph = 0; ph < NPHASES; ++ph) {
        int type, l, s, ctype, cl; decode_phase(ph, type, l, s); decode_ctx(ph, ctype, cl);
        unsigned char* ws = ws0; asm volatile("" : "+s"(ws));
        const float* x = p.in[0]; const float* ctxin = p.in[2];
        float* out = p.out; asm volatile("" : "+s"(out));
        float* mod = (float*)(ws + OFF_MOD); const float* lbs = (const float*)(ws + OFF_LBS);
        bf16_t* hmod = (bf16_t*)(ws + OFF_HMOD); float* hc = (float*)(ws + OFF_HC); bf16_t* hcmod = (bf16_t*)(ws + OFF_HCMOD);
        bf16_t* Zc = (bf16_t*)(ws + OFF_ZC); bf16_t* actc = (bf16_t*)(ws + OFF_ACTC); bf16_t* OLc = (bf16_t*)(ws + OFF_OLC);
        float* Uctx = (float*)(ws + OFF_UCTX); float* Dctx = (float*)(ws + OFF_DCTX);
        unsigned char* big = ws + OFF_BIG;
        bf16_t* Zhg = (bf16_t*)(big + BIG_HG_Z); bf16_t* OL = (bf16_t*)(big + BIG_HG_OL); float* U = (float*)(big + BIG_HG_U); float* Dk = (float*)(big + BIG_HG_D);
        bf16_t* Zb = (bf16_t*)big; bf16_t* act = (bf16_t*)big;
        if (type == T_P0) {
            phase0(p, smem);
        } else if (type == T_INIT) {
            ln_mod(x, nullptr, hmod, nullptr, nullptr, false, mod + 0, mod + 1024, MLAT, SEQ, 0);
            ln_mod(ctxin, nullptr, hcmod, nullptr, nullptr, false, mod + 0, mod + 1024, MCTX, 1 << 30, 4);
        }
        if (is_gemm(type) || is_gemm(ctype)) {
            GemmJob j; j.e.kind = 0; j.e.O = nullptr; j.e.ldc = 0; j.e.mode = 0; j.e.silu_tiles = 0; j.e.hin = nullptr; j.e.out = nullptr; j.e.gate = nullptr; j.e.b0 = 0; j.e.ctx = 0;
            j.A = nullptr; j.Bt = nullptr; j.lda = 0; j.M = 0; j.N = 0; j.K = 0;
            for (int job = 0; job < 2; ++job) {
                const bool c = job == 1; const int t = c ? ctype : type, ll = c ? cl : l;
                if (!is_gemm(t)) continue;
                const int kind = ll & 1, idx = ll >> 1; const float* modl = mod + (size_t)ll * 5 * 6144;
                const float* hin = (ll == 0) ? x : out; const float* hcin = (ll == 0) ? ctxin : hc;
                if (t == T_GEMM_IN) {
                    j.A = c ? hcmod : hmod + (size_t)s * SLAB * DM; j.lda = DM; j.K = DM; j.M = c ? MCTX : SLAB; j.e.kind = 0;
                    if (kind == 0) { j.Bt = (const bf16_t*)(ws + OFF_WT_HGIN) + (size_t)idx * HGIN * DM; j.N = HGIN; j.e.O = c ? Zc : Zhg; j.e.ldc = HGIN; j.e.mode = 1; j.e.silu_tiles = 8; }
                    else { j.Bt = (const bf16_t*)(ws + OFF_WT_SGIN) + (size_t)idx * SGIN * DM; j.N = SGIN; j.e.O = c ? Zc : Zb; j.e.ldc = SGIN; j.e.mode = 2; j.e.silu_tiles = 0; }
                } else if (t == T_GEMM_OUT) {
                    j.M = c ? MCTX : SLAB; j.N = DM; j.e.kind = 1; j.e.hin = c ? hcin : hin + (size_t)s * SLAB * DM; j.e.out = c ? hc : out + (size_t)s * SLAB * DM; j.e.gate = modl + 2048; j.e.b0 = s * 2; j.e.ctx = c ? 1 : 0;
                    if (kind == 0) { j.A = (c ? Zc : Zhg) + 1024; j.lda = HGIN; j.K = DM; j.Bt = (const bf16_t*)(ws + OFF_WT_HGOUT) + (size_t)idx * DM * DM; }
                    else { j.A = c ? Zc : Zb; j.lda = SGIN; j.K = SGW; j.Bt = (const bf16_t*)(ws + OFF_WT_SGOUT) + (size_t)idx * DM * SGW; }
                } else if (t == T_GEMM_UP) {
                    j.A = c ? hcmod : hmod; j.lda = DM; j.K = DM; j.M = c ? MCTX : MLAT; j.N = UPW; j.Bt = (const bf16_t*)(ws + OFF_WT_UP) + (size_t)ll * UPW * DM;
                    if (c) { j.e.kind = 0; j.e.O = Zc; j.e.ldc = UPW; j.e.mode = 0; j.e.silu_tiles = 0; }
                    else { j.e.kind = 2; j.e.O = act; j.e.ldc = DFF; j.e.hin = p.in[19] + (size_t)ll * 3 * UPW; j.e.gate = p.in[20] + (size_t)ll * UPW; }
                } else {
                    j.A = c ? actc : act; j.lda = DFF; j.K = DFF; j.M = c ? MCTX : MLAT; j.N = DM; j.Bt = (const bf16_t*)(ws + OFF_WT_DOWN) + (size_t)ll * DM * DFF;
                    j.e.kind = 1; j.e.hin = c ? hc : out; j.e.out = c ? hc : out; j.e.gate = modl + 5120; j.e.b0 = 0; j.e.ctx = c ? 1 : 0;
                }
#ifndef NO_GEMM
                gemm_call(smem, j);
#endif
            }
        }
        {
            const int idx = l >> 1; const float* modl = mod + (size_t)l * 5 * 6144;
            const float* lbf = lbs + (0 * 2 + idx) * 1024; const float* lbb = lbs + (1 * 2 + idx) * 1024; const float* normw = p.in[10] + idx * 128;
            if (type == T_SCAN1 || ctype == T_SCAN1) {
                const int cidx = cl >> 1;
                const int n0 = type == T_SCAN1 ? 256 : 0, nu = n0 + (ctype == T_SCAN1 ? 32 : 0);
                for (int u = bid; u < nu; u += nblk) {
                    bf16_t* Zp; bf16_t* OLp; float *Uf, *Ub, *Df, *Db; int T, h; const float *lf, *lb2;
                    if (u < n0) { const int bl = u >> 7, sc = u & 15; h = (u >> 4) & 7; const size_t t0 = (size_t)bl * SEQ + sc * 512; const int sq = (bl * 8 + h) * 2; T = 512; lf = lbf; lb2 = lbb;
                        Zp = Zhg + t0 * HGIN; OLp = OL + t0 * DM; Uf = U + ((size_t)(sq + 0) * 16 + sc) * 16384; Ub = U + ((size_t)(sq + 1) * 16 + sc) * 16384; Df = Dk + ((sq + 0) * 16 + sc) * 128; Db = Dk + ((sq + 1) * 16 + sc) * 128; }
                    else { const int uc = u - n0, b = uc >> 3; h = uc & 7; const int sq = (b * 8 + h) * 2; T = CTXL; lf = lbs + (0 * 2 + cidx) * 1024; lb2 = lbs + (1 * 2 + cidx) * 1024;
                        Zp = Zc + (size_t)b * CTXL * HGIN; OLp = OLc + (size_t)b * CTXL * DM; Uf = Uctx + (size_t)(sq + 0) * 16384; Ub = Uctx + (size_t)(sq + 1) * 16384; Df = Dctx + (sq + 0) * 128; Db = Dctx + (sq + 1) * 128; }
#ifndef NO_SCAN1
                    scan_unit(smem, Zp, T, h, lf, lb2, OLp, Uf, Ub, Df, Db);
#endif
                }
            }
            if (type == T_SCAN2) {
#ifndef NO_SCAN2
                scan_pass2(U, Dk, Uctx, s);
#endif
            } else if (type == T_SCAN3) {
#ifndef NO_SCAN3
                for (int u = bid; u < 1024; u += nblk) scan_pass3_unit(smem, Zhg, OL, U, normw, u >> 9, (u >> 6) & 7, u & 63);
#endif
            }
            if (type == T_MIX || ctype == T_MIX) {
                const int n0 = type == T_MIX ? 256 : 0, nu = n0 + (ctype == T_MIX ? 16 : 0);
                for (int u = bid; u < nu; u += nblk) { const bool c = u >= n0; const int uu = c ? u - n0 : u; const int ix = (c ? cl : l) >> 1;
                    const bf16_t* wsb = (const bf16_t*)(ws + OFF_WS_B) + (size_t)ix * 8 * 128 * 128;
#ifndef NO_MIX
                    sgu_mix_unit(smem, c ? Zc : Zb, uu >> 1, uu & 1, wsb, p.in[16] + ix * 8 * 128, p.in[13] + ix * SGW, p.in[14] + ix * SGW);
#endif
                }
            }
            if (type == T_LN1 || type == T_LN2) {
                const int which = type == T_LN1 ? 0 : 1;
                const float* modn = type == T_LN1 ? modl + 3072 : mod + (size_t)(l + 1) * 5 * 6144;
                const bool want_mod = type == T_LN1 || l < 3;
                ln_mod(out, out, want_mod ? hmod : nullptr, p.in[6] + (l * 2 + which) * DM, p.in[7] + (l * 2 + which) * DM, true, modn + 0, modn + 1024, MLAT, SEQ, 0);
            }
        }
        if (ctype == T_READOUT) {
#ifndef NO_CTXR
            ctx_readout(Zc, OLc, p.in[10]);
#endif
        } else if (ctype == T_CONV) {
#ifndef NO_CONV
            conv_swiglu(Zc, actc, p.in[19] + (size_t)cl * 3 * UPW, p.in[20] + (size_t)cl * UPW, MCTX, CTXL);
#endif
        } else if (ctype == T_LN1 || ctype == T_LN2) {
            const int which = ctype == T_LN1 ? 0 : 1;
            const float* modn = ctype == T_LN1 ? mod + (size_t)cl * 5 * 6144 + 3072 : mod + (size_t)(cl + 1) * 5 * 6144;
            ln_mod(hc, hc, hcmod, p.in[6] + (cl * 2 + which) * DM, p.in[7] + (cl * 2 + which) * DM, true, modn + 0, modn + 1024, MCTX, 1 << 30, 4);
        }
        if (ph + 1 < NPHASES) xcd_barrier(xb);
    }
}

extern "C" void kernel_launch(void* const* d_in, const int* in_sizes, int n_in, void* d_out, int out_size, void* d_ws, size_t ws_size, hipStream_t stream) {
    static int grid_blocks = 0;
    if (!grid_blocks) {
        int dev = 0, cus = 0, per_cu = 0;
        hipGetDevice(&dev);
        hipDeviceGetAttribute(&cus, hipDeviceAttributeMultiprocessorCount, dev);
        hipFuncSetAttribute((const void*)fwd_megakernel, hipFuncAttributeMaxDynamicSharedMemorySize, LDS_BYTES);
        hipOccupancyMaxActiveBlocksPerMultiprocessor(&per_cu, (const void*)fwd_megakernel, 512, LDS_BYTES);
        if (per_cu < 1) per_cu = 1;
        grid_blocks = cus * per_cu;
        (void)hipGetLastError();
    }
    if (n_in != 22 || ws_size < WS_END) { fprintf(stderr, "kernel_launch: unexpected inputs (n_in %d, ws %zu < %zu)\n", n_in, ws_size, (size_t)WS_END); return; }
    (void)hipMemsetAsync((unsigned char*)d_ws + OFF_BAR, 0, (size_t)XCD_BAR_WORDS * 4, stream);
    Params p{};
    for (int i = 0; i < 22; ++i) p.in[i] = (const float*)d_in[i];
    p.out = (float*)d_out; p.ws = (unsigned char*)d_ws;
    void* args[] = {&p};
    hipError_t e = hipLaunchCooperativeKernel((const void*)fwd_megakernel, dim3(grid_blocks), dim3(512), args, LDS_BYTES, stream);
    if (e != hipSuccess) fprintf(stderr, "cooperative launch failed: %s (grid %d)\n", hipGetErrorString(e), grid_blocks);
}
```

```cpp
#include <hip/hip_runtime.h>
#include <hip/hip_cooperative_groups.h>
#include <cstdio>
namespace cg = cooperative_groups;

typedef unsigned short bf16_t;
typedef short bf16x8 __attribute__((ext_vector_type(8)));
typedef float f32x4 __attribute__((ext_vector_type(4)));
typedef float f32x2 __attribute__((ext_vector_type(2)));
typedef unsigned u32x4 __attribute__((ext_vector_type(4)));
typedef unsigned u32x2 __attribute__((ext_vector_type(2)));

__device__ __forceinline__ unsigned cvt_pk_bf16(float lo, float hi) { unsigned r; asm volatile("v_cvt_pk_bf16_f32 %0, %1, %2" : "=v"(r) : "v"(lo), "v"(hi)); return r; }
__device__ __forceinline__ bf16_t f2bf(float f) { return (bf16_t)(cvt_pk_bf16(f, 0.f) & 0xffffu); }
__device__ __forceinline__ float bf2f(bf16_t b) { return __uint_as_float(((unsigned)b) << 16); }
__device__ __forceinline__ float bflo(unsigned w) { return __uint_as_float(w << 16); }
__device__ __forceinline__ float bfhi(unsigned w) { return __uint_as_float(w & 0xffff0000u); }
__device__ __forceinline__ float silu_f(float v) { return v * __builtin_amdgcn_rcpf(1.0f + __expf(-v)); }
__device__ __forceinline__ float sigmoid_f(float v) { return __builtin_amdgcn_rcpf(1.0f + __expf(-v)); }
__device__ __forceinline__ f32x2 gelu_pk(f32x2 v) {
    const f32x2 av = __builtin_elementwise_abs(v), d = av * 0.2316418882f + 1.0f;
    f32x2 t; t.x = __builtin_amdgcn_rcpf(d.x); t.y = __builtin_amdgcn_rcpf(d.y);
    f32x2 q = t * 0.5307027145f + (-0.7265760135f); q = q * t + 0.7107068705f; q = q * t + (-0.142248368f); q = q * t + 0.127414796f; q = q * t;
    const f32x2 s = (v * v) * (-0.72134752044f);
    f32x2 e; e.x = __builtin_amdgcn_exp2f(s.x); e.y = __builtin_amdgcn_exp2f(s.y);
    const f32x2 m = v * (q * e), r = v - m;
    f32x2 o; o.x = v.x < 0.f ? m.x : r.x; o.y = v.y < 0.f ? m.y : r.y; return o;
}

constexpr int WTAB_OFF = 131072 + 512;
__device__ __forceinline__ int hw_slot() { return (int)(__builtin_amdgcn_s_getreg((5 << 11) | 4) & 0x3fu); }
__device__ __forceinline__ int tidx() {
    extern __shared__ __attribute__((aligned(16))) unsigned char smem_t[];
    const int w = *(volatile __attribute__((address_space(3))) int*)((__attribute__((address_space(3))) unsigned char*)smem_t + WTAB_OFF + 4 * hw_slot());
    int lane; asm volatile("v_mbcnt_lo_u32_b32 %0, -1, 0\n\tv_mbcnt_hi_u32_b32 %0, -1, %0" : "=v"(lane));
    return __builtin_amdgcn_readfirstlane(w) * 64 + lane; }
__device__ __forceinline__ int bidx() { int b = blockIdx.x; asm volatile("" : "+s"(b)); return b; }


#define XB_TMO      128
#define XB_XCNT(j)  (256  + 64 * (j))
#define XB_XSUB(j)  (1280 + 64 * (j))
#define XB_XGEN(j)  (2304 + 64 * (j))
#define XB_TOP      3328
#define XB_TOPGEN   3392
#define XCD_BAR_WORDS 3456
#define XB_SPIN_CAP (1u << 20)
#define XLAS __attribute__((address_space(3)))
__device__ __forceinline__ unsigned xb_ld(unsigned* p)              { return __hip_atomic_load(p, __ATOMIC_RELAXED, __HIP_MEMORY_SCOPE_AGENT); }
__device__ __forceinline__ unsigned xb_add(unsigned* p, unsigned v) { return __hip_atomic_fetch_add(p, v, __ATOMIC_RELAXED, __HIP_MEMORY_SCOPE_AGENT); }
__device__ __forceinline__ unsigned xb_xcc_id() { return (unsigned)__builtin_amdgcn_s_getreg((3 << 11) | 20) & 0xFu; }
#define XB_SPIN(cond, bar) do { unsigned _sp = 0; while (cond) { __builtin_amdgcn_s_sleep(1); \
    if ((++_sp & 255u) == 0u) { if (xb_ld(&(bar)[XB_TMO])) break; if (_sp > XB_SPIN_CAP) { atomicAdd(&(bar)[XB_TMO], 1u); break; } } } } while (0)
struct XcdBarrier { unsigned* bar; unsigned x; volatile XLAS unsigned* st; };
__device__ __forceinline__ XcdBarrier xcd_barrier_post(unsigned* bar, volatile XLAS unsigned* st) {
    XcdBarrier b; b.bar = bar; b.x = xb_xcc_id(); b.st = st;
    if (threadIdx.x == 0) (void)xb_add(&bar[XB_XCNT(b.x)], 1u);
    return b;
}
__device__ __forceinline__ void xcd_barrier_complete(unsigned* bar, unsigned x, unsigned& nloc, unsigned& nx) {
    const unsigned G = gridDim.x * gridDim.y * gridDim.z;
    unsigned sum, cnt, mine, sp = 0u;
    for (;;) {
        sum = 0u; cnt = 0u; mine = 0u;
#pragma unroll
        for (unsigned j = 0; j < 16; ++j) { const unsigned c = xb_ld(&bar[XB_XCNT(j)]); sum += c; cnt += (c > 0u) ? 1u : 0u; mine = (j == x) ? c : mine; }
        if (sum == G) break;
        __builtin_amdgcn_s_sleep(1);
        if ((++sp & 255u) == 0u) { if (xb_ld(&bar[XB_TMO])) break; if (sp > XB_SPIN_CAP) { atomicAdd(&bar[XB_TMO], 1u); break; } }
    }
    nloc = mine > 0u ? mine : 1u; nx = cnt > 0u ? cnt : 1u;
}
__device__ __forceinline__ void xcd_barrier(const XcdBarrier& b) {
    asm volatile("s_waitcnt vmcnt(0)" ::: "memory");
    __syncthreads();
    if (tidx() == 0) {
        unsigned* bar = b.bar; asm volatile("" : "+s"(bar));
        __builtin_amdgcn_s_waitcnt(0);
        unsigned nloc = b.st[0], nx = b.st[1];
        if (nloc == 0u) { xcd_barrier_complete(bar, b.x, nloc, nx); b.st[0] = nloc; b.st[1] = nx; }
        const unsigned old = xb_add(&bar[XB_XSUB(b.x)], 1u);
        const unsigned gen = old / nloc;
        if (old + 1u == (gen + 1u) * nloc) {
            __builtin_amdgcn_fence(__ATOMIC_RELEASE, "agent");
            asm volatile("s_waitcnt vmcnt(0)" ::: "memory");
            const unsigned og = xb_add(&bar[XB_TOP], 1u);
            const unsigned tg = og / nx;
            if (og + 1u == (tg + 1u) * nx) xb_add(&bar[XB_TOPGEN], 1u);
            else XB_SPIN(xb_ld(&bar[XB_TOPGEN]) == tg, bar);
            __builtin_amdgcn_fence(__ATOMIC_ACQUIRE, "agent");
            xb_add(&bar[XB_XGEN(b.x)], 1u);
            asm volatile("s_waitcnt vmcnt(0)" ::: "memory");
        } else {
            XB_SPIN(xb_ld(&bar[XB_XGEN(b.x)]) == gen, bar);
            __builtin_amdgcn_fence(__ATOMIC_ACQUIRE, "agent");
            asm volatile("s_waitcnt vmcnt(0)" ::: "memory");
        }
    }
    __syncthreads();
}

__device__ __forceinline__ float shx(float v, int o, int lane) { return __int_as_float(__builtin_amdgcn_ds_bpermute((lane ^ o) << 2, __float_as_int(v))); }
__device__ __forceinline__ float opq(float c) { asm volatile("" : "+s"(c)); return c; }

constexpr int DM = 1024, NB = 4, SEQ = 8192, CTXL = 256, MLAT = NB * SEQ, MCTX = NB * CTXL;
constexpr int HGIN = 5120, SGW = 3072, SGIN = 6144, DFF = 2816, UPW = 5632;
constexpr int SLAB = 16384;
constexpr float ALPHA_F = 1.6817928305074292f;
constexpr int LDP = 136;

constexpr size_t al256(size_t x) { return (x + 255) & ~(size_t)255; }
constexpr size_t OFF_WT_HGIN = 0;
constexpr size_t OFF_WT_HGOUT = OFF_WT_HGIN + al256((size_t)2 * HGIN * DM * 2);
constexpr size_t OFF_WT_SGIN = OFF_WT_HGOUT + al256((size_t)2 * DM * DM * 2);
constexpr size_t OFF_WT_SGOUT = OFF_WT_SGIN + al256((size_t)2 * SGIN * DM * 2);
constexpr size_t OFF_WT_UP = OFF_WT_SGOUT + al256((size_t)2 * DM * SGW * 2);
constexpr size_t OFF_WT_DOWN = OFF_WT_UP + al256((size_t)4 * UPW * DM * 2);
constexpr size_t OFF_WS_B = OFF_WT_DOWN + al256((size_t)4 * DM * DFF * 2);
constexpr size_t OFF_MOD = OFF_WS_B + al256((size_t)2 * 8 * 128 * 128 * 2);
constexpr size_t OFF_LBS = OFF_MOD + al256((size_t)4 * 5 * 6144 * 4);
constexpr size_t OFF_HMOD = OFF_LBS + al256((size_t)2 * 2 * 1024 * 4);
constexpr size_t OFF_HC = OFF_HMOD + al256((size_t)MLAT * DM * 2);
constexpr size_t OFF_HCMOD = OFF_HC + al256((size_t)MCTX * DM * 4);
constexpr size_t OFF_ZC = OFF_HCMOD + al256((size_t)MCTX * DM * 2);
constexpr size_t OFF_ACTC = OFF_ZC + al256((size_t)MCTX * SGIN * 2);
constexpr size_t OFF_OLC = OFF_ACTC + al256((size_t)MCTX * DFF * 2);
constexpr size_t OFF_UCTX = OFF_OLC + al256((size_t)MCTX * DM * 2);
constexpr size_t OFF_DCTX = OFF_UCTX + al256((size_t)NB * 8 * 2 * 16384 * 4);
constexpr size_t OFF_BAR = OFF_DCTX + al256((size_t)NB * 8 * 2 * 128 * 4);
constexpr size_t OFF_BIG = OFF_BAR + al256((size_t)XCD_BAR_WORDS * 4);
constexpr size_t BIG_HG_Z = 0;
constexpr size_t BIG_HG_OL = BIG_HG_Z + (size_t)SLAB * HGIN * 2;
constexpr size_t BIG_HG_U = BIG_HG_OL + (size_t)SLAB * DM * 2;
constexpr size_t BIG_HG_D = BIG_HG_U + (size_t)32 * 16 * 16384 * 4;
constexpr size_t BIG_HG_END = BIG_HG_D + (size_t)32 * 16 * 128 * 4;
constexpr size_t BIG_FF_ACT = (size_t)SLAB * UPW * 2;
constexpr size_t BIG_FF_END = BIG_FF_ACT + (size_t)SLAB * DFF * 2;
constexpr size_t BIG_SG_END = (size_t)SLAB * SGIN * 2;
constexpr size_t BIG_BYTES = BIG_FF_END > BIG_HG_END ? (BIG_FF_END > BIG_SG_END ? BIG_FF_END : BIG_SG_END) : (BIG_HG_END > BIG_SG_END ? BIG_HG_END : BIG_SG_END);
constexpr size_t WS_END = OFF_BIG + BIG_BYTES;
static_assert(WS_END <= (size_t)536870912, "workspace map exceeds the guaranteed 512 MiB");
constexpr int LDS_BYTES = 144 * 1024;

struct Params { const float* in[22]; float* out; unsigned char* ws; };
namespace pg8 {
#define PG8_LAS __attribute__((address_space(3)))
constexpr int BM = 256, BK = 64, HALF = 128, HTB = HALF * BK * 2, STAGE_BYTES = 8 * HTB, NXCD = 8, WGM = 8;
__host__ __device__ __forceinline__ int lds_byte(int r, int c) { const int st = (r >> 4) * 2 + (c >> 5), rr = r & 15, cc = c & 31, ob = rr * 64 + cc * 2; return st * 1024 + (ob ^ (((ob >> 9) & 1) << 5)); }
__host__ __device__ __forceinline__ void stage_rc(int b, int& R, int& C) { const int st = b / 1024, sb = b % 1024, swz = sb ^ (((sb >> 9) & 1) << 5); R = (st >> 1) * 16 + swz / 64; C = (st & 1) * 32 + (swz % 64) / 2; }
__host__ __device__ __forceinline__ int perm32(int rho) { const int n = rho >> 4, i = rho & 15; return 8 * (i >> 2) + 4 * n + (i & 3); }
struct Unit { int pm, pn; };
struct Gemm { const bf16_t* A; const bf16_t* Bt; int M, N, K, lda; };
struct StaticOrder {
    int nM, nN, nwg, G, c;
    __device__ void init(int M, int N, int G_, int c_) { nM = M / BM; nN = N / BM; nwg = nM * nN; G = G_; c = c_; }
    __device__ bool next(int i, Unit& u) const {
        const long L = (long)i * G + c; if (L >= nwg) return false;
        int wgid = (int)L; { const int q = nwg / NXCD, r = nwg % NXCD, xcd = wgid % NXCD, off = wgid / NXCD; wgid = (xcd < r ? xcd * (q + 1) : r * (q + 1) + (xcd - r) * q) + off; }
        const int nig = WGM * nN, gid = wgid / nig, fm = gid * WGM, gsz = (nM - fm) < WGM ? (nM - fm) : WGM;
        u.pm = fm + ((wgid % nig) % gsz); u.pn = (wgid % nig) / gsz; return true;
    }
};
template <class Epi>
__device__ __forceinline__ void gemm_phase(PG8_LAS unsigned char* lds, const Gemm g, const StaticOrder& S, const Epi& E) {
    const bool perm = E.perm();
    const int tid = tidx(), wid = __builtin_amdgcn_readfirstlane(tid >> 6), lane = tid & 63, wr = wid >> 2, wc = wid & 3, fr = lane & 15, fq = lane >> 4;
    const int K = g.K, nt = K / BK, lda = g.lda;
    unsigned voffA[2], voffB[2];
#pragma unroll
    for (int i = 0; i < 2; ++i) { int R, C; stage_rc(tid * 16 + i * 8192, R, C); const int Rb = perm ? ((R & ~31) + perm32(R & 31)) : R;
        voffA[i] = (unsigned)(R * lda + C) * 2u; voffB[i] = (unsigned)(Rb * K + C) * 2u; }
    const size_t kstep = (size_t)(BK * 2);
    const size_t hstepA = (size_t)HALF * lda * 2, hstepB = (size_t)HALF * K * 2;
    const size_t tstepA = 2 * hstepA, tstepB = 2 * hstepB;
    const unsigned ldsw = (unsigned)wid * 1024u;
    const int aoff = lds_byte(wr * 64 + fr, fq * 8), boff = lds_byte(wc * 32 + fr, fq * 8);
#define PG8_SA(b, h) (((b) * 2 + (h)) * HTB)
#define PG8_SB(b, h) ((4 + (b) * 2 + (h)) * HTB)
#define PG8_R64_voffA r64A
#define PG8_R64_voffB r64B
#define PG8_R64(v) PG8_R64_##v
#define PG8_STAGE(bufoff, gbase, voff) do { _Pragma("unroll") for (int _i = 0; _i < 2; ++_i) \
        __builtin_amdgcn_global_load_lds((const unsigned*)((const char*)(gbase) + (voff)[_i]), (PG8_LAS unsigned*)(lds + (bufoff) + ldsw + _i * 8192), 16, 0, 0); } while (0)
#define PG8_LDA(dst, b, h) do { _Pragma("unroll") for (int m = 0; m < 4; ++m) _Pragma("unroll") for (int k = 0; k < 2; ++k) dst[m][k] = *(const PG8_LAS bf16x8*)(lds + PG8_SA(b, h) + aoff + m * 2048 + k * 1024); } while (0)
#define PG8_LDB(dst, b, h) do { _Pragma("unroll") for (int n = 0; n < 2; ++n) _Pragma("unroll") for (int k = 0; k < 2; ++k) dst[n][k] = *(const PG8_LAS bf16x8*)(lds + PG8_SB(b, h) + boff + n * 2048 + k * 1024); } while (0)
#define PG8_MMA(ai, bj, At, Bt) do { __builtin_amdgcn_s_setprio(1); _Pragma("unroll") for (int m = 0; m < 4; ++m) _Pragma("unroll") for (int n = 0; n < 2; ++n) _Pragma("unroll") for (int k = 0; k < 2; ++k) \
        acc[ai][bj][m][n] = __builtin_amdgcn_mfma_f32_16x16x32_bf16(Bt[n][k], At[m][k], acc[ai][bj][m][n], 0, 0, 0); __builtin_amdgcn_s_setprio(0); } while (0)
#define PG8_WAIT_V(n) asm volatile("s_waitcnt vmcnt(" #n ")" ::: "memory")
#define PG8_WAIT_L(n) asm volatile("s_waitcnt lgkmcnt(" #n ")" ::: "memory")
#define PG8_BAR __builtin_amdgcn_s_barrier()
#define PG8_SCHED __builtin_amdgcn_sched_barrier(0)
    Unit cur, nxt; int ui = 0;
    if (!S.next(0, cur)) return;
    f32x4 acc[2][2][4][2];
#pragma unroll
    for (int a = 0; a < 2; ++a)
#pragma unroll
        for (int b = 0; b < 2; ++b)
#pragma unroll
            for (int m = 0; m < 4; ++m)
#pragma unroll
                for (int n = 0; n < 2; ++n) acc[a][b][m][n] = (f32x4){0.f, 0.f, 0.f, 0.f};
    bf16x8 At[4][2], B0[2][2], B1[2][2];
    const char* cA = (const char*)g.A + (size_t)cur.pm * tstepA; const char* cB = (const char*)g.Bt + (size_t)cur.pn * tstepB;
    PG8_STAGE(PG8_SB(0, 0), cB, voffB); PG8_STAGE(PG8_SA(0, 0), cA, voffA); PG8_STAGE(PG8_SB(0, 1), cB + hstepB, voffB); PG8_STAGE(PG8_SA(0, 1), cA + hstepA, voffA);
    if (wr == 1) PG8_BAR;
    PG8_WAIT_V(4); PG8_BAR;
    PG8_STAGE(PG8_SB(1, 0), cB + kstep, voffB); PG8_STAGE(PG8_SA(1, 0), cA + kstep, voffA); PG8_STAGE(PG8_SB(1, 1), cB + hstepB + kstep, voffB);
    PG8_WAIT_V(6); PG8_BAR;
    for (;;) {
        const bool has_next = S.next(ui + 1, nxt);
        const char* nA = has_next ? (const char*)g.A + (size_t)nxt.pm * tstepA : cA; const char* nB = has_next ? (const char*)g.Bt + (size_t)nxt.pn * tstepB : cB;
        for (int t = 0; t < nt; t += 2) {
            const bool last = (t == nt - 2);
            const char* a1 = cA + (size_t)(t + 1) * kstep;
            const char* a2 = last ? nA : cA + (size_t)(t + 2) * kstep; const char* b2 = last ? nB : cB + (size_t)(t + 2) * kstep;
            const char* a3 = a2 + kstep; const char* b3 = b2 + kstep;
            PG8_LDB(B0, 0, 0); PG8_SCHED; PG8_LDA(At, 0, 0); PG8_STAGE(PG8_SA(1, 1), a1 + hstepA, voffA);
            PG8_WAIT_L(8); PG8_BAR; PG8_WAIT_L(0); PG8_MMA(0, 0, At, B0); PG8_BAR; PG8_SCHED;
            PG8_LDB(B1, 0, 1); PG8_STAGE(PG8_SB(0, 0), b2, voffB);
            PG8_BAR; PG8_WAIT_L(0); PG8_MMA(0, 1, At, B1); PG8_BAR;
            PG8_LDA(At, 0, 1); PG8_STAGE(PG8_SA(0, 0), a2, voffA);
            PG8_BAR; PG8_WAIT_L(0); PG8_MMA(1, 0, At, B0); PG8_BAR; PG8_SCHED;
            PG8_STAGE(PG8_SB(0, 1), b2 + hstepB, voffB);
            PG8_WAIT_V(6); PG8_BAR; PG8_MMA(1, 1, At, B1); PG8_BAR;
            PG8_LDB(B0, 1, 0); PG8_SCHED; PG8_LDA(At, 1, 0); PG8_STAGE(PG8_SA(0, 1), a2 + hstepA, voffA);
            PG8_WAIT_L(8); PG8_BAR; PG8_WAIT_L(0); PG8_MMA(0, 0, At, B0); PG8_BAR; PG8_SCHED;
            PG8_LDB(B1, 1, 1); PG8_STAGE(PG8_SB(1, 0), b3, voffB);
            PG8_BAR; PG8_WAIT_L(0); PG8_MMA(0, 1, At, B1); PG8_BAR;
            PG8_LDA(At, 1, 1); PG8_STAGE(PG8_SA(1, 0), a3, voffA);
            PG8_BAR; PG8_WAIT_L(0); PG8_MMA(1, 0, At, B0); PG8_BAR; PG8_SCHED;
            PG8_STAGE(PG8_SB(1, 1), b3 + hstepB, voffB);
            PG8_WAIT_V(6); PG8_BAR; PG8_MMA(1, 1, At, B1); PG8_BAR;
        }
        E(acc, cur, wr, wc, fr, fq);
        if (!has_next) break;
#pragma unroll
        for (int a = 0; a < 2; ++a)
#pragma unroll
            for (int b = 0; b < 2; ++b)
#pragma unroll
                for (int m = 0; m < 4; ++m)
#pragma unroll
                    for (int n = 0; n < 2; ++n) acc[a][b][m][n] = (f32x4){0.f, 0.f, 0.f, 0.f};
        cur = nxt; cA = nA; cB = nB; ++ui;
    }
    PG8_WAIT_V(0);
    if (wr == 0) PG8_BAR;
    PG8_BAR;
#undef PG8_SA
#undef PG8_SB
#undef PG8_STAGE
#undef PG8_LDA
#undef PG8_LDB
#undef PG8_MMA
#undef PG8_WAIT_V
#undef PG8_WAIT_L
#undef PG8_BAR
#undef PG8_SCHED
}
}
struct EpiAny {
    int kind;
    bf16_t* O; int ldc; int mode; int silu_tiles;
    const float* hin; float* out; const float* gate; int b0; int ctx;
    __device__ __forceinline__ bool perm() const { return kind != 1; }
    __device__ __forceinline__ void operator()(const f32x4 (&acc)[2][2][4][2], const pg8::Unit& u, int wr, int wc, int fr, int fq) const {
        if (kind == 0) {
            const int row0 = u.pm * 256 + wr * 64 + fr, col0 = u.pn * 256 + wc * 32 + 8 * fq;
            const bool do_silu = (mode == 1) && (u.pn < silu_tiles);
#pragma unroll
            for (int ai = 0; ai < 2; ++ai)
#pragma unroll
                for (int m = 0; m < 4; ++m) { bf16_t* rowp = O + (size_t)(row0 + ai * 128 + m * 16) * ldc + col0;
#pragma unroll
                    for (int bj = 0; bj < 2; ++bj) { f32x4 v0 = acc[ai][bj][m][0], v1 = acc[ai][bj][m][1];
                        if (mode == 2) { f32x2 a = gelu_pk((f32x2){v0[0], v0[1]}), b = gelu_pk((f32x2){v0[2], v0[3]}), c = gelu_pk((f32x2){v1[0], v1[1]}), d = gelu_pk((f32x2){v1[2], v1[3]});
                            v0 = (f32x4){a.x, a.y, b.x, b.y}; v1 = (f32x4){c.x, c.y, d.x, d.y}; }
                        else if (do_silu) {
#pragma unroll
                            for (int j = 0; j < 4; ++j) { v0[j] = silu_f(v0[j]); v1[j] = silu_f(v1[j]); } }
                        u32x4 w; w.x = cvt_pk_bf16(v0[0], v0[1]); w.y = cvt_pk_bf16(v0[2], v0[3]); w.z = cvt_pk_bf16(v1[0], v1[1]); w.w = cvt_pk_bf16(v1[2], v1[3]);
                        *(u32x4*)(rowp + bj * 128) = w; }
                    asm volatile("" ::: "memory"); }
        } else if (kind == 2) {
            const float* cw = hin; const float* cb = gate;
            const bool first = fr == 0, lastl = fr == 15;
#pragma unroll 1
            for (int n = 0; n < 2; ++n) {
                const int j0 = u.pn * 128 + wc * 32 + 8 * fq + 4 * n;
                f32x4 wa[3], wg[3], ba, bg;
#pragma unroll
                for (int k = 0; k < 3; ++k) { wa[k] = *(const f32x4*)(cw + k * UPW + j0); wg[k] = *(const f32x4*)(cw + k * UPW + DFF + j0); }
                ba = *(const f32x4*)(cb + j0); bg = *(const f32x4*)(cb + DFF + j0);
#pragma unroll
                for (int ai = 0; ai < 2; ++ai) {
                    float res[4][4];
#pragma unroll
                    for (int e = 0; e < 4; ++e) {
                        float ya[4], yg[4];
#pragma unroll
                        for (int m = 0; m < 4; ++m) { ya[m] = n == 0 ? acc[ai][0][m][0][e] : acc[ai][0][m][1][e]; yg[m] = n == 0 ? acc[ai][1][m][0][e] : acc[ai][1][m][1][e]; }
#pragma unroll
                        for (int m = 0; m < 4; ++m) {
                            const float pa = m > 0 ? ya[m - 1] : 0.f, na = m < 3 ? ya[m + 1] : 0.f, pg = m > 0 ? yg[m - 1] : 0.f, ng = m < 3 ? yg[m + 1] : 0.f;
                            const float la = __int_as_float(__builtin_amdgcn_update_dpp(0, __float_as_int(lastl ? pa : ya[m]), 0x121, 0xf, 0xf, false));
                            const float ra = __int_as_float(__builtin_amdgcn_update_dpp(0, __float_as_int(first ? na : ya[m]), 0x12F, 0xf, 0xf, false));
                            const float lg = __int_as_float(__builtin_amdgcn_update_dpp(0, __float_as_int(lastl ? pg : yg[m]), 0x121, 0xf, 0xf, false));
                            const float rg = __int_as_float(__builtin_amdgcn_update_dpp(0, __float_as_int(first ? ng : yg[m]), 0x12F, 0xf, 0xf, false));
                            const float av = wa[0][e] * la + wa[1][e] * ya[m] + wa[2][e] * ra + ba[e];
                            const float gv = wg[0][e] * lg + wg[1][e] * yg[m] + wg[2][e] * rg + bg[e];
                            res[m][e] = silu_f(gv) * av;
                        }
                    }
#pragma unroll
                    for (int m = 0; m < 4; ++m) { u32x2 w; w.x = cvt_pk_bf16(res[m][0], res[m][1]); w.y = cvt_pk_bf16(res[m][2], res[m][3]);
                        *(u32x2*)(O + (size_t)(u.pm * 256 + ai * 128 + wr * 64 + m * 16 + fr) * ldc + j0) = w; }
                }
            }
        } else {
            const int row0 = u.pm * 256 + wr * 64 + fr, col0 = u.pn * 256 + wc * 32 + 4 * fq;
            const int b = ctx ? 4 : b0 + (u.pm * 256) / SEQ;
            const float* gp = gate + (size_t)b * 6144 + col0;
            f32x4 gv[2][2];
#pragma unroll
            for (int bj = 0; bj < 2; ++bj)
#pragma unroll
                for (int n = 0; n < 2; ++n) gv[bj][n] = *(const f32x4*)(gp + bj * 128 + n * 16);
#pragma unroll
            for (int ai = 0; ai < 2; ++ai)
#pragma unroll
                for (int m = 0; m < 4; ++m) { const size_t off = (size_t)(row0 + ai * 128 + m * 16) * DM + col0;
#pragma unroll
                    for (int bj = 0; bj < 2; ++bj)
#pragma unroll
                        for (int n = 0; n < 2; ++n) { const f32x4 h4 = *(const f32x4*)(hin + off + bj * 128 + n * 16);
                            *(f32x4*)(out + off + bj * 128 + n * 16) = h4 * ALPHA_F + gv[bj][n] * acc[ai][bj][m][n]; }
                    asm volatile("" ::: "memory"); }
        }
    }
};
struct GemmJob { const bf16_t* A; const bf16_t* Bt; int lda, M, N, K; EpiAny e; };
constexpr int EPI_LDS_OFF = 131072;
struct EpiLds {
    int kind0;
    __device__ __forceinline__ bool perm() const { return kind0 != 1; }
    __device__ __forceinline__ void operator()(const f32x4 (&acc)[2][2][4][2], const pg8::Unit& u, int wr, int wc, int fr, int fq) const {
        extern __shared__ __attribute__((aligned(16))) unsigned char smem_e[];
        const volatile __attribute__((address_space(3))) unsigned* dw = (const volatile __attribute__((address_space(3))) unsigned*)((__attribute__((address_space(3))) unsigned char*)smem_e + EPI_LDS_OFF);
        union { EpiAny e; unsigned w[sizeof(EpiAny) / 4]; } d;
#pragma unroll
        for (int i = 0; i < (int)(sizeof(EpiAny) / 4); ++i) d.w[i] = __builtin_amdgcn_readfirstlane(dw[i]);
        d.e(acc, u, wr, wc, fr, fq);
    }
};
__device__ __forceinline__ void gemm_call(unsigned char* smem, const GemmJob& j) {
    __syncthreads();
    if (tidx() == 0) *(EpiAny*)(smem + EPI_LDS_OFF) = j.e;
    __syncthreads();
    pg8::Gemm g; g.A = j.A; g.Bt = j.Bt; g.M = j.M; g.N = j.N; g.K = j.K; g.lda = j.lda;
    pg8::StaticOrder S; S.init(j.M, j.N, (int)gridDim.x, bidx());
    EpiLds el; el.kind0 = j.e.kind;
    pg8::gemm_phase<EpiLds>((PG8_LAS unsigned char*)smem, g, S, el);
}

__device__ void transpose_cvt(const float* src, bf16_t* dst, int nmat, int K, int N, int ffn_perm, float* tile  ) {
    const int tid = tidx(), tk = K / 64, tn = N / 64, per = tk * tn, total = nmat * per;
    for (int u = bidx(); u < total; u += gridDim.x) {
        const int mi = u / per, r = u % per, kt = r / tn, ntl = r % tn;
        const float* s = src + (size_t)mi * K * N + (size_t)(kt * 64) * N + ntl * 64;
#pragma unroll
        for (int i = 0; i < 2; ++i) { const int row = (tid >> 4) + 32 * i, c4 = (tid & 15) * 4; const f32x4 v = *(const f32x4*)(s + (size_t)row * N + c4);
            tile[row * 65 + c4 + 0] = v[0]; tile[row * 65 + c4 + 1] = v[1]; tile[row * 65 + c4 + 2] = v[2]; tile[row * 65 + c4 + 3] = v[3]; }
        __syncthreads();
        { const int n = tid >> 3, k8 = (tid & 7) * 8; int ng = ntl * 64 + n;
          if (ffn_perm) ng = ng < DFF ? ((ng >> 7) * 256 + (ng & 127)) : ((((ng - DFF) >> 7) * 256) + 128 + ((ng - DFF) & 127));
          u32x4 w; w.x = cvt_pk_bf16(tile[(k8 + 0) * 65 + n], tile[(k8 + 1) * 65 + n]); w.y = cvt_pk_bf16(tile[(k8 + 2) * 65 + n], tile[(k8 + 3) * 65 + n]);
          w.z = cvt_pk_bf16(tile[(k8 + 4) * 65 + n], tile[(k8 + 5) * 65 + n]); w.w = cvt_pk_bf16(tile[(k8 + 6) * 65 + n], tile[(k8 + 7) * 65 + n]);
          *(u32x4*)(dst + (size_t)mi * K * N + (size_t)ng * K + kt * 64 + k8) = w; }
        __syncthreads();
    }
}
__device__ void phase0(const Params& p, unsigned char* smem) {
    const int tid = tidx();
    unsigned char* ws = p.ws;
    float* mod = (float*)(ws + OFF_MOD);
    {
        float* sc = (float*)smem; float* red = sc + 5 * 1024;
        const float* c = p.in[1]; const float* cctx = p.in[3]; const float* ada_w = p.in[4]; const float* ada_b = p.in[5];
        for (int i = tid; i < 5 * 1024; i += 512) { const float v = i < 4096 ? c[i] : cctx[i - 4096]; sc[i] = silu_f(v); }
        __syncthreads();
        for (int u = bidx(); u < 256; u += gridDim.x) {
            const int l = u >> 6, col0 = (u & 63) * 96, cq = tid % 24, kp = tid / 24;
            float acc[5][4];
#pragma unroll
            for (int r = 0; r < 5; ++r)
#pragma unroll
                for (int e = 0; e < 4; ++e) acc[r][e] = 0.f;
            if (kp < 21) {
                for (int k = kp; k < 1024; k += 21) { const f32x4 w = *(const f32x4*)(ada_w + ((size_t)l * 1024 + k) * 6144 + col0 + cq * 4);
#pragma unroll
                    for (int r = 0; r < 5; ++r) { const float s = sc[r * 1024 + k];
#pragma unroll
                        for (int e = 0; e < 4; ++e) acc[r][e] += s * w[e]; } }
#pragma unroll
                for (int r = 0; r < 5; ++r)
#pragma unroll
                    for (int e = 0; e < 4; ++e) red[(kp * 5 + r) * 96 + cq * 4 + e] = acc[r][e];
            }
            __syncthreads();
            if (tid < 480) { const int r = tid / 96, cc = tid % 96; float s = ada_b[l * 6144 + col0 + cc];
                for (int k2 = 0; k2 < 21; ++k2) s += red[(k2 * 5 + r) * 96 + cc];
                mod[((size_t)l * 5 + r) * 6144 + col0 + cc] = s; }
            __syncthreads();
        }
    }
    if (bidx() == 0) {
        const float* hg_lb = p.in[9]; float* lbs = (float*)(ws + OFF_LBS);
        for (int i = tid; i < 2048; i += 512) { const int dir = i >> 10, k = i & 1023; const float a0 = hg_lb[(dir * 2 + 0) * 1024 + k], a1 = hg_lb[(dir * 2 + 1) * 1024 + k];
            lbs[(dir * 2 + 0) * 1024 + k] = 0.f; lbs[(dir * 2 + 1) * 1024 + k] = 1.0f / (1.0f + expf(a0 - a1)); }
    }
    {
        const float* s = p.in[15]; bf16_t* d = (bf16_t*)(ws + OFF_WS_B);
        for (int i = bidx() * 512 + tid; i < 2 * 8 * 128 * 128 / 4; i += gridDim.x * 512) { const f32x4 v = *(const f32x4*)(s + (size_t)i * 4); u32x2 w; w.x = cvt_pk_bf16(v[0], v[1]); w.y = cvt_pk_bf16(v[2], v[3]); *(u32x2*)(d + (size_t)i * 4) = w; }
    }
    __syncthreads();
    float* tile = (float*)smem;
    transpose_cvt(p.in[8], (bf16_t*)(ws + OFF_WT_HGIN), 2, DM, HGIN, 0, tile);
    transpose_cvt(p.in[11], (bf16_t*)(ws + OFF_WT_HGOUT), 2, DM, DM, 0, tile);
    transpose_cvt(p.in[12], (bf16_t*)(ws + OFF_WT_SGIN), 2, DM, SGIN, 0, tile);
    transpose_cvt(p.in[17], (bf16_t*)(ws + OFF_WT_SGOUT), 2, SGW, DM, 0, tile);
    transpose_cvt(p.in[18], (bf16_t*)(ws + OFF_WT_UP), 4, DM, UPW, 1, tile);
    transpose_cvt(p.in[21], (bf16_t*)(ws + OFF_WT_DOWN), 4, DFF, DM, 0, tile);
}

__device__ void ln_mod(const float* src, float* hdst, bf16_t* mdst, const float* lng, const float* lnb, bool do_ln,
                       const float* shift, const float* scale, int nrows, int rows_per_b, int b0) {
    const int lane = tidx() & 63, gw = bidx() * 8 + (tidx() >> 6), nw = gridDim.x * 8;
    for (int row = gw; row < nrows; row += nw) {
        const float* s = src + (size_t)row * DM; f32x4 x[4];
#pragma unroll
        for (int i = 0; i < 4; ++i) x[i] = *(const f32x4*)(s + i * 256 + lane * 4);
        if (do_ln) {
            float sm = 0.f;
#pragma unroll
            for (int i = 0; i < 4; ++i) sm += (x[i][0] + x[i][1]) + (x[i][2] + x[i][3]);
#pragma unroll
            for (int o = 32; o >= 1; o >>= 1) sm += shx(sm, o, lane);
            const float mean = sm * (1.0f / 1024.0f); float q = 0.f;
#pragma unroll
            for (int i = 0; i < 4; ++i) { const f32x4 d = x[i] - mean; q += (d[0] * d[0] + d[1] * d[1]) + (d[2] * d[2] + d[3] * d[3]); }
#pragma unroll
            for (int o = 32; o >= 1; o >>= 1) q += shx(q, o, lane);
            const float rstd = rsqrtf(q * (1.0f / 1024.0f) + opq(1e-5f));
#pragma unroll
            for (int i = 0; i < 4; ++i) { const f32x4 g4 = *(const f32x4*)(lng + i * 256 + lane * 4), b4 = *(const f32x4*)(lnb + i * 256 + lane * 4);
                x[i] = (x[i] - mean) * rstd * g4 + b4; *(f32x4*)(hdst + (size_t)row * DM + i * 256 + lane * 4) = x[i]; }
        }
        if (mdst) {
            const int b = b0 + row / rows_per_b; const float* sh = shift + (size_t)b * 6144; const float* scl = scale + (size_t)b * 6144;
#pragma unroll
            for (int i = 0; i < 4; ++i) { const f32x4 s4 = *(const f32x4*)(sh + i * 256 + lane * 4), c4 = *(const f32x4*)(scl + i * 256 + lane * 4);
                const f32x4 y = x[i] * (c4 + 1.0f) + s4; u32x2 w; w.x = cvt_pk_bf16(y[0], y[1]); w.y = cvt_pk_bf16(y[2], y[3]);
                *(u32x2*)(mdst + (size_t)row * DM + i * 256 + lane * 4) = w; }
        }
    }
}

__device__ __forceinline__ void tile_mma_128(const bf16_t* la, const bf16_t* lb, f32x4 (&acc)[8], int w, int fr, int fq) {
#pragma unroll
    for (int kk = 0; kk < 4; ++kk) {
        const bf16x8 a = *(const bf16x8*)(la + (16 * w + fr) * LDP + kk * 32 + fq * 8);
#pragma unroll
        for (int nb = 0; nb < 8; ++nb) { const bf16x8 b = *(const bf16x8*)(lb + (16 * nb + fr) * LDP + kk * 32 + fq * 8);
            acc[nb] = __builtin_amdgcn_mfma_f32_16x16x32_bf16(b, a, acc[nb], 0, 0, 0); }
    }
}

__device__ void scan_unit(unsigned char* smem, bf16_t* Z, int T, int h, const float* lbf, const float* lbb, bf16_t* OL, float* Uf, float* Ub, float* Df, float* Db) {
    float* Qs = (float*)smem; float* Fs = Qs + 2048; float* Ks = Fs + 2048; float* Vs = Ks + 2048; float* OP = Vs + 2048;
    const int tid = tidx(), d = tid & 127, kq = tid >> 7, ttl = tid >> 5, k4 = (tid & 31) * 4;
    for (int dir = 0; dir < 2; ++dir) {
        const int zcol = (dir ? 4096 : 3072) + h * 128;
        const float* lb = (dir ? lbb : lbf) + h * 128;
        const f32x4 lbv = *(const f32x4*)(lb + k4);
        float S[32];
#pragma unroll
        for (int i = 0; i < 32; ++i) S[i] = 0.f;
        float P = 1.f;
#pragma unroll 1
        for (int st = 0; st < T / 16; ++st) {
            __syncthreads();
            {   const int pos = st * 16 + ttl, tok = dir ? (T - 1 - pos) : pos;
                const bf16_t* zr = Z + (size_t)tok * HGIN;
                const u32x2 q2 = *(const u32x2*)(zr + h * 128 + k4), f2 = *(const u32x2*)(zr + zcol + k4), v2 = *(const u32x2*)(zr + 2048 + h * 128 + k4);
                const float zf[4] = {bflo(f2.x), bfhi(f2.x), bflo(f2.y), bfhi(f2.y)};
                f32x4 fv, kv;
#pragma unroll
                for (int e = 0; e < 4; ++e) { const float f = lbv[e] + (1.0f - lbv[e]) * sigmoid_f(zf[e]); fv[e] = f; kv[e] = 1.0f - f; }
                *(f32x4*)(Fs + ttl * 128 + k4) = fv; *(f32x4*)(Ks + ttl * 128 + k4) = kv;
                *(f32x4*)(Qs + ttl * 128 + k4) = (f32x4){bflo(q2.x), bfhi(q2.x), bflo(q2.y), bfhi(q2.y)};
                *(f32x4*)(Vs + ttl * 128 + k4) = (f32x4){bflo(v2.x), bfhi(v2.x), bflo(v2.y), bfhi(v2.y)};
            }
            __syncthreads();
            if (tid < 128) {
#pragma unroll 1
                for (int tt = 0; tt < 16; ++tt) { P *= Fs[tt * 128 + tid]; const float qg = Qs[tt * 128 + tid] * P;
                    const int pos = st * 16 + tt, tok = dir ? (T - 1 - pos) : pos; Z[(size_t)tok * HGIN + zcol + tid] = f2bf(qg); }
            }
#pragma unroll 1
            for (int tt = 0; tt < 16; ++tt) {
                const float v = Vs[tt * 128 + d]; float o = 0.f;
                const f32x4* F4 = (const f32x4*)(Fs + tt * 128 + kq * 32); const f32x4* K4 = (const f32x4*)(Ks + tt * 128 + kq * 32); const f32x4* Q4 = (const f32x4*)(Qs + tt * 128 + kq * 32);
#pragma unroll
                for (int i4 = 0; i4 < 8; ++i4) { const f32x4 f = F4[i4], k = K4[i4], q = Q4[i4];
#pragma unroll
                    for (int e = 0; e < 4; ++e) { S[i4 * 4 + e] = f[e] * S[i4 * 4 + e] + k[e] * v; o += q[e] * S[i4 * 4 + e]; } }
                OP[(kq * 16 + tt) * 128 + d] = o;
            }
            __syncthreads();
            {   const f32x4 s = *(const f32x4*)(OP + (0 * 16 + ttl) * 128 + k4) + *(const f32x4*)(OP + (1 * 16 + ttl) * 128 + k4) + *(const f32x4*)(OP + (2 * 16 + ttl) * 128 + k4) + *(const f32x4*)(OP + (3 * 16 + ttl) * 128 + k4);
                const int pos = st * 16 + ttl, tok = dir ? (T - 1 - pos) : pos;
                bf16_t* op = OL + (size_t)tok * DM + h * 128 + k4; f32x4 r = s;
                if (dir) { const u32x2 pv = *(const u32x2*)op; r[0] += bflo(pv.x); r[1] += bfhi(pv.x); r[2] += bflo(pv.y); r[3] += bfhi(pv.y); }
                u32x2 w; w.x = cvt_pk_bf16(r[0], r[1]); w.y = cvt_pk_bf16(r[2], r[3]); *(u32x2*)op = w;
            }
        }
        float* U = dir ? Ub : Uf;
#pragma unroll
        for (int i = 0; i < 32; ++i) U[(kq * 32 + i) * 128 + d] = S[i];
        if (tid < 128) (dir ? Db : Df)[tid] = P;
    }
    __syncthreads();
}
__device__ void scan_unit_mfma(unsigned char* smem, bf16_t* Z, int T, int h, const float* lbf, const float* lbb, bf16_t* OL, float* Uf, float* Ub, float* Df, float* Db) {
    bf16_t* rq = (bf16_t*)smem; bf16_t* rz = rq + 4096; bf16_t* rv = rz + 4096;
    float* tot = (float*)(smem + 24576); float* EG = tot + 512;
    bf16_t* QS = (bf16_t*)(smem + 27136); bf16_t* QE = QS + 32 * 136; bf16_t* KS0 = QE + 32 * 136; bf16_t* KS1 = KS0 + 16 * 136;
    bf16_t* KET = KS1 + 32 * 136; bf16_t* VT = KET + 128 * 40; bf16_t* Pm = VT + 128 * 40; bf16_t* ST = Pm + 32 * 40;
    const int tid = tidx(), lane = tid & 63, w = tid >> 6, fr = lane & 15, fq = lane >> 4, kc = tid & 127, g = tid >> 7;
    for (int dir = 0; dir < 2; ++dir) {
        const int zcol = (dir ? 4096 : 3072) + h * 128;
        const float lbk = ((dir ? lbb : lbf) + h * 128)[kc];
        float Lprev = 0.f;
        f32x4 sacc[8];
#pragma unroll
        for (int dt = 0; dt < 8; ++dt) sacc[dt] = (f32x4){0.f, 0.f, 0.f, 0.f};
        __syncthreads();
        for (int i = tid; i < 128 * 136 / 8; i += 512) ((u32x4*)ST)[i] = (u32x4){0u, 0u, 0u, 0u};
#pragma unroll 1
        for (int ch = 0; ch < T / 32; ++ch) {
            __syncthreads();
            {   const int t = tid >> 4, c8 = (tid & 15) * 8, pos = ch * 32 + t, tok = dir ? (T - 1 - pos) : pos; const bf16_t* zr = Z + (size_t)tok * HGIN;
                *(u32x4*)(rq + t * 128 + c8) = *(const u32x4*)(zr + h * 128 + c8); *(u32x4*)(rz + t * 128 + c8) = *(const u32x4*)(zr + zcol + c8); *(u32x4*)(rv + t * 128 + c8) = *(const u32x4*)(zr + 2048 + h * 128 + c8); }
            __syncthreads();
            float lg[8], kk[8], qv[8]; float run = 0.f;
#pragma unroll
            for (int i = 0; i < 8; ++i) { const int t = 8 * g + i; const float z = bf2f(rz[t * 128 + kc]); const float f = lbk + (1.0f - lbk) * sigmoid_f(z);
                kk[i] = 1.0f - f; run += __logf(f); lg[i] = run; qv[i] = bf2f(rq[t * 128 + kc]); }
            tot[g * 128 + kc] = run;
            {   u32x4 pk; unsigned short e[8];
#pragma unroll
                for (int i = 0; i < 8; ++i) e[i] = rv[(8 * g + i) * 128 + kc];
                pk.x = (unsigned)e[0] | ((unsigned)e[1] << 16); pk.y = (unsigned)e[2] | ((unsigned)e[3] << 16); pk.z = (unsigned)e[4] | ((unsigned)e[5] << 16); pk.w = (unsigned)e[6] | ((unsigned)e[7] << 16);
                *(u32x4*)(VT + kc * 40 + 8 * g) = pk; }
            __syncthreads();
            {   const float t0 = tot[kc], t1 = tot[128 + kc], t2 = tot[256 + kc], t3 = tot[384 + kc];
                const float base = g == 0 ? 0.f : g == 1 ? t0 : g == 2 ? t0 + t1 : t0 + t1 + t2;
                const float R1 = t0 + t1, gend = R1 + t2 + t3, Rb = g >= 2 ? R1 : 0.f, eRb = g >= 2 ? __expf(R1) : 1.0f, ePrev = __expf(Lprev), eEnd1 = __expf(gend - R1);
                float kev[8];
#pragma unroll
                for (int i = 0; i < 8; ++i) { const int t = 8 * g + i; const float G = base + lg[i];
                    const float qs = qv[i] * __expf(G - Rb), qe = qs * eRb, ks1 = kk[i] * __expf(fminf(R1 - G, 80.f));
                    QS[t * 136 + kc] = f2bf(qs); QE[t * 136 + kc] = f2bf(qe); KS1[t * 136 + kc] = f2bf(ks1);
                    if (g < 2) KS0[t * 136 + kc] = f2bf(kk[i] * __expf(fminf(-G, 80.f)));
                    kev[i] = ks1 * eEnd1;
                    const int pos = ch * 32 + t, tok = dir ? (T - 1 - pos) : pos; Z[(size_t)tok * HGIN + zcol + kc] = f2bf(qe * ePrev); }
                u32x4 pk; pk.x = cvt_pk_bf16(kev[0], kev[1]); pk.y = cvt_pk_bf16(kev[2], kev[3]); pk.z = cvt_pk_bf16(kev[4], kev[5]); pk.w = cvt_pk_bf16(kev[6], kev[7]);
                *(u32x4*)(KET + kc * 40 + 8 * g) = pk;
                if (g == 0) EG[kc] = __expf(gend);
                Lprev += gend; }
            __syncthreads();
            if (w < 3) {
                const int ti = w == 0 ? 0 : 1, sj = w == 2 ? 1 : 0; const bf16_t* ksb = w == 0 ? KS0 : KS1;
                f32x4 c = (f32x4){0.f, 0.f, 0.f, 0.f};
#pragma unroll
                for (int k4 = 0; k4 < 4; ++k4) { const bf16x8 a = *(const bf16x8*)(ksb + (16 * sj + fr) * 136 + k4 * 32 + fq * 8), bb = *(const bf16x8*)(QS + (16 * ti + fr) * 136 + k4 * 32 + fq * 8);
                    c = __builtin_amdgcn_mfma_f32_16x16x32_bf16(a, bb, c, 0, 0, 0); }
                if (ti == sj) {
#pragma unroll
                    for (int r = 0; r < 4; ++r) if (4 * fq + r > fr) c[r] = 0.f; }
                u32x2 pw; pw.x = cvt_pk_bf16(c[0], c[1]); pw.y = cvt_pk_bf16(c[2], c[3]);
                *(u32x2*)(Pm + (16 * ti + fr) * 40 + 16 * sj + 4 * fq) = pw;
            } else if (w == 3) { *(u32x2*)(Pm + fr * 40 + 16 + 4 * fq) = (u32x2){0u, 0u}; }
            __syncthreads();
            {   f32x4 o0 = (f32x4){0.f, 0.f, 0.f, 0.f}, o1 = o0;
#pragma unroll
                for (int k4 = 0; k4 < 4; ++k4) { const bf16x8 a = *(const bf16x8*)(ST + (16 * w + fr) * 136 + k4 * 32 + fq * 8);
                    const bf16x8 b0 = *(const bf16x8*)(QE + fr * 136 + k4 * 32 + fq * 8), b1 = *(const bf16x8*)(QE + (16 + fr) * 136 + k4 * 32 + fq * 8);
                    o0 = __builtin_amdgcn_mfma_f32_16x16x32_bf16(a, b0, o0, 0, 0, 0); o1 = __builtin_amdgcn_mfma_f32_16x16x32_bf16(a, b1, o1, 0, 0, 0); }
                {   const bf16x8 a = *(const bf16x8*)(VT + (16 * w + fr) * 40 + fq * 8), b0 = *(const bf16x8*)(Pm + fr * 40 + fq * 8), b1 = *(const bf16x8*)(Pm + (16 + fr) * 40 + fq * 8);
                    o0 = __builtin_amdgcn_mfma_f32_16x16x32_bf16(a, b0, o0, 0, 0, 0); o1 = __builtin_amdgcn_mfma_f32_16x16x32_bf16(a, b1, o1, 0, 0, 0); }
#pragma unroll
                for (int tt = 0; tt < 2; ++tt) { f32x4 r = tt ? o1 : o0; const int pos = ch * 32 + 16 * tt + fr, tok = dir ? (T - 1 - pos) : pos;
                    bf16_t* op = OL + (size_t)tok * DM + h * 128 + 16 * w + 4 * fq;
                    if (dir) { const u32x2 pv = *(const u32x2*)op; r[0] += bflo(pv.x); r[1] += bfhi(pv.x); r[2] += bflo(pv.y); r[3] += bfhi(pv.y); }
                    u32x2 wv; wv.x = cvt_pk_bf16(r[0], r[1]); wv.y = cvt_pk_bf16(r[2], r[3]); *(u32x2*)op = wv; }
                const f32x4 eg4 = *(const f32x4*)(EG + 16 * w + 4 * fq);
                const bf16x8 ak = *(const bf16x8*)(KET + (16 * w + fr) * 40 + fq * 8);
#pragma unroll
                for (int dt = 0; dt < 8; ++dt) { const bf16x8 bv = *(const bf16x8*)(VT + (16 * dt + fr) * 40 + fq * 8);
                    sacc[dt] = __builtin_amdgcn_mfma_f32_16x16x32_bf16(ak, bv, sacc[dt] * eg4, 0, 0, 0); }
            }
            __syncthreads();
#pragma unroll
            for (int dt = 0; dt < 8; ++dt) { u32x2 sw; sw.x = cvt_pk_bf16(sacc[dt][0], sacc[dt][1]); sw.y = cvt_pk_bf16(sacc[dt][2], sacc[dt][3]);
                *(u32x2*)(ST + (16 * dt + fr) * 136 + 16 * w + 4 * fq) = sw; }
        }
        float* U = dir ? Ub : Uf;
#pragma unroll
        for (int dt = 0; dt < 8; ++dt)
#pragma unroll
            for (int r = 0; r < 4; ++r) U[(16 * w + 4 * fq + r) * 128 + 16 * dt + fr] = sacc[dt][r];
        if (g == 0) (dir ? Db : Df)[kc] = __expf(Lprev);
    }
    __syncthreads();
}
__device__ void scan_pass2(float* U, const float* Dk, const float* Uctx, int s) {
    const int gt = bidx() * 512 + tidx(), nt = gridDim.x * 512;
    for (int e4 = gt; e4 < 32 * 4096; e4 += nt) {
        const int seq = e4 >> 12, el = (e4 & 4095) * 4, k = el >> 7, bl = seq >> 4, hd = seq & 15, dir = seq & 1;
        f32x4 cur = *(const f32x4*)(Uctx + (size_t)((s * 2 + bl) * 16 + hd) * 16384 + el);
        for (int jj = 0; jj < 16; ++jj) { const int j = dir ? 15 - jj : jj; float* up = U + ((size_t)seq * 16 + j) * 16384 + el;
            const f32x4 tmp = *(const f32x4*)up; *(f32x4*)up = cur; const float dk = Dk[(seq * 16 + j) * 128 + k]; cur = cur * dk + tmp; }
    }
}
__device__ void scan_pass3_unit(unsigned char* smem, bf16_t* Z, const bf16_t* OL, const float* U, const float* normw, int bl, int h, int tile) {
    bf16_t* la = (bf16_t*)smem; bf16_t* lb = la + 128 * LDP;
    const int tid = tidx(), w = tid >> 6, lane = tid & 63, fr = lane & 15, fq = lane >> 4;
    const int tok0 = bl * SEQ + tile * 128, j = tile >> 2;
    f32x4 acc[8];
#pragma unroll
    for (int nb = 0; nb < 8; ++nb) acc[nb] = (f32x4){0.f, 0.f, 0.f, 0.f};
    for (int dir = 0; dir < 2; ++dir) {
        __syncthreads();
        const int zcol = (dir ? 4096 : 3072) + h * 128;
#pragma unroll
        for (int i = 0; i < 4; ++i) { const int c = tid + 512 * i, r = c >> 4, k8 = (c & 15) * 8;
            *(u32x4*)(la + r * LDP + k8) = *(const u32x4*)(Z + (size_t)(tok0 + r) * HGIN + zcol + k8); }
        const float* Sp = U + ((size_t)((bl * 8 + h) * 2 + dir) * 16 + j) * 16384;
#pragma unroll
        for (int i = 0; i < 8; ++i) { const int c = tid + 512 * i, k = c >> 5, d4 = (c & 31) * 4; const f32x4 v = *(const f32x4*)(Sp + k * 128 + d4);
            lb[(d4 + 0) * LDP + k] = f2bf(v[0]); lb[(d4 + 1) * LDP + k] = f2bf(v[1]); lb[(d4 + 2) * LDP + k] = f2bf(v[2]); lb[(d4 + 3) * LDP + k] = f2bf(v[3]); }
        __syncthreads();
        tile_mma_128(la, lb, acc, w, fr, fq);
    }
    const int tok = tok0 + 16 * w + fr;
    float ss = 0.f;
#pragma unroll
    for (int nb = 0; nb < 8; ++nb) { const u32x2 pv = *(const u32x2*)(OL + (size_t)tok * DM + h * 128 + 16 * nb + 4 * fq);
        acc[nb][0] += bflo(pv.x); acc[nb][1] += bfhi(pv.x); acc[nb][2] += bflo(pv.y); acc[nb][3] += bfhi(pv.y);
        ss += (acc[nb][0] * acc[nb][0] + acc[nb][1] * acc[nb][1]) + (acc[nb][2] * acc[nb][2] + acc[nb][3] * acc[nb][3]); }
    ss += shx(ss, 16, lane); ss += shx(ss, 32, lane);
    const float rn = rsqrtf(ss * (1.0f / 128.0f) + opq(1e-6f));
#pragma unroll
    for (int nb = 0; nb < 8; ++nb) { bf16_t* gp = Z + (size_t)tok * HGIN + 1024 + h * 128 + 16 * nb + 4 * fq; const u32x2 gv = *(const u32x2*)gp;
        const f32x4 nw = *(const f32x4*)(normw + 16 * nb + 4 * fq);
        u32x2 wv; wv.x = cvt_pk_bf16(acc[nb][0] * rn * nw[0] * bflo(gv.x), acc[nb][1] * rn * nw[1] * bfhi(gv.x));
        wv.y = cvt_pk_bf16(acc[nb][2] * rn * nw[2] * bflo(gv.y), acc[nb][3] * rn * nw[3] * bfhi(gv.y)); *(u32x2*)gp = wv; }
}
__device__ void ctx_readout(bf16_t* Zc, const bf16_t* OLc, const float* normw) {
    const int lane = tidx() & 63, gw = bidx() * 8 + (tidx() >> 6), nw = gridDim.x * 8;
    for (int row = gw; row < MCTX; row += nw) {
        const bf16_t* op = OLc + (size_t)row * DM + lane * 16; bf16_t* gp = Zc + (size_t)row * HGIN + 1024 + lane * 16;
        const u32x4 o0 = *(const u32x4*)op, o1 = *(const u32x4*)(op + 8);
        float o[16] = {bflo(o0.x), bfhi(o0.x), bflo(o0.y), bfhi(o0.y), bflo(o0.z), bfhi(o0.z), bflo(o0.w), bfhi(o0.w), bflo(o1.x), bfhi(o1.x), bflo(o1.y), bfhi(o1.y), bflo(o1.z), bfhi(o1.z), bflo(o1.w), bfhi(o1.w)};
        float ss = 0.f;
#pragma unroll
        for (int e = 0; e < 16; ++e) ss += o[e] * o[e];
        ss += shx(ss, 1, lane); ss += shx(ss, 2, lane); ss += shx(ss, 4, lane);
        const float rn = rsqrtf(ss * (1.0f / 128.0f) + opq(1e-6f));
        const u32x4 g0 = *(const u32x4*)gp, g1 = *(const u32x4*)(gp + 8);
        const float g[16] = {bflo(g0.x), bfhi(g0.x), bflo(g0.y), bfhi(g0.y), bflo(g0.z), bfhi(g0.z), bflo(g0.w), bfhi(g0.w), bflo(g1.x), bfhi(g1.x), bflo(g1.y), bfhi(g1.y), bflo(g1.z), bfhi(g1.z), bflo(g1.w), bfhi(g1.w)};
        const float* nwp = normw + (lane & 7) * 16;
#pragma unroll
        for (int e = 0; e < 16; ++e) o[e] = o[e] * rn * nwp[e] * g[e];
        u32x4 w0, w1; w0.x = cvt_pk_bf16(o[0], o[1]); w0.y = cvt_pk_bf16(o[2], o[3]); w0.z = cvt_pk_bf16(o[4], o[5]); w0.w = cvt_pk_bf16(o[6], o[7]);
        w1.x = cvt_pk_bf16(o[8], o[9]); w1.y = cvt_pk_bf16(o[10], o[11]); w1.z = cvt_pk_bf16(o[12], o[13]); w1.w = cvt_pk_bf16(o[14], o[15]);
        *(u32x4*)gp = w0; *(u32x4*)(gp + 8) = w1;
    }
}

__device__ void sgu_mix_unit(unsigned char* smem, bf16_t* Z, int chunk, int gh, const bf16_t* wsb  , const float* bs  , const float* lng, const float* lnb) {
    float* stats = (float*)smem;
    bf16_t* la = (bf16_t*)(smem + 1024); bf16_t* lb = la + 128 * LDP;
    const int tid = tidx(), w = tid >> 6, lane = tid & 63, fr = lane & 15, fq = lane >> 4;
    const int t0 = chunk * 128;
    __syncthreads();
    for (int i = 0; i < 16; ++i) {
        const bf16_t* vr = Z + (size_t)(t0 + 16 * w + i) * SGIN + SGW + lane * 8; float x[48]; float sm = 0.f;
#pragma unroll
        for (int c = 0; c < 6; ++c) { const u32x4 v = *(const u32x4*)(vr + c * 512);
            x[c * 8 + 0] = bflo(v.x); x[c * 8 + 1] = bfhi(v.x); x[c * 8 + 2] = bflo(v.y); x[c * 8 + 3] = bfhi(v.y); x[c * 8 + 4] = bflo(v.z); x[c * 8 + 5] = bfhi(v.z); x[c * 8 + 6] = bflo(v.w); x[c * 8 + 7] = bfhi(v.w); }
#pragma unroll
        for (int e = 0; e < 48; ++e) sm += x[e];
#pragma unroll
        for (int o = 32; o >= 1; o >>= 1) sm += shx(sm, o, lane);
        const float mean = sm * (1.0f / 3072.0f); float q = 0.f;
#pragma unroll
        for (int e = 0; e < 48; ++e) { const float dd = x[e] - mean; q += dd * dd; }
#pragma unroll
        for (int o = 32; o >= 1; o >>= 1) q += shx(q, o, lane);
        if (lane == 0) { stats[(16 * w + i) * 2] = mean; stats[(16 * w + i) * 2 + 1] = rsqrtf(q * (1.0f / 3072.0f) + opq(1e-5f)); }
    }
    for (int gi = 0; gi < 4; ++gi) {
        const int g = gh * 4 + gi;
        for (int cb = 0; cb < 3; ++cb) {
            __syncthreads();
            if (cb == 0) {
#pragma unroll
                for (int i = 0; i < 4; ++i) { const int c = tid + 512 * i, r = c >> 4, k8 = (c & 15) * 8; *(u32x4*)(la + r * LDP + k8) = *(const u32x4*)(wsb + ((size_t)g * 128 + r) * 128 + k8); }
            }
            const int cg0 = g * 384 + cb * 128;
#pragma unroll
            for (int i = 0; i < 4; ++i) { const int c = tid + 512 * i, q = c >> 4, c8 = (c & 15) * 8;
                const u32x4 v = *(const u32x4*)(Z + (size_t)(t0 + q) * SGIN + SGW + cg0 + c8);
                const float mean = stats[q * 2], rstd = stats[q * 2 + 1];
                const float xv[8] = {bflo(v.x), bfhi(v.x), bflo(v.y), bfhi(v.y), bflo(v.z), bfhi(v.z), bflo(v.w), bfhi(v.w)};
                const f32x4 g0 = *(const f32x4*)(lng + cg0 + c8), g1 = *(const f32x4*)(lng + cg0 + c8 + 4), b0 = *(const f32x4*)(lnb + cg0 + c8), b1 = *(const f32x4*)(lnb + cg0 + c8 + 4);
#pragma unroll
                for (int e = 0; e < 8; ++e) { const float gg = e < 4 ? g0[e & 3] : g1[e & 3], bb = e < 4 ? b0[e & 3] : b1[e & 3];
                    lb[(c8 + e) * LDP + q] = f2bf((xv[e] - mean) * rstd * gg + bb); } }
            __syncthreads();
            f32x4 acc[8];
#pragma unroll
            for (int nb = 0; nb < 8; ++nb) acc[nb] = (f32x4){0.f, 0.f, 0.f, 0.f};
            tile_mma_128(la, lb, acc, w, fr, fq);
            const int pr = 16 * w + fr; const float bias = bs[g * 128 + pr];
#pragma unroll
            for (int nb = 0; nb < 8; ++nb) { bf16_t* up = Z + (size_t)(t0 + pr) * SGIN + cg0 + 16 * nb + 4 * fq; const u32x2 uv = *(const u32x2*)up;
                u32x2 wv; wv.x = cvt_pk_bf16(bflo(uv.x) * (acc[nb][0] + bias), bfhi(uv.x) * (acc[nb][1] + bias)); wv.y = cvt_pk_bf16(bflo(uv.y) * (acc[nb][2] + bias), bfhi(uv.y) * (acc[nb][3] + bias));
                *(u32x2*)up = wv; }
        }
    }
}

__device__ void conv_swiglu(const bf16_t* Z, bf16_t* act, const float* cw, const float* cb, int rows, int row_len) {
    const int gt = bidx() * 512 + tidx(), nt = gridDim.x * 512, total = rows * 352;
    for (int i = gt; i < total; i += nt) {
        const int t = i / 352, j8 = (i % 352) * 8, np = (j8 >> 7) * 256 + (j8 & 127), pos = t % row_len;
        const bool hasL = pos != 0, hasR = pos != row_len - 1;
        const bf16_t* zr = Z + (size_t)t * UPW + np; const u32x4 zero = (u32x4){0u, 0u, 0u, 0u};
        const u32x4 a1 = *(const u32x4*)zr, g1 = *(const u32x4*)(zr + 128);
        const u32x4 a0 = hasL ? *(const u32x4*)(zr - UPW) : zero, g0 = hasL ? *(const u32x4*)(zr - UPW + 128) : zero;
        const u32x4 a2 = hasR ? *(const u32x4*)(zr + UPW) : zero, g2 = hasR ? *(const u32x4*)(zr + UPW + 128) : zero;
        float r[8];
#pragma unroll
        for (int e = 0; e < 8; ++e) { const int j = j8 + e; const unsigned sh = (e & 1) ? 0u : 16u;
            const unsigned wa0 = e < 2 ? a0.x : e < 4 ? a0.y : e < 6 ? a0.z : a0.w, wa1 = e < 2 ? a1.x : e < 4 ? a1.y : e < 6 ? a1.z : a1.w, wa2 = e < 2 ? a2.x : e < 4 ? a2.y : e < 6 ? a2.z : a2.w;
            const unsigned wg0 = e < 2 ? g0.x : e < 4 ? g0.y : e < 6 ? g0.z : g0.w, wg1 = e < 2 ? g1.x : e < 4 ? g1.y : e < 6 ? g1.z : g1.w, wg2 = e < 2 ? g2.x : e < 4 ? g2.y : e < 6 ? g2.z : g2.w;
            const float fa0 = __uint_as_float((wa0 << sh) & 0xffff0000u), fa1 = __uint_as_float((wa1 << sh) & 0xffff0000u), fa2 = __uint_as_float((wa2 << sh) & 0xffff0000u);
            const float fg0 = __uint_as_float((wg0 << sh) & 0xffff0000u), fg1 = __uint_as_float((wg1 << sh) & 0xffff0000u), fg2 = __uint_as_float((wg2 << sh) & 0xffff0000u);
            const float av = cw[j] * fa0 + cw[UPW + j] * fa1 + cw[2 * UPW + j] * fa2 + cb[j];
            const float gv = cw[DFF + j] * fg0 + cw[UPW + DFF + j] * fg1 + cw[2 * UPW + DFF + j] * fg2 + cb[DFF + j];
            r[e] = silu_f(gv) * av; }
        u32x4 w; w.x = cvt_pk_bf16(r[0], r[1]); w.y = cvt_pk_bf16(r[2], r[3]); w.z = cvt_pk_bf16(r[4], r[5]); w.w = cvt_pk_bf16(r[6], r[7]);
        *(u32x4*)(act + (size_t)t * DFF + j8) = w;
    }
}
enum { T_NONE = 0, T_P0, T_INIT, T_GEMM_IN, T_SCAN1, T_SCAN2, T_SCAN3, T_MIX, T_GEMM_OUT, T_LN1, T_GEMM_UP, T_CONV, T_GEMM_DN, T_LN2, T_READOUT };
constexpr int NPHASES = 2 + 14 + 10 + 14 + 10;
__device__ __forceinline__ void decode_phase(int ph, int& type, int& l, int& s) {
    l = 0; s = 0;
    if (ph == 0) { type = T_P0; return; }
    if (ph == 1) { type = T_INIT; return; }
    int q = ph - 2;
    if (q < 14) l = 0; else if (q < 24) { l = 1; q -= 14; } else if (q < 38) { l = 2; q -= 24; } else { l = 3; q -= 38; }
    const int half = (l & 1) ? 3 : 5, nm = 2 * half;
    if (q < nm) { s = q / half; const int st = q % half;
        if (l & 1) type = st == 0 ? T_GEMM_IN : st == 1 ? T_MIX : T_GEMM_OUT;
        else type = st == 0 ? T_GEMM_IN : st == 1 ? T_SCAN1 : st == 2 ? T_SCAN2 : st == 3 ? T_SCAN3 : T_GEMM_OUT;
        return; }
    q -= nm;
    type = q == 0 ? T_LN1 : q == 1 ? T_GEMM_UP : q == 2 ? T_GEMM_DN : T_LN2;
}
__device__ __forceinline__ void decode_ctx(int ph, int& type, int& l) {
    const int c = ph - 2; type = T_NONE; l = 0;
    if (c < 0 || c > 18) return;
    if (c < 9) { l = 0; type = c == 0 ? T_GEMM_IN : c == 1 ? T_SCAN1 : c == 2 ? T_READOUT : c == 3 ? T_GEMM_OUT : c == 4 ? T_LN1 : c == 5 ? T_GEMM_UP : c == 6 ? T_CONV : c == 7 ? T_GEMM_DN : T_LN2; }
    else if (c < 17) { const int d = c - 9; l = 1; type = d == 0 ? T_GEMM_IN : d == 1 ? T_MIX : d == 2 ? T_GEMM_OUT : d == 3 ? T_LN1 : d == 4 ? T_GEMM_UP : d == 5 ? T_CONV : d == 6 ? T_GEMM_DN : T_LN2; }
    else { l = 2; type = c == 17 ? T_GEMM_IN : T_SCAN1; }
}
__device__ __forceinline__ bool is_gemm(int t) { return t == T_GEMM_IN || t == T_GEMM_OUT || t == T_GEMM_UP || t == T_GEMM_DN; }
__global__ __launch_bounds__(512, 2) void fwd_megakernel(Params p) {
    extern __shared__ __attribute__((aligned(16))) unsigned char smem[];
    { cg::grid_group grid = cg::this_grid(); grid.sync(); }
    unsigned char* ws0 = p.ws;
    const int nblk = gridDim.x, bid = bidx();
    unsigned char* ws = ws0;
    volatile XLAS unsigned* xst = (volatile XLAS unsigned*)((XLAS unsigned char*)smem + 131072 + 256);
    if (threadIdx.x == 0) { xst[0] = 0u; xst[1] = 0u; xst[2] = 0u; xst[3] = 0u; }
    if ((threadIdx.x & 63) == 0) *(volatile XLAS int*)((XLAS unsigned char*)smem + WTAB_OFF + 4 * hw_slot()) = (int)(threadIdx.x >> 6);
    __syncthreads();
    const XcdBarrier xb = xcd_barrier_post((unsigned*)(ws + OFF_BAR), xst);
    for (int ph = 0; ph < NPHASES; ++ph) {
        int type, l, s, ctype, cl; decode_phase(ph, type, l, s); decode_ctx(ph, ctype, cl);
        unsigned char* ws = ws0; asm volatile("" : "+s"(ws));
        const float* x = p.in[0]; const float* ctxin = p.in[2];
        float* out = p.out; asm volatile("" : "+s"(out));
        float* mod = (float*)(ws + OFF_MOD); const float* lbs = (const float*)(ws + OFF_LBS);
        bf16_t* hmod = (bf16_t*)(ws + OFF_HMOD); float* hc = (float*)(ws + OFF_HC); bf16_t* hcmod = (bf16_t*)(ws + OFF_HCMOD);
        bf16_t* Zc = (bf16_t*)(ws + OFF_ZC); bf16_t* actc = (bf16_t*)(ws + OFF_ACTC); bf16_t* OLc = (bf16_t*)(ws + OFF_OLC);
        float* Uctx = (float*)(ws + OFF_UCTX); float* Dctx = (float*)(ws + OFF_DCTX);
        unsigned char* big = ws + OFF_BIG;
        bf16_t* Zhg = (bf16_t*)(big + BIG_HG_Z); bf16_t* OL = (bf16_t*)(big + BIG_HG_OL); float* U = (float*)(big + BIG_HG_U); float* Dk = (float*)(big + BIG_HG_D);
        bf16_t* Zb = (bf16_t*)big; bf16_t* act = (bf16_t*)big;
        if (type == T_P0) {
            phase0(p, smem);
        } else if (type == T_INIT) {
            ln_mod(x, nullptr, hmod, nullptr, nullptr, false, mod + 0, mod + 1024, MLAT, SEQ, 0);
            ln_mod(ctxin, nullptr, hcmod, nullptr, nullptr, false, mod + 0, mod + 1024, MCTX, 1 << 30, 4);
        }
        if (is_gemm(type) || is_gemm(ctype)) {
            GemmJob j; j.e.kind = 0; j.e.O = nullptr; j.e.ldc = 0; j.e.mode = 0; j.e.silu_tiles = 0; j.e.hin = nullptr; j.e.out = nullptr; j.e.gate = nullptr; j.e.b0 = 0; j.e.ctx = 0;
            j.A = nullptr; j.Bt = nullptr; j.lda = 0; j.M = 0; j.N = 0; j.K = 0;
            for (int job = 0; job < 2; ++job) {
                const bool c = job == 1; const int t = c ? ctype : type, ll = c ? cl : l;
                if (!is_gemm(t)) continue;
                const int kind = ll & 1, idx = ll >> 1; const float* modl = mod + (size_t)ll * 5 * 6144;
                const float* hin = (ll == 0) ? x : out; const float* hcin = (ll == 0) ? ctxin : hc;
                if (t == T_GEMM_IN) {
                    j.A = c ? hcmod : hmod + (size_t)s * SLAB * DM; j.lda = DM; j.K = DM; j.M = c ? MCTX : SLAB; j.e.kind = 0;
                    if (kind == 0) { j.Bt = (const bf16_t*)(ws + OFF_WT_HGIN) + (size_t)idx * HGIN * DM; j.N = HGIN; j.e.O = c ? Zc : Zhg; j.e.ldc = HGIN; j.e.mode = 1; j.e.silu_tiles = 8; }
                    else { j.Bt = (const bf16_t*)(ws + OFF_WT_SGIN) + (size_t)idx * SGIN * DM; j.N = SGIN; j.e.O = c ? Zc : Zb; j.e.ldc = SGIN; j.e.mode = 2; j.e.silu_tiles = 0; }
                } else if (t == T_GEMM_OUT) {
                    j.M = c ? MCTX : SLAB; j.N = DM; j.e.kind = 1; j.e.hin = c ? hcin : hin + (size_t)s * SLAB * DM; j.e.out = c ? hc : out + (size_t)s * SLAB * DM; j.e.gate = modl + 2048; j.e.b0 = s * 2; j.e.ctx = c ? 1 : 0;
                    if (kind == 0) { j.A = (c ? Zc : Zhg) + 1024; j.lda = HGIN; j.K = DM; j.Bt = (const bf16_t*)(ws + OFF_WT_HGOUT) + (size_t)idx * DM * DM; }
                    else { j.A = c ? Zc : Zb; j.lda = SGIN; j.K = SGW; j.Bt = (const bf16_t*)(ws + OFF_WT_SGOUT) + (size_t)idx * DM * SGW; }
                } else if (t == T_GEMM_UP) {
                    j.A = c ? hcmod : hmod; j.lda = DM; j.K = DM; j.M = c ? MCTX : MLAT; j.N = UPW; j.Bt = (const bf16_t*)(ws + OFF_WT_UP) + (size_t)ll * UPW * DM;
                    if (c) { j.e.kind = 0; j.e.O = Zc; j.e.ldc = UPW; j.e.mode = 0; j.e.silu_tiles = 0; }
                    else { j.e.kind = 2; j.e.O = act; j.e.ldc = DFF; j.e.hin = p.in[19] + (size_t)ll * 3 * UPW; j.e.gate = p.in[20] + (size_t)ll * UPW; }
                } else {
                    j.A = c ? actc : act; j.lda = DFF; j.K = DFF; j.M = c ? MCTX : MLAT; j.N = DM; j.Bt = (const bf16_t*)(ws + OFF_WT_DOWN) + (size_t)ll * DM * DFF;
                    j.e.kind = 1; j.e.hin = c ? hc : out; j.e.out = c ? hc : out; j.e.gate = modl + 5120; j.e.b0 = 0; j.e.ctx = c ? 1 : 0;
                }
#ifndef NO_GEMM
                gemm_call(smem, j);
#endif
            }
        }
        {
            const int idx = l >> 1; const float* modl = mod + (size_t)l * 5 * 6144;
            const float* lbf = lbs + (0 * 2 + idx) * 1024; const float* lbb = lbs + (1 * 2 + idx) * 1024; const float* normw = p.in[10] + idx * 128;
            if (type == T_SCAN1 || ctype == T_SCAN1) {
                const int cidx = cl >> 1;
                const int n0 = type == T_SCAN1 ? 256 : 0, nu = n0 + (ctype == T_SCAN1 ? 32 : 0);
                for (int u = bid; u < nu; u += nblk) {
                    bf16_t* Zp; bf16_t* OLp; float *Uf, *Ub, *Df, *Db; int T, h; const float *lf, *lb2;
                    if (u < n0) { const int bl = u >> 7, sc = u & 15; h = (u >> 4) & 7; const size_t t0 = (size_t)bl * SEQ + sc * 512; const int sq = (bl * 8 + h) * 2; T = 512; lf = lbf; lb2 = lbb;
                        Zp = Zhg + t0 * HGIN; OLp = OL + t0 * DM; Uf = U + ((size_t)(sq + 0) * 16 + sc) * 16384; Ub = U + ((size_t)(sq + 1) * 16 + sc) * 16384; Df = Dk + ((sq + 0) * 16 + sc) * 128; Db = Dk + ((sq + 1) * 16 + sc) * 128; }
                    else { const int uc = u - n0, b = uc >> 3; h = uc & 7; const int sq = (b * 8 + h) * 2; T = CTXL; lf = lbs + (0 * 2 + cidx) * 1024; lb2 = lbs + (1 * 2 + cidx) * 1024;
                        Zp = Zc + (size_t)b * CTXL * HGIN; OLp = OLc + (size_t)b * CTXL * DM; Uf = Uctx + (size_t)(sq + 0) * 16384; Ub = Uctx + (size_t)(sq + 1) * 16384; Df = Dctx + (sq + 0) * 128; Db = Dctx + (sq + 1) * 128; }
#ifndef NO_SCAN1
                    scan_unit_mfma(smem, Zp, T, h, lf, lb2, OLp, Uf, Ub, Df, Db);
#endif
                }
            }
            if (type == T_SCAN2) {
#ifndef NO_SCAN2
                scan_pass2(U, Dk, Uctx, s);
#endif
            } else if (type == T_SCAN3) {
#ifndef NO_SCAN3
                for (int u = bid; u < 1024; u += nblk) scan_pass3_unit(smem, Zhg, OL, U, normw, u >> 9, (u >> 6) & 7, u & 63);
#endif
            }
            if (type == T_MIX || ctype == T_MIX) {
                const int n0 = type == T_MIX ? 256 : 0, nu = n0 + (ctype == T_MIX ? 16 : 0);
                for (int u = bid; u < nu; u += nblk) { const bool c = u >= n0; const int uu = c ? u - n0 : u; const int ix = (c ? cl : l) >> 1;
                    const bf16_t* wsb = (const bf16_t*)(ws + OFF_WS_B) + (size_t)ix * 8 * 128 * 128;
#ifndef NO_MIX
                    sgu_mix_unit(smem, c ? Zc : Zb, uu >> 1, uu & 1, wsb, p.in[16] + ix * 8 * 128, p.in[13] + ix * SGW, p.in[14] + ix * SGW);
#endif
                }
            }
            if (type == T_LN1 || type == T_LN2) {
                const int which = type == T_LN1 ? 0 : 1;
                const float* modn = type == T_LN1 ? modl + 3072 : mod + (size_t)(l + 1) * 5 * 6144;
                const bool want_mod = type == T_LN1 || l < 3;
                ln_mod(out, out, want_mod ? hmod : nullptr, p.in[6] + (l * 2 + which) * DM, p.in[7] + (l * 2 + which) * DM, true, modn + 0, modn + 1024, MLAT, SEQ, 0);
            }
        }
        if (ctype == T_READOUT) {
#ifndef NO_CTXR
            ctx_readout(Zc, OLc, p.in[10]);
#endif
        } else if (ctype == T_CONV) {
#ifndef NO_CONV
            conv_swiglu(Zc, actc, p.in[19] + (size_t)cl * 3 * UPW, p.in[20] + (size_t)cl * UPW, MCTX, CTXL);
#endif
        } else if (ctype == T_LN1 || ctype == T_LN2) {
            const int which = ctype == T_LN1 ? 0 : 1;
            const float* modn = ctype == T_LN1 ? mod + (size_t)cl * 5 * 6144 + 3072 : mod + (size_t)(cl + 1) * 5 * 6144;
            ln_mod(hc, hc, hcmod, p.in[6] + (cl * 2 + which) * DM, p.in[7] + (cl * 2 + which) * DM, true, modn + 0, modn + 1024, MCTX, 1 << 30, 4);
        }
        if (ph + 1 < NPHASES) xcd_barrier(xb);
    }
}

extern "C" void kernel_launch(void* const* d_in, const int* in_sizes, int n_in, void* d_out, int out_size, void* d_ws, size_t ws_size, hipStream_t stream) {
    static int grid_blocks = 0;
    if (!grid_blocks) {
        int dev = 0, cus = 0, per_cu = 0;
        hipGetDevice(&dev);
        hipDeviceGetAttribute(&cus, hipDeviceAttributeMultiprocessorCount, dev);
        hipFuncSetAttribute((const void*)fwd_megakernel, hipFuncAttributeMaxDynamicSharedMemorySize, LDS_BYTES);
        hipOccupancyMaxActiveBlocksPerMultiprocessor(&per_cu, (const void*)fwd_megakernel, 512, LDS_BYTES);
        if (per_cu < 1) per_cu = 1;
        grid_blocks = cus * per_cu;
        (void)hipGetLastError();
    }
    if (n_in != 22 || ws_size < WS_END) { fprintf(stderr, "kernel_launch: unexpected inputs (n_in %d, ws %zu < %zu)\n", n_in, ws_size, (size_t)WS_END); return; }
    (void)hipMemsetAsync((unsigned char*)d_ws + OFF_BAR, 0, (size_t)XCD_BAR_WORDS * 4, stream);
    Params p{};
    for (int i = 0; i < 22; ++i) p.in[i] = (const float*)d_in[i];
    p.out = (float*)d_out; p.ws = (unsigned char*)d_ws;
    void* args[] = {&p};
    hipError_t e = hipLaunchCooperativeKernel((const void*)fwd_megakernel, dim3(grid_blocks), dim3(512), args, LDS_BYTES, stream);
    if (e != hipSuccess) fprintf(stderr, "cooperative launch failed: %s (grid %d)\n", hipGetErrorString(e), grid_blocks);
}
```

```cpp
#include <hip/hip_runtime.h>
#include <hip/hip_cooperative_groups.h>
#include <cstdio>
namespace cg = cooperative_groups;

typedef unsigned short bf16_t;
typedef short bf16x8 __attribute__((ext_vector_type(8)));
typedef float f32x4 __attribute__((ext_vector_type(4)));
typedef float f32x2 __attribute__((ext_vector_type(2)));
typedef unsigned u32x4 __attribute__((ext_vector_type(4)));
typedef unsigned u32x2 __attribute__((ext_vector_type(2)));

__device__ __forceinline__ unsigned cvt_pk_bf16(float lo, float hi) { unsigned r; asm volatile("v_cvt_pk_bf16_f32 %0, %1, %2" : "=v"(r) : "v"(lo), "v"(hi)); return r; }
__device__ __forceinline__ bf16_t f2bf(float f) { return (bf16_t)(cvt_pk_bf16(f, 0.f) & 0xffffu); }
__device__ __forceinline__ float bf2f(bf16_t b) { return __uint_as_float(((unsigned)b) << 16); }
__device__ __forceinline__ float bflo(unsigned w) { return __uint_as_float(w << 16); }
__device__ __forceinline__ float bfhi(unsigned w) { return __uint_as_float(w & 0xffff0000u); }
__device__ __forceinline__ float silu_f(float v) { return v * __builtin_amdgcn_rcpf(1.0f + __expf(-v)); }
__device__ __forceinline__ float sigmoid_f(float v) { return __builtin_amdgcn_rcpf(1.0f + __expf(-v)); }
__device__ __forceinline__ f32x2 gelu_pk(f32x2 v) {
    const f32x2 av = __builtin_elementwise_abs(v), d = av * 0.2316418882f + 1.0f;
    f32x2 t; t.x = __builtin_amdgcn_rcpf(d.x); t.y = __builtin_amdgcn_rcpf(d.y);
    f32x2 q = t * 0.5307027145f + (-0.7265760135f); q = q * t + 0.7107068705f; q = q * t + (-0.142248368f); q = q * t + 0.127414796f; q = q * t;
    const f32x2 s = (v * v) * (-0.72134752044f);
    f32x2 e; e.x = __builtin_amdgcn_exp2f(s.x); e.y = __builtin_amdgcn_exp2f(s.y);
    const f32x2 m = v * (q * e), r = v - m;
    f32x2 o; o.x = v.x < 0.f ? m.x : r.x; o.y = v.y < 0.f ? m.y : r.y; return o;
}

constexpr int WTAB_OFF = 131072 + 512;
__device__ __forceinline__ int hw_slot() { return (int)(__builtin_amdgcn_s_getreg((5 << 11) | 4) & 0x3fu); }
__device__ __forceinline__ int tidx() {
    extern __shared__ __attribute__((aligned(16))) unsigned char smem_t[];
    const int w = *(volatile __attribute__((address_space(3))) int*)((__attribute__((address_space(3))) unsigned char*)smem_t + WTAB_OFF + 4 * hw_slot());
    int lane; asm volatile("v_mbcnt_lo_u32_b32 %0, -1, 0\n\tv_mbcnt_hi_u32_b32 %0, -1, %0" : "=v"(lane));
    return __builtin_amdgcn_readfirstlane(w) * 64 + lane; }
__device__ __forceinline__ int bidx() { int b = blockIdx.x; asm volatile("" : "+s"(b)); return b; }


#define XB_TMO      128
#define XB_XCNT(j)  (256  + 64 * (j))
#define XB_XSUB(j)  (1280 + 64 * (j))
#define XB_XGEN(j)  (2304 + 64 * (j))
#define XB_TOP      3328
#define XB_TOPGEN   3392
#define XCD_BAR_WORDS 3456
#define XB_SPIN_CAP (1u << 20)
#define XLAS __attribute__((address_space(3)))
__device__ __forceinline__ unsigned xb_ld(unsigned* p)              { return __hip_atomic_load(p, __ATOMIC_RELAXED, __HIP_MEMORY_SCOPE_AGENT); }
__device__ __forceinline__ unsigned xb_add(unsigned* p, unsigned v) { return __hip_atomic_fetch_add(p, v, __ATOMIC_RELAXED, __HIP_MEMORY_SCOPE_AGENT); }
__device__ __forceinline__ unsigned xb_xcc_id() { return (unsigned)__builtin_amdgcn_s_getreg((3 << 11) | 20) & 0xFu; }
#define XB_SPIN(cond, bar) do { unsigned _sp = 0; while (cond) { __builtin_amdgcn_s_sleep(1); \
    if ((++_sp & 255u) == 0u) { if (xb_ld(&(bar)[XB_TMO])) break; if (_sp > XB_SPIN_CAP) { atomicAdd(&(bar)[XB_TMO], 1u); break; } } } } while (0)
struct XcdBarrier { unsigned* bar; unsigned x; volatile XLAS unsigned* st; };
__device__ __forceinline__ XcdBarrier xcd_barrier_post(unsigned* bar, volatile XLAS unsigned* st) {
    XcdBarrier b; b.bar = bar; b.x = xb_xcc_id(); b.st = st;
    if (threadIdx.x == 0) (void)xb_add(&bar[XB_XCNT(b.x)], 1u);
    return b;
}
__device__ __forceinline__ void xcd_barrier_complete(unsigned* bar, unsigned x, unsigned& nloc, unsigned& nx) {
    const unsigned G = gridDim.x * gridDim.y * gridDim.z;
    unsigned sum, cnt, mine, sp = 0u;
    for (;;) {
        sum = 0u; cnt = 0u; mine = 0u;
#pragma unroll
        for (unsigned j = 0; j < 16; ++j) { const unsigned c = xb_ld(&bar[XB_XCNT(j)]); sum += c; cnt += (c > 0u) ? 1u : 0u; mine = (j == x) ? c : mine; }
        if (sum == G) break;
        __builtin_amdgcn_s_sleep(1);
        if ((++sp & 255u) == 0u) { if (xb_ld(&bar[XB_TMO])) break; if (sp > XB_SPIN_CAP) { atomicAdd(&bar[XB_TMO], 1u); break; } }
    }
    nloc = mine > 0u ? mine : 1u; nx = cnt > 0u ? cnt : 1u;
}
__device__ __forceinline__ void xcd_barrier(const XcdBarrier& b) {
    asm volatile("s_waitcnt vmcnt(0)" ::: "memory");
    __syncthreads();
    if (tidx() == 0) {
        unsigned* bar = b.bar; asm volatile("" : "+s"(bar));
        __builtin_amdgcn_s_waitcnt(0);
        unsigned nloc = b.st[0], nx = b.st[1];
        if (nloc == 0u) { xcd_barrier_complete(bar, b.x, nloc, nx); b.st[0] = nloc; b.st[1] = nx; }
        const unsigned old = xb_add(&bar[XB_XSUB(b.x)], 1u);
        const unsigned gen = old / nloc;
        if (old + 1u == (gen + 1u) * nloc) {
            __builtin_amdgcn_fence(__ATOMIC_RELEASE, "agent");
            asm volatile("s_waitcnt vmcnt(0)" ::: "memory");
            const unsigned og = xb_add(&bar[XB_TOP], 1u);
            const unsigned tg = og / nx;
            if (og + 1u == (tg + 1u) * nx) xb_add(&bar[XB_TOPGEN], 1u);
            else XB_SPIN(xb_ld(&bar[XB_TOPGEN]) == tg, bar);
            __builtin_amdgcn_fence(__ATOMIC_ACQUIRE, "agent");
            xb_add(&bar[XB_XGEN(b.x)], 1u);
            asm volatile("s_waitcnt vmcnt(0)" ::: "memory");
        } else {
            XB_SPIN(xb_ld(&bar[XB_XGEN(b.x)]) == gen, bar);
            __builtin_amdgcn_fence(__ATOMIC_ACQUIRE, "agent");
            asm volatile("s_waitcnt vmcnt(0)" ::: "memory");
        }
    }
    __syncthreads();
}

__device__ __forceinline__ void lds_barrier() { asm volatile("s_waitcnt lgkmcnt(0)" ::: "memory"); __builtin_amdgcn_s_barrier(); asm volatile("" ::: "memory"); }

__device__ __forceinline__ float shx(float v, int o, int lane) { return __int_as_float(__builtin_amdgcn_ds_bpermute((lane ^ o) << 2, __float_as_int(v))); }
__device__ __forceinline__ float opq(float c) { asm volatile("" : "+s"(c)); return c; }
__device__ __forceinline__ f32x4 zero4() { const float z = opq(0.f); return (f32x4){z, z, z, z}; }

constexpr int DM = 1024, NB = 4, SEQ = 8192, CTXL = 256, MLAT = NB * SEQ, MCTX = NB * CTXL;
constexpr int HGIN = 5120, SGW = 3072, SGIN = 6144, DFF = 2816, UPW = 5632;
constexpr int SLAB = 16384;
constexpr float ALPHA_F = 1.6817928305074292f;
constexpr int LDP = 136;

constexpr size_t al256(size_t x) { return (x + 255) & ~(size_t)255; }
constexpr size_t OFF_WT_HGIN = 0;
constexpr size_t OFF_WT_HGOUT = OFF_WT_HGIN + al256((size_t)2 * HGIN * DM * 2);
constexpr size_t OFF_WT_SGIN = OFF_WT_HGOUT + al256((size_t)2 * DM * DM * 2);
constexpr size_t OFF_WT_SGOUT = OFF_WT_SGIN + al256((size_t)2 * SGIN * DM * 2);
constexpr size_t OFF_WT_UP = OFF_WT_SGOUT + al256((size_t)2 * DM * SGW * 2);
constexpr size_t OFF_WT_DOWN = OFF_WT_UP + al256((size_t)4 * UPW * DM * 2);
constexpr size_t OFF_WS_B = OFF_WT_DOWN + al256((size_t)4 * DM * DFF * 2);
constexpr size_t OFF_MOD = OFF_WS_B + al256((size_t)2 * 8 * 128 * 128 * 2);
constexpr size_t OFF_LBS = OFF_MOD + al256((size_t)4 * 5 * 6144 * 4);
constexpr size_t OFF_HMOD = OFF_LBS + al256((size_t)2 * 2 * 1024 * 4);
constexpr size_t OFF_HC = OFF_HMOD + al256((size_t)MLAT * DM * 2);
constexpr size_t OFF_HCMOD = OFF_HC + al256((size_t)MCTX * DM * 4);
constexpr size_t OFF_ZC = OFF_HCMOD + al256((size_t)MCTX * DM * 2);
constexpr size_t OFF_ACTC = OFF_ZC + al256((size_t)MCTX * SGIN * 2);
constexpr size_t OFF_OLC = OFF_ACTC + al256((size_t)MCTX * DFF * 2);
constexpr size_t OFF_UCTX = OFF_OLC + al256((size_t)MCTX * DM * 2);
constexpr size_t OFF_DCTX = OFF_UCTX + al256((size_t)NB * 8 * 2 * 16384 * 4);
constexpr size_t OFF_BAR = OFF_DCTX + al256((size_t)NB * 8 * 2 * 128 * 4);
constexpr size_t OFF_BIG = OFF_BAR + al256((size_t)XCD_BAR_WORDS * 4);
constexpr size_t BIG_HG_Z = 0;
constexpr size_t BIG_HG_OL = BIG_HG_Z + (size_t)SLAB * HGIN * 2;
constexpr size_t BIG_HG_U = BIG_HG_OL + (size_t)SLAB * DM * 2;
constexpr size_t BIG_HG_D = BIG_HG_U + (size_t)32 * 16 * 16384 * 4;
constexpr size_t BIG_HG_END = BIG_HG_D + (size_t)32 * 16 * 128 * 4;
constexpr size_t BIG_FF_ACT = (size_t)SLAB * UPW * 2;
constexpr size_t BIG_FF_END = BIG_FF_ACT + (size_t)SLAB * DFF * 2;
constexpr size_t BIG_SG_END = (size_t)SLAB * SGIN * 2;
constexpr size_t BIG_BYTES = BIG_FF_END > BIG_HG_END ? (BIG_FF_END > BIG_SG_END ? BIG_FF_END : BIG_SG_END) : (BIG_HG_END > BIG_SG_END ? BIG_HG_END : BIG_SG_END);
constexpr size_t WS_END = OFF_BIG + BIG_BYTES;
static_assert(WS_END <= (size_t)536870912, "workspace map exceeds the guaranteed 512 MiB");
constexpr int LDS_BYTES = 144 * 1024;

struct Params { const float* in[22]; float* out; unsigned char* ws; };
namespace pg8 {
#define PG8_LAS __attribute__((address_space(3)))
constexpr int BM = 256, BK = 64, HALF = 128, HTB = HALF * BK * 2, STAGE_BYTES = 8 * HTB, NXCD = 8, WGM = 8;
__host__ __device__ __forceinline__ int lds_byte(int r, int c) { const int st = (r >> 4) * 2 + (c >> 5), rr = r & 15, cc = c & 31, ob = rr * 64 + cc * 2; return st * 1024 + (ob ^ (((ob >> 9) & 1) << 5)); }
__host__ __device__ __forceinline__ void stage_rc(int b, int& R, int& C) { const int st = b / 1024, sb = b % 1024, swz = sb ^ (((sb >> 9) & 1) << 5); R = (st >> 1) * 16 + swz / 64; C = (st & 1) * 32 + (swz % 64) / 2; }
__host__ __device__ __forceinline__ int perm32(int rho) { const int n = rho >> 4, i = rho & 15; return 8 * (i >> 2) + 4 * n + (i & 3); }
struct Unit { int pm, pn; };
struct Gemm { const bf16_t* A; const bf16_t* Bt; int M, N, K, lda; };
struct StaticOrder {
    int nM, nN, nwg, G, c;
    __device__ void init(int M, int N, int G_, int c_) { nM = M / BM; nN = N / BM; nwg = nM * nN; G = G_; c = c_; }
    __device__ bool next(int i, Unit& u) const {
        const long L = (long)i * G + c; if (L >= nwg) return false;
        int wgid = (int)L; { const int q = nwg / NXCD, r = nwg % NXCD, xcd = wgid % NXCD, off = wgid / NXCD; wgid = (xcd < r ? xcd * (q + 1) : r * (q + 1) + (xcd - r) * q) + off; }
        const int nig = WGM * nN, gid = wgid / nig, fm = gid * WGM, gsz = (nM - fm) < WGM ? (nM - fm) : WGM;
        u.pm = fm + ((wgid % nig) % gsz); u.pn = (wgid % nig) / gsz; return true;
    }
};
template <class Epi>
__device__ __forceinline__ void gemm_phase(PG8_LAS unsigned char* lds, const Gemm g, const StaticOrder& S, const Epi& E) {
    const bool perm = E.perm();
    const int tid = tidx(), wid = __builtin_amdgcn_readfirstlane(tid >> 6), lane = tid & 63, wr = wid >> 2, wc = wid & 3, fr = lane & 15, fq = lane >> 4;
    const int K = g.K, nt = K / BK, lda = g.lda;
    unsigned voffA[2], voffB[2];
#pragma unroll
    for (int i = 0; i < 2; ++i) { int R, C; stage_rc(tid * 16 + i * 8192, R, C); const int Rb = perm ? ((R & ~31) + perm32(R & 31)) : R;
        voffA[i] = (unsigned)(R * lda + C) * 2u; voffB[i] = (unsigned)(Rb * K + C) * 2u; }
    const size_t kstep = (size_t)(BK * 2);
    const size_t hstepA = (size_t)HALF * lda * 2, hstepB = (size_t)HALF * K * 2;
    const size_t tstepA = 2 * hstepA, tstepB = 2 * hstepB;
    const unsigned ldsw = (unsigned)wid * 1024u;
    const int aoff = lds_byte(wr * 64 + fr, fq * 8), boff = lds_byte(wc * 32 + fr, fq * 8);
#define PG8_SA(b, h) (((b) * 2 + (h)) * HTB)
#define PG8_SB(b, h) ((4 + (b) * 2 + (h)) * HTB)
#define PG8_R64_voffA r64A
#define PG8_R64_voffB r64B
#define PG8_R64(v) PG8_R64_##v
#define PG8_STAGE(bufoff, gbase, voff) do { _Pragma("unroll") for (int _i = 0; _i < 2; ++_i) \
        __builtin_amdgcn_global_load_lds((const unsigned*)((const char*)(gbase) + (voff)[_i]), (PG8_LAS unsigned*)(lds + (bufoff) + ldsw + _i * 8192), 16, 0, 0); } while (0)
#define PG8_LDA(dst, b, h) do { _Pragma("unroll") for (int m = 0; m < 4; ++m) _Pragma("unroll") for (int k = 0; k < 2; ++k) dst[m][k] = *(const PG8_LAS bf16x8*)(lds + PG8_SA(b, h) + aoff + m * 2048 + k * 1024); } while (0)
#define PG8_LDB(dst, b, h) do { _Pragma("unroll") for (int n = 0; n < 2; ++n) _Pragma("unroll") for (int k = 0; k < 2; ++k) dst[n][k] = *(const PG8_LAS bf16x8*)(lds + PG8_SB(b, h) + boff + n * 2048 + k * 1024); } while (0)
#define PG8_MMA(ai, bj, At, Bt) do { __builtin_amdgcn_s_setprio(1); _Pragma("unroll") for (int m = 0; m < 4; ++m) _Pragma("unroll") for (int n = 0; n < 2; ++n) _Pragma("unroll") for (int k = 0; k < 2; ++k) \
        acc[ai][bj][m][n] = __builtin_amdgcn_mfma_f32_16x16x32_bf16(Bt[n][k], At[m][k], acc[ai][bj][m][n], 0, 0, 0); __builtin_amdgcn_s_setprio(0); } while (0)
#define PG8_WAIT_V(n) asm volatile("s_waitcnt vmcnt(" #n ")" ::: "memory")
#define PG8_WAIT_L(n) asm volatile("s_waitcnt lgkmcnt(" #n ")" ::: "memory")
#define PG8_BAR __builtin_amdgcn_s_barrier()
#define PG8_SCHED __builtin_amdgcn_sched_barrier(0)
    Unit cur, nxt; int ui = 0;
    if (!S.next(0, cur)) return;
    f32x4 acc[2][2][4][2];
#pragma unroll
    for (int a = 0; a < 2; ++a)
#pragma unroll
        for (int b = 0; b < 2; ++b)
#pragma unroll
            for (int m = 0; m < 4; ++m)
#pragma unroll
                for (int n = 0; n < 2; ++n) acc[a][b][m][n] = (f32x4){0.f, 0.f, 0.f, 0.f};
    bf16x8 At[4][2], B0[2][2], B1[2][2];
    const char* cA = (const char*)g.A + (size_t)cur.pm * tstepA; const char* cB = (const char*)g.Bt + (size_t)cur.pn * tstepB;
    PG8_STAGE(PG8_SB(0, 0), cB, voffB); PG8_STAGE(PG8_SA(0, 0), cA, voffA); PG8_STAGE(PG8_SB(0, 1), cB + hstepB, voffB); PG8_STAGE(PG8_SA(0, 1), cA + hstepA, voffA);
    if (wr == 1) PG8_BAR;
    PG8_WAIT_V(4); PG8_BAR;
    PG8_STAGE(PG8_SB(1, 0), cB + kstep, voffB); PG8_STAGE(PG8_SA(1, 0), cA + kstep, voffA); PG8_STAGE(PG8_SB(1, 1), cB + hstepB + kstep, voffB);
    PG8_WAIT_V(6); PG8_BAR;
    for (;;) {
        const bool has_next = S.next(ui + 1, nxt);
        const char* nA = has_next ? (const char*)g.A + (size_t)nxt.pm * tstepA : cA; const char* nB = has_next ? (const char*)g.Bt + (size_t)nxt.pn * tstepB : cB;
        for (int t = 0; t < nt; t += 2) {
            const bool last = (t == nt - 2);
            const char* a1 = cA + (size_t)(t + 1) * kstep;
            const char* a2 = last ? nA : cA + (size_t)(t + 2) * kstep; const char* b2 = last ? nB : cB + (size_t)(t + 2) * kstep;
            const char* a3 = a2 + kstep; const char* b3 = b2 + kstep;
            PG8_LDB(B0, 0, 0); PG8_SCHED; PG8_LDA(At, 0, 0); PG8_STAGE(PG8_SA(1, 1), a1 + hstepA, voffA);
            PG8_WAIT_L(8); PG8_BAR; PG8_WAIT_L(0); PG8_MMA(0, 0, At, B0); PG8_BAR; PG8_SCHED;
            PG8_LDB(B1, 0, 1); PG8_STAGE(PG8_SB(0, 0), b2, voffB);
            PG8_BAR; PG8_WAIT_L(0); PG8_MMA(0, 1, At, B1); PG8_BAR;
            PG8_LDA(At, 0, 1); PG8_STAGE(PG8_SA(0, 0), a2, voffA);
            PG8_BAR; PG8_WAIT_L(0); PG8_MMA(1, 0, At, B0); PG8_BAR; PG8_SCHED;
            PG8_STAGE(PG8_SB(0, 1), b2 + hstepB, voffB);
            PG8_WAIT_V(6); PG8_BAR; PG8_MMA(1, 1, At, B1); PG8_BAR;
            PG8_LDB(B0, 1, 0); PG8_SCHED; PG8_LDA(At, 1, 0); PG8_STAGE(PG8_SA(0, 1), a2 + hstepA, voffA);
            PG8_WAIT_L(8); PG8_BAR; PG8_WAIT_L(0); PG8_MMA(0, 0, At, B0); PG8_BAR; PG8_SCHED;
            PG8_LDB(B1, 1, 1); PG8_STAGE(PG8_SB(1, 0), b3, voffB);
            PG8_BAR; PG8_WAIT_L(0); PG8_MMA(0, 1, At, B1); PG8_BAR;
            PG8_LDA(At, 1, 1); PG8_STAGE(PG8_SA(1, 0), a3, voffA);
            PG8_BAR; PG8_WAIT_L(0); PG8_MMA(1, 0, At, B0); PG8_BAR; PG8_SCHED;
            PG8_STAGE(PG8_SB(1, 1), b3 + hstepB, voffB);
            PG8_WAIT_V(6); PG8_BAR; PG8_MMA(1, 1, At, B1); PG8_BAR;
        }
        E(acc, cur, wr, wc, fr, fq);
        if (!has_next) break;
#pragma unroll
        for (int a = 0; a < 2; ++a)
#pragma unroll
            for (int b = 0; b < 2; ++b)
#pragma unroll
                for (int m = 0; m < 4; ++m)
#pragma unroll
                    for (int n = 0; n < 2; ++n) acc[a][b][m][n] = (f32x4){0.f, 0.f, 0.f, 0.f};
        cur = nxt; cA = nA; cB = nB; ++ui;
    }
    PG8_WAIT_V(0);
    if (wr == 0) PG8_BAR;
    PG8_BAR;
#undef PG8_SA
#undef PG8_SB
#undef PG8_STAGE
#undef PG8_LDA
#undef PG8_LDB
#undef PG8_MMA
#undef PG8_WAIT_V
#undef PG8_WAIT_L
#undef PG8_BAR
#undef PG8_SCHED
}
}
struct EpiAny {
    int kind;
    bf16_t* O; int ldc; int mode; int silu_tiles;
    const float* hin; float* out; const float* gate; int b0; int ctx;
    __device__ __forceinline__ bool perm() const { return kind != 1; }
    __device__ __forceinline__ void operator()(const f32x4 (&acc)[2][2][4][2], const pg8::Unit& u, int wr, int wc, int fr, int fq) const {
        if (kind == 0) {
            const int row0 = u.pm * 256 + wr * 64 + fr, col0 = u.pn * 256 + wc * 32 + 8 * fq;
            const bool do_silu = (mode == 1) && (u.pn < silu_tiles);
#pragma unroll
            for (int ai = 0; ai < 2; ++ai)
#pragma unroll
                for (int m = 0; m < 4; ++m) { bf16_t* rowp = O + (size_t)(row0 + ai * 128 + m * 16) * ldc + col0;
#pragma unroll
                    for (int bj = 0; bj < 2; ++bj) { f32x4 v0 = acc[ai][bj][m][0], v1 = acc[ai][bj][m][1];
                        if (mode == 2) { f32x2 a = gelu_pk((f32x2){v0[0], v0[1]}), b = gelu_pk((f32x2){v0[2], v0[3]}), c = gelu_pk((f32x2){v1[0], v1[1]}), d = gelu_pk((f32x2){v1[2], v1[3]});
                            v0 = (f32x4){a.x, a.y, b.x, b.y}; v1 = (f32x4){c.x, c.y, d.x, d.y}; }
                        else if (do_silu) {
#pragma unroll
                            for (int j = 0; j < 4; ++j) { v0[j] = silu_f(v0[j]); v1[j] = silu_f(v1[j]); } }
                        u32x4 w; w.x = cvt_pk_bf16(v0[0], v0[1]); w.y = cvt_pk_bf16(v0[2], v0[3]); w.z = cvt_pk_bf16(v1[0], v1[1]); w.w = cvt_pk_bf16(v1[2], v1[3]);
                        *(u32x4*)(rowp + bj * 128) = w; }
                    asm volatile("" ::: "memory"); }
        } else if (kind == 2) {
            const float* cw = hin; const float* cb = gate;
            const bool first = fr == 0, lastl = fr == 15;
#pragma unroll 1
            for (int n = 0; n < 2; ++n) {
                const int j0 = u.pn * 128 + wc * 32 + 8 * fq + 4 * n;
                f32x4 wa[3], wg[3], ba, bg;
#pragma unroll
                for (int k = 0; k < 3; ++k) { wa[k] = *(const f32x4*)(cw + k * UPW + j0); wg[k] = *(const f32x4*)(cw + k * UPW + DFF + j0); }
                ba = *(const f32x4*)(cb + j0); bg = *(const f32x4*)(cb + DFF + j0);
#pragma unroll
                for (int ai = 0; ai < 2; ++ai) {
                    float res[4][4];
#pragma unroll
                    for (int e = 0; e < 4; ++e) {
                        float ya[4], yg[4];
#pragma unroll
                        for (int m = 0; m < 4; ++m) { ya[m] = n == 0 ? acc[ai][0][m][0][e] : acc[ai][0][m][1][e]; yg[m] = n == 0 ? acc[ai][1][m][0][e] : acc[ai][1][m][1][e]; }
#pragma unroll
                        for (int m = 0; m < 4; ++m) {
                            const float pa = m > 0 ? ya[m - 1] : 0.f, na = m < 3 ? ya[m + 1] : 0.f, pg = m > 0 ? yg[m - 1] : 0.f, ng = m < 3 ? yg[m + 1] : 0.f;
                            const float la = __int_as_float(__builtin_amdgcn_update_dpp(0, __float_as_int(lastl ? pa : ya[m]), 0x121, 0xf, 0xf, false));
                            const float ra = __int_as_float(__builtin_amdgcn_update_dpp(0, __float_as_int(first ? na : ya[m]), 0x12F, 0xf, 0xf, false));
                            const float lg = __int_as_float(__builtin_amdgcn_update_dpp(0, __float_as_int(lastl ? pg : yg[m]), 0x121, 0xf, 0xf, false));
                            const float rg = __int_as_float(__builtin_amdgcn_update_dpp(0, __float_as_int(first ? ng : yg[m]), 0x12F, 0xf, 0xf, false));
                            const float av = wa[0][e] * la + wa[1][e] * ya[m] + wa[2][e] * ra + ba[e];
                            const float gv = wg[0][e] * lg + wg[1][e] * yg[m] + wg[2][e] * rg + bg[e];
                            res[m][e] = silu_f(gv) * av;
                        }
                    }
#pragma unroll
                    for (int m = 0; m < 4; ++m) { u32x2 w; w.x = cvt_pk_bf16(res[m][0], res[m][1]); w.y = cvt_pk_bf16(res[m][2], res[m][3]);
                        *(u32x2*)(O + (size_t)(u.pm * 256 + ai * 128 + wr * 64 + m * 16 + fr) * ldc + j0) = w; }
                }
            }
        } else {
            const int row0 = u.pm * 256 + wr * 64 + fr, col0 = u.pn * 256 + wc * 32 + 4 * fq;
            const int b = ctx ? 4 : b0 + (u.pm * 256) / SEQ;
            const float* gp = gate + (size_t)b * 6144 + col0;
            f32x4 gv[2][2];
#pragma unroll
            for (int bj = 0; bj < 2; ++bj)
#pragma unroll
                for (int n = 0; n < 2; ++n) gv[bj][n] = *(const f32x4*)(gp + bj * 128 + n * 16);
#pragma unroll
            for (int ai = 0; ai < 2; ++ai)
#pragma unroll
                for (int m = 0; m < 4; ++m) { const size_t off = (size_t)(row0 + ai * 128 + m * 16) * DM + col0;
#pragma unroll
                    for (int bj = 0; bj < 2; ++bj)
#pragma unroll
                        for (int n = 0; n < 2; ++n) { const f32x4 h4 = *(const f32x4*)(hin + off + bj * 128 + n * 16);
                            *(f32x4*)(out + off + bj * 128 + n * 16) = h4 * ALPHA_F + gv[bj][n] * acc[ai][bj][m][n]; }
                    asm volatile("" ::: "memory"); }
        }
    }
};
struct GemmJob { const bf16_t* A; const bf16_t* Bt; int lda, M, N, K; EpiAny e; };
constexpr int EPI_LDS_OFF = 131072;
struct EpiLds {
    int kind0;
    __device__ __forceinline__ bool perm() const { return kind0 != 1; }
    __device__ __forceinline__ void operator()(const f32x4 (&acc)[2][2][4][2], const pg8::Unit& u, int wr, int wc, int fr, int fq) const {
        extern __shared__ __attribute__((aligned(16))) unsigned char smem_e[];
        const volatile __attribute__((address_space(3))) unsigned* dw = (const volatile __attribute__((address_space(3))) unsigned*)((__attribute__((address_space(3))) unsigned char*)smem_e + EPI_LDS_OFF);
        union { EpiAny e; unsigned w[sizeof(EpiAny) / 4]; } d;
#pragma unroll
        for (int i = 0; i < (int)(sizeof(EpiAny) / 4); ++i) d.w[i] = __builtin_amdgcn_readfirstlane(dw[i]);
        d.e(acc, u, wr, wc, fr, fq);
    }
};
__device__ __forceinline__ void gemm_call(unsigned char* smem, const GemmJob& j) {
    __syncthreads();
    if (tidx() == 0) *(EpiAny*)(smem + EPI_LDS_OFF) = j.e;
    __syncthreads();
    pg8::Gemm g; g.A = j.A; g.Bt = j.Bt; g.M = j.M; g.N = j.N; g.K = j.K; g.lda = j.lda;
    pg8::StaticOrder S; S.init(j.M, j.N, (int)gridDim.x, bidx());
    EpiLds el; el.kind0 = j.e.kind;
    pg8::gemm_phase<EpiLds>((PG8_LAS unsigned char*)smem, g, S, el);
}

__device__ void transpose_cvt(const float* src, bf16_t* dst, int nmat, int K, int N, int ffn_perm, float* tile  ) {
    const int tid = tidx(), tk = K / 64, tn = N / 64, per = tk * tn, total = nmat * per;
    for (int u = bidx(); u < total; u += gridDim.x) {
        const int mi = u / per, r = u % per, kt = r / tn, ntl = r % tn;
        const float* s = src + (size_t)mi * K * N + (size_t)(kt * 64) * N + ntl * 64;
#pragma unroll
        for (int i = 0; i < 2; ++i) { const int row = (tid >> 4) + 32 * i, c4 = (tid & 15) * 4; const f32x4 v = *(const f32x4*)(s + (size_t)row * N + c4);
            tile[row * 65 + c4 + 0] = v[0]; tile[row * 65 + c4 + 1] = v[1]; tile[row * 65 + c4 + 2] = v[2]; tile[row * 65 + c4 + 3] = v[3]; }
        __syncthreads();
        { const int n = tid >> 3, k8 = (tid & 7) * 8; int ng = ntl * 64 + n;
          if (ffn_perm) ng = ng < DFF ? ((ng >> 7) * 256 + (ng & 127)) : ((((ng - DFF) >> 7) * 256) + 128 + ((ng - DFF) & 127));
          u32x4 w; w.x = cvt_pk_bf16(tile[(k8 + 0) * 65 + n], tile[(k8 + 1) * 65 + n]); w.y = cvt_pk_bf16(tile[(k8 + 2) * 65 + n], tile[(k8 + 3) * 65 + n]);
          w.z = cvt_pk_bf16(tile[(k8 + 4) * 65 + n], tile[(k8 + 5) * 65 + n]); w.w = cvt_pk_bf16(tile[(k8 + 6) * 65 + n], tile[(k8 + 7) * 65 + n]);
          *(u32x4*)(dst + (size_t)mi * K * N + (size_t)ng * K + kt * 64 + k8) = w; }
        __syncthreads();
    }
}
__device__ void phase0(const Params& p, unsigned char* smem) {
    const int tid = tidx();
    unsigned char* ws = p.ws;
    float* mod = (float*)(ws + OFF_MOD);
    {
        float* sc = (float*)smem; float* red = sc + 5 * 1024;
        const float* c = p.in[1]; const float* cctx = p.in[3]; const float* ada_w = p.in[4]; const float* ada_b = p.in[5];
        for (int i = tid; i < 5 * 1024; i += 512) { const float v = i < 4096 ? c[i] : cctx[i - 4096]; sc[i] = silu_f(v); }
        __syncthreads();
        for (int u = bidx(); u < 256; u += gridDim.x) {
            const int l = u >> 6, col0 = (u & 63) * 96, cq = tid % 24, kp = tid / 24;
            float acc[5][4];
#pragma unroll
            for (int r = 0; r < 5; ++r)
#pragma unroll
                for (int e = 0; e < 4; ++e) acc[r][e] = 0.f;
            if (kp < 21) {
                for (int k = kp; k < 1024; k += 21) { const f32x4 w = *(const f32x4*)(ada_w + ((size_t)l * 1024 + k) * 6144 + col0 + cq * 4);
#pragma unroll
                    for (int r = 0; r < 5; ++r) { const float s = sc[r * 1024 + k];
#pragma unroll
                        for (int e = 0; e < 4; ++e) acc[r][e] += s * w[e]; } }
#pragma unroll
                for (int r = 0; r < 5; ++r)
#pragma unroll
                    for (int e = 0; e < 4; ++e) red[(kp * 5 + r) * 96 + cq * 4 + e] = acc[r][e];
            }
            __syncthreads();
            if (tid < 480) { const int r = tid / 96, cc = tid % 96; float s = ada_b[l * 6144 + col0 + cc];
                for (int k2 = 0; k2 < 21; ++k2) s += red[(k2 * 5 + r) * 96 + cc];
                mod[((size_t)l * 5 + r) * 6144 + col0 + cc] = s; }
            __syncthreads();
        }
    }
    if (bidx() == 0) {
        const float* hg_lb = p.in[9]; float* lbs = (float*)(ws + OFF_LBS);
        for (int i = tid; i < 2048; i += 512) { const int dir = i >> 10, k = i & 1023; const float a0 = hg_lb[(dir * 2 + 0) * 1024 + k], a1 = hg_lb[(dir * 2 + 1) * 1024 + k];
            lbs[(dir * 2 + 0) * 1024 + k] = 0.f; lbs[(dir * 2 + 1) * 1024 + k] = 1.0f / (1.0f + expf(a0 - a1)); }
    }
    {
        const float* s = p.in[15]; bf16_t* d = (bf16_t*)(ws + OFF_WS_B);
        for (int i = bidx() * 512 + tid; i < 2 * 8 * 128 * 128 / 4; i += gridDim.x * 512) { const f32x4 v = *(const f32x4*)(s + (size_t)i * 4); u32x2 w; w.x = cvt_pk_bf16(v[0], v[1]); w.y = cvt_pk_bf16(v[2], v[3]); *(u32x2*)(d + (size_t)i * 4) = w; }
    }
    __syncthreads();
    float* tile = (float*)smem;
    transpose_cvt(p.in[8], (bf16_t*)(ws + OFF_WT_HGIN), 2, DM, HGIN, 0, tile);
    transpose_cvt(p.in[11], (bf16_t*)(ws + OFF_WT_HGOUT), 2, DM, DM, 0, tile);
    transpose_cvt(p.in[12], (bf16_t*)(ws + OFF_WT_SGIN), 2, DM, SGIN, 0, tile);
    transpose_cvt(p.in[17], (bf16_t*)(ws + OFF_WT_SGOUT), 2, SGW, DM, 0, tile);
    transpose_cvt(p.in[18], (bf16_t*)(ws + OFF_WT_UP), 4, DM, UPW, 1, tile);
    transpose_cvt(p.in[21], (bf16_t*)(ws + OFF_WT_DOWN), 4, DFF, DM, 0, tile);
}

__device__ void ln_mod(const float* src, float* hdst, bf16_t* mdst, const float* lng, const float* lnb, bool do_ln,
                       const float* shift, const float* scale, int nrows, int rows_per_b, int b0) {
    const int tid = tidx(), lane = tid & 63, gw = bidx() * 8 + (tid >> 6), nw = gridDim.x * 8;
    f32x4 g4[4], b4[4];
#pragma unroll
    for (int i = 0; i < 4; ++i) { g4[i] = do_ln ? *(const f32x4*)(lng + i * 256 + lane * 4) : zero4(); b4[i] = do_ln ? *(const f32x4*)(lnb + i * 256 + lane * 4) : zero4(); }
    f32x4 xn[2][4];
    int row0 = gw * 2;
    if (row0 < nrows) {
#pragma unroll
        for (int rr = 0; rr < 2; ++rr) { const int row = row0 + rr < nrows ? row0 + rr : row0; const float* s = src + (size_t)row * DM;
#pragma unroll
            for (int i = 0; i < 4; ++i) xn[rr][i] = *(const f32x4*)(s + i * 256 + lane * 4); }
    }
    for (; row0 < nrows; row0 += nw * 2) {
        f32x4 x[2][4];
#pragma unroll
        for (int rr = 0; rr < 2; ++rr)
#pragma unroll
            for (int i = 0; i < 4; ++i) x[rr][i] = xn[rr][i];
        const int nrow0 = row0 + nw * 2;
        if (nrow0 < nrows) {
#pragma unroll
            for (int rr = 0; rr < 2; ++rr) { const int row = nrow0 + rr < nrows ? nrow0 + rr : nrow0; const float* s = src + (size_t)row * DM;
#pragma unroll
                for (int i = 0; i < 4; ++i) xn[rr][i] = *(const f32x4*)(s + i * 256 + lane * 4); }
        }
        f32x4 s4[4], c4[4];
        if (mdst) { const int bb = b0 + row0 / rows_per_b; const float* sh = shift + (size_t)bb * 6144; const float* scl = scale + (size_t)bb * 6144;
#pragma unroll
            for (int i = 0; i < 4; ++i) { s4[i] = *(const f32x4*)(sh + i * 256 + lane * 4); c4[i] = *(const f32x4*)(scl + i * 256 + lane * 4) + 1.0f; } }
        if (do_ln) {
            float sm0 = 0.f, sm1 = 0.f;
#pragma unroll
            for (int i = 0; i < 4; ++i) { sm0 += (x[0][i][0] + x[0][i][1]) + (x[0][i][2] + x[0][i][3]); sm1 += (x[1][i][0] + x[1][i][1]) + (x[1][i][2] + x[1][i][3]); }
#pragma unroll
            for (int o = 32; o >= 1; o >>= 1) { sm0 += shx(sm0, o, lane); sm1 += shx(sm1, o, lane); }
            const float m0 = sm0 * (1.0f / 1024.0f), m1 = sm1 * (1.0f / 1024.0f); float q0 = 0.f, q1 = 0.f;
#pragma unroll
            for (int i = 0; i < 4; ++i) { const f32x4 d0 = x[0][i] - m0, d1 = x[1][i] - m1; q0 += (d0[0] * d0[0] + d0[1] * d0[1]) + (d0[2] * d0[2] + d0[3] * d0[3]); q1 += (d1[0] * d1[0] + d1[1] * d1[1]) + (d1[2] * d1[2] + d1[3] * d1[3]); }
#pragma unroll
            for (int o = 32; o >= 1; o >>= 1) { q0 += shx(q0, o, lane); q1 += shx(q1, o, lane); }
            const float r0 = rsqrtf(q0 * (1.0f / 1024.0f) + opq(1e-5f)), r1 = rsqrtf(q1 * (1.0f / 1024.0f) + opq(1e-5f));
#pragma unroll
            for (int i = 0; i < 4; ++i) { x[0][i] = (x[0][i] - m0) * r0 * g4[i] + b4[i]; x[1][i] = (x[1][i] - m1) * r1 * g4[i] + b4[i]; }
        }
#pragma unroll
        for (int rr = 0; rr < 2; ++rr) {
            const int row = row0 + rr; if (row >= nrows) break;
            if (do_ln) {
#pragma unroll
                for (int i = 0; i < 4; ++i) *(f32x4*)(hdst + (size_t)row * DM + i * 256 + lane * 4) = x[rr][i]; }
            if (mdst) {
#pragma unroll
                for (int i = 0; i < 4; ++i) { const f32x4 y = x[rr][i] * c4[i] + s4[i]; u32x2 w; w.x = cvt_pk_bf16(y[0], y[1]); w.y = cvt_pk_bf16(y[2], y[3]);
                    *(u32x2*)(mdst + (size_t)row * DM + i * 256 + lane * 4) = w; } }
        }
    }
}

template <bool SWZ>
__device__ __forceinline__ void tile_mma_128(const bf16_t* la, const bf16_t* lb, f32x4 (&acc)[8], int w, int fr, int fq) {
#pragma unroll
    for (int kk = 0; kk < 4; ++kk) {
        const bf16x8 a = *(const bf16x8*)(la + (16 * w + fr) * LDP + kk * 32 + fq * 8);
#pragma unroll
        for (int nb = 0; nb < 8; ++nb) { const int col = SWZ ? ((kk * 32 + fq * 8) ^ ((16 * nb + fr) & 0x78)) : (kk * 32 + fq * 8);
            const bf16x8 b = *(const bf16x8*)(lb + (16 * nb + fr) * LDP + col);
            acc[nb] = __builtin_amdgcn_mfma_f32_16x16x32_bf16(b, a, acc[nb], 0, 0, 0); }
    }
}

__device__ void scan_unit_mfma(unsigned char* smem, bf16_t* Z, int T, int h, const float* lbf, const float* lbb, bf16_t* OL, float* Uf, float* Ub, float* Df, float* Db) {
    bf16_t* rq = (bf16_t*)smem; bf16_t* rz = rq + 4096; bf16_t* rv = rz + 4096;
    float* tot = (float*)(smem + 24576); float* EG = tot + 512;
    bf16_t* QS = (bf16_t*)(smem + 27136); bf16_t* QE = QS + 32 * 136; bf16_t* KS0 = QE + 32 * 136; bf16_t* KS1 = KS0 + 16 * 136;
    bf16_t* KET = KS1 + 32 * 136; bf16_t* VT = KET + 128 * 40; bf16_t* Pm = VT + 128 * 40; bf16_t* ST = Pm + 32 * 40;
    const int tid = tidx(), lane = tid & 63, w = tid >> 6, fr = lane & 15, fq = lane >> 4, kc = tid & 127, g = tid >> 7;
    for (int dir = 0; dir < 2; ++dir) {
        const int zcol = (dir ? 4096 : 3072) + h * 128;
        const float lbk = ((dir ? lbb : lbf) + h * 128)[kc];
        float Lprev = 0.f;
        f32x4 sacc[8];
#pragma unroll
        for (int dt = 0; dt < 8; ++dt) sacc[dt] = (f32x4){0.f, 0.f, 0.f, 0.f};
        __syncthreads();
        for (int i = tid; i < 128 * 136 / 8; i += 512) ((u32x4*)ST)[i] = (u32x4){0u, 0u, 0u, 0u};
        u32x4 pfq, pfz, pfv;
        {   const int t = tid >> 4, c8 = (tid & 15) * 8, tok = dir ? (T - 1 - t) : t; const bf16_t* zr = Z + (size_t)tok * HGIN;
            pfq = *(const u32x4*)(zr + h * 128 + c8); pfz = *(const u32x4*)(zr + zcol + c8); pfv = *(const u32x4*)(zr + 2048 + h * 128 + c8); }
#pragma unroll 1
        for (int ch = 0; ch < T / 32; ++ch) {
            lds_barrier();
            {   const int t = tid >> 4, c8 = (tid & 15) * 8;
                *(u32x4*)(rq + t * 128 + c8) = pfq; *(u32x4*)(rz + t * 128 + c8) = pfz; *(u32x4*)(rv + t * 128 + c8) = pfv;
                if (ch + 1 < T / 32) { const int pos = (ch + 1) * 32 + t, tok = dir ? (T - 1 - pos) : pos; const bf16_t* zr = Z + (size_t)tok * HGIN;
                    pfq = *(const u32x4*)(zr + h * 128 + c8); pfz = *(const u32x4*)(zr + zcol + c8); pfv = *(const u32x4*)(zr + 2048 + h * 128 + c8); } }
            u32x2 oprev[2] = {(u32x2){0u, 0u}, (u32x2){0u, 0u}};
            if (dir) {
#pragma unroll
                for (int tt = 0; tt < 2; ++tt) { const int pos = ch * 32 + 16 * tt + fr, tok = T - 1 - pos; oprev[tt] = *(const u32x2*)(OL + (size_t)tok * DM + h * 128 + 16 * w + 4 * fq); } }
            lds_barrier();
            float lg[8], kk[8], qv[8]; float run = 0.f;
#pragma unroll
            for (int i = 0; i < 8; ++i) { const int t = 8 * g + i; const float z = bf2f(rz[t * 128 + kc]); const float f = lbk + (1.0f - lbk) * sigmoid_f(z);
                kk[i] = 1.0f - f; run += __logf(f); lg[i] = run; qv[i] = bf2f(rq[t * 128 + kc]); }
            tot[g * 128 + kc] = run;
            {   u32x4 pk; unsigned short e[8];
#pragma unroll
                for (int i = 0; i < 8; ++i) e[i] = rv[(8 * g + i) * 128 + kc];
                pk.x = (unsigned)e[0] | ((unsigned)e[1] << 16); pk.y = (unsigned)e[2] | ((unsigned)e[3] << 16); pk.z = (unsigned)e[4] | ((unsigned)e[5] << 16); pk.w = (unsigned)e[6] | ((unsigned)e[7] << 16);
                *(u32x4*)(VT + kc * 40 + 8 * g) = pk; }
            lds_barrier();
            {   const float t0 = tot[kc], t1 = tot[128 + kc], t2 = tot[256 + kc], t3 = tot[384 + kc];
                const float base = g == 0 ? 0.f : g == 1 ? t0 : g == 2 ? t0 + t1 : t0 + t1 + t2;
                const float R1 = t0 + t1, gend = R1 + t2 + t3, Rb = g >= 2 ? R1 : 0.f, eRb = g >= 2 ? __expf(R1) : 1.0f, ePrev = __expf(Lprev), eEnd1 = __expf(gend - R1);
                float kev[8];
#pragma unroll
                for (int i = 0; i < 8; ++i) { const int t = 8 * g + i; const float G = base + lg[i];
                    const float qs = qv[i] * __expf(G - Rb), qe = qs * eRb, ks1 = kk[i] * __expf(fminf(R1 - G, 80.f));
                    QS[t * 136 + kc] = f2bf(qs); QE[t * 136 + kc] = f2bf(qe); KS1[t * 136 + kc] = f2bf(ks1);
                    if (g < 2) KS0[t * 136 + kc] = f2bf(kk[i] * __expf(fminf(-G, 80.f)));
                    kev[i] = ks1 * eEnd1;
                    const int pos = ch * 32 + t, tok = dir ? (T - 1 - pos) : pos; Z[(size_t)tok * HGIN + zcol + kc] = f2bf(qe * ePrev); }
                u32x4 pk; pk.x = cvt_pk_bf16(kev[0], kev[1]); pk.y = cvt_pk_bf16(kev[2], kev[3]); pk.z = cvt_pk_bf16(kev[4], kev[5]); pk.w = cvt_pk_bf16(kev[6], kev[7]);
                *(u32x4*)(KET + kc * 40 + 8 * g) = pk;
                if (g == 0) EG[kc] = __expf(gend);
                Lprev += gend; }
            lds_barrier();
            if (w < 3) {
                const int ti = w == 0 ? 0 : 1, sj = w == 2 ? 1 : 0; const bf16_t* ksb = w == 0 ? KS0 : KS1;
                f32x4 c = (f32x4){0.f, 0.f, 0.f, 0.f};
#pragma unroll
                for (int k4 = 0; k4 < 4; ++k4) { const bf16x8 a = *(const bf16x8*)(ksb + (16 * sj + fr) * 136 + k4 * 32 + fq * 8), bb = *(const bf16x8*)(QS + (16 * ti + fr) * 136 + k4 * 32 + fq * 8);
                    c = __builtin_amdgcn_mfma_f32_16x16x32_bf16(a, bb, c, 0, 0, 0); }
                if (ti == sj) {
#pragma unroll
                    for (int r = 0; r < 4; ++r) if (4 * fq + r > fr) c[r] = 0.f; }
                u32x2 pw; pw.x = cvt_pk_bf16(c[0], c[1]); pw.y = cvt_pk_bf16(c[2], c[3]);
                *(u32x2*)(Pm + (16 * ti + fr) * 40 + 16 * sj + 4 * fq) = pw;
            } else if (w == 3) { *(u32x2*)(Pm + fr * 40 + 16 + 4 * fq) = (u32x2){0u, 0u}; }
            lds_barrier();
            {   f32x4 o0 = (f32x4){0.f, 0.f, 0.f, 0.f}, o1 = o0;
#pragma unroll
                for (int k4 = 0; k4 < 4; ++k4) { const bf16x8 a = *(const bf16x8*)(ST + (16 * w + fr) * 136 + k4 * 32 + fq * 8);
                    const bf16x8 b0 = *(const bf16x8*)(QE + fr * 136 + k4 * 32 + fq * 8), b1 = *(const bf16x8*)(QE + (16 + fr) * 136 + k4 * 32 + fq * 8);
                    o0 = __builtin_amdgcn_mfma_f32_16x16x32_bf16(a, b0, o0, 0, 0, 0); o1 = __builtin_amdgcn_mfma_f32_16x16x32_bf16(a, b1, o1, 0, 0, 0); }
                {   const bf16x8 a = *(const bf16x8*)(VT + (16 * w + fr) * 40 + fq * 8), b0 = *(const bf16x8*)(Pm + fr * 40 + fq * 8), b1 = *(const bf16x8*)(Pm + (16 + fr) * 40 + fq * 8);
                    o0 = __builtin_amdgcn_mfma_f32_16x16x32_bf16(a, b0, o0, 0, 0, 0); o1 = __builtin_amdgcn_mfma_f32_16x16x32_bf16(a, b1, o1, 0, 0, 0); }
#pragma unroll
                for (int tt = 0; tt < 2; ++tt) { f32x4 r = tt ? o1 : o0; const int pos = ch * 32 + 16 * tt + fr, tok = dir ? (T - 1 - pos) : pos;
                    bf16_t* op = OL + (size_t)tok * DM + h * 128 + 16 * w + 4 * fq;
                    if (dir) { const u32x2 pv = oprev[tt]; r[0] += bflo(pv.x); r[1] += bfhi(pv.x); r[2] += bflo(pv.y); r[3] += bfhi(pv.y); }
                    u32x2 wv; wv.x = cvt_pk_bf16(r[0], r[1]); wv.y = cvt_pk_bf16(r[2], r[3]); *(u32x2*)op = wv; }
                const f32x4 eg4 = *(const f32x4*)(EG + 16 * w + 4 * fq);
                const bf16x8 ak = *(const bf16x8*)(KET + (16 * w + fr) * 40 + fq * 8);
#pragma unroll
                for (int dt = 0; dt < 8; ++dt) { const bf16x8 bv = *(const bf16x8*)(VT + (16 * dt + fr) * 40 + fq * 8);
                    sacc[dt] = __builtin_amdgcn_mfma_f32_16x16x32_bf16(ak, bv, sacc[dt] * eg4, 0, 0, 0); }
            }
            lds_barrier();
#pragma unroll
            for (int dt = 0; dt < 8; ++dt) { u32x2 sw; sw.x = cvt_pk_bf16(sacc[dt][0], sacc[dt][1]); sw.y = cvt_pk_bf16(sacc[dt][2], sacc[dt][3]);
                *(u32x2*)(ST + (16 * dt + fr) * 136 + 16 * w + 4 * fq) = sw; }
        }
        float* U = dir ? Ub : Uf;
#pragma unroll
        for (int dt = 0; dt < 8; ++dt) *(f32x4*)(U + (16 * dt + fr) * 128 + 16 * w + 4 * fq) = sacc[dt];
        if (g == 0) (dir ? Db : Df)[kc] = __expf(Lprev);
    }
    __syncthreads();
}
__device__ void scan_pass2(float* U, const float* Dk, const float* Uctx, int s) {
    const int gt = bidx() * 512 + tidx(), nt = gridDim.x * 512;
    for (int e4 = gt; e4 < 32 * 4096; e4 += nt) {
        const int seq = e4 >> 12, el = (e4 & 4095) * 4, k = el & 127, bl = seq >> 4, hd = seq & 15, dir = seq & 1;
        f32x4 cur = *(const f32x4*)(Uctx + (size_t)((s * 2 + bl) * 16 + hd) * 16384 + el);
        for (int jj = 0; jj < 16; ++jj) { const int j = dir ? 15 - jj : jj; float* up = U + ((size_t)seq * 16 + j) * 16384 + el;
            const f32x4 tmp = *(const f32x4*)up; *(f32x4*)up = cur; const f32x4 dk = *(const f32x4*)(Dk + (seq * 16 + j) * 128 + k); cur = cur * dk + tmp; }
    }
}
__device__ void scan_pass3_unit(unsigned char* smem, bf16_t* Z, const bf16_t* OL, const float* U, const float* normw, int bl, int h, int tile) {
    bf16_t* la = (bf16_t*)smem; bf16_t* lb = la + 128 * LDP;
    const int tid = tidx(), w = tid >> 6, lane = tid & 63, fr = lane & 15, fq = lane >> 4;
    const int tok0 = bl * SEQ + tile * 128, j = tile >> 2, tok = tok0 + 16 * w + fr;
    u32x4 ra[2][4]; f32x4 rb[2][4][2]; u32x2 rol[8], rg[8];
#pragma unroll
    for (int dir = 0; dir < 2; ++dir) {
        const int zcol = (dir ? 4096 : 3072) + h * 128; const float* Sp = U + ((size_t)((bl * 8 + h) * 2 + dir) * 16 + j) * 16384;
#pragma unroll
        for (int i = 0; i < 4; ++i) { const int c = tid + 512 * i, r = c >> 4, k8 = (c & 15) * 8;
            ra[dir][i] = *(const u32x4*)(Z + (size_t)(tok0 + r) * HGIN + zcol + k8);
            rb[dir][i][0] = *(const f32x4*)(Sp + r * 128 + k8); rb[dir][i][1] = *(const f32x4*)(Sp + r * 128 + k8 + 4); }
    }
#pragma unroll
    for (int nb = 0; nb < 8; ++nb) { rol[nb] = *(const u32x2*)(OL + (size_t)tok * DM + h * 128 + 16 * nb + 4 * fq); rg[nb] = *(const u32x2*)(Z + (size_t)tok * HGIN + 1024 + h * 128 + 16 * nb + 4 * fq); }
    f32x4 acc[8];
#pragma unroll
    for (int nb = 0; nb < 8; ++nb) acc[nb] = (f32x4){0.f, 0.f, 0.f, 0.f};
#pragma unroll
    for (int dir = 0; dir < 2; ++dir) {
        lds_barrier();
#pragma unroll
        for (int i = 0; i < 4; ++i) { const int c = tid + 512 * i, r = c >> 4, k8 = (c & 15) * 8;
            *(u32x4*)(la + r * LDP + k8) = ra[dir][i];
            u32x4 pk; pk.x = cvt_pk_bf16(rb[dir][i][0][0], rb[dir][i][0][1]); pk.y = cvt_pk_bf16(rb[dir][i][0][2], rb[dir][i][0][3]); pk.z = cvt_pk_bf16(rb[dir][i][1][0], rb[dir][i][1][1]); pk.w = cvt_pk_bf16(rb[dir][i][1][2], rb[dir][i][1][3]);
            *(u32x4*)(lb + r * LDP + k8) = pk; }
        lds_barrier();
        tile_mma_128<false>(la, lb, acc, w, fr, fq);
    }
    float ss = 0.f;
#pragma unroll
    for (int nb = 0; nb < 8; ++nb) { const u32x2 pv = rol[nb];
        acc[nb][0] += bflo(pv.x); acc[nb][1] += bfhi(pv.x); acc[nb][2] += bflo(pv.y); acc[nb][3] += bfhi(pv.y);
        ss += (acc[nb][0] * acc[nb][0] + acc[nb][1] * acc[nb][1]) + (acc[nb][2] * acc[nb][2] + acc[nb][3] * acc[nb][3]); }
    ss += shx(ss, 16, lane); ss += shx(ss, 32, lane);
    const float rn = rsqrtf(ss * (1.0f / 128.0f) + opq(1e-6f));
#pragma unroll
    for (int nb = 0; nb < 8; ++nb) { bf16_t* gp = Z + (size_t)tok * HGIN + 1024 + h * 128 + 16 * nb + 4 * fq; const u32x2 gv = rg[nb];
        const f32x4 nw = *(const f32x4*)(normw + 16 * nb + 4 * fq);
        u32x2 wv; wv.x = cvt_pk_bf16(acc[nb][0] * rn * nw[0] * bflo(gv.x), acc[nb][1] * rn * nw[1] * bfhi(gv.x));
        wv.y = cvt_pk_bf16(acc[nb][2] * rn * nw[2] * bflo(gv.y), acc[nb][3] * rn * nw[3] * bfhi(gv.y)); *(u32x2*)gp = wv; }
}
__device__ void ctx_readout(bf16_t* Zc, const bf16_t* OLc, const float* normw) {
    const int lane = tidx() & 63, gw = bidx() * 8 + (tidx() >> 6), nw = gridDim.x * 8;
    for (int row = gw; row < MCTX; row += nw) {
        const bf16_t* op = OLc + (size_t)row * DM + lane * 16; bf16_t* gp = Zc + (size_t)row * HGIN + 1024 + lane * 16;
        const u32x4 o0 = *(const u32x4*)op, o1 = *(const u32x4*)(op + 8);
        float o[16] = {bflo(o0.x), bfhi(o0.x), bflo(o0.y), bfhi(o0.y), bflo(o0.z), bfhi(o0.z), bflo(o0.w), bfhi(o0.w), bflo(o1.x), bfhi(o1.x), bflo(o1.y), bfhi(o1.y), bflo(o1.z), bfhi(o1.z), bflo(o1.w), bfhi(o1.w)};
        float ss = 0.f;
#pragma unroll
        for (int e = 0; e < 16; ++e) ss += o[e] * o[e];
        ss += shx(ss, 1, lane); ss += shx(ss, 2, lane); ss += shx(ss, 4, lane);
        const float rn = rsqrtf(ss * (1.0f / 128.0f) + opq(1e-6f));
        const u32x4 g0 = *(const u32x4*)gp, g1 = *(const u32x4*)(gp + 8);
        const float g[16] = {bflo(g0.x), bfhi(g0.x), bflo(g0.y), bfhi(g0.y), bflo(g0.z), bfhi(g0.z), bflo(g0.w), bfhi(g0.w), bflo(g1.x), bfhi(g1.x), bflo(g1.y), bfhi(g1.y), bflo(g1.z), bfhi(g1.z), bflo(g1.w), bfhi(g1.w)};
        const float* nwp = normw + (lane & 7) * 16;
#pragma unroll
        for (int e = 0; e < 16; ++e) o[e] = o[e] * rn * nwp[e] * g[e];
        u32x4 w0, w1; w0.x = cvt_pk_bf16(o[0], o[1]); w0.y = cvt_pk_bf16(o[2], o[3]); w0.z = cvt_pk_bf16(o[4], o[5]); w0.w = cvt_pk_bf16(o[6], o[7]);
        w1.x = cvt_pk_bf16(o[8], o[9]); w1.y = cvt_pk_bf16(o[10], o[11]); w1.z = cvt_pk_bf16(o[12], o[13]); w1.w = cvt_pk_bf16(o[14], o[15]);
        *(u32x4*)gp = w0; *(u32x4*)(gp + 8) = w1;
    }
}

__device__ void sgu_mix_unit(unsigned char* smem, bf16_t* Z, int chunk, int gh, const bf16_t* wsb  , const float* bs  , const float* lng, const float* lnb) {
    float* stats = (float*)smem;
    bf16_t* la = (bf16_t*)(smem + 1024); bf16_t* lb = la + 128 * LDP;
    const int tid = tidx(), w = tid >> 6, lane = tid & 63, fr = lane & 15, fq = lane >> 4;
    const int t0 = chunk * 128;
    __syncthreads();
    for (int i = 0; i < 16; i += 2) {
        float x[2][48]; float sm[2] = {0.f, 0.f}, qq[2] = {0.f, 0.f};
#pragma unroll
        for (int rr = 0; rr < 2; ++rr) { const bf16_t* vr = Z + (size_t)(t0 + 16 * w + i + rr) * SGIN + SGW + lane * 8;
#pragma unroll
            for (int c = 0; c < 6; ++c) { const u32x4 v = *(const u32x4*)(vr + c * 512);
                x[rr][c * 8 + 0] = bflo(v.x); x[rr][c * 8 + 1] = bfhi(v.x); x[rr][c * 8 + 2] = bflo(v.y); x[rr][c * 8 + 3] = bfhi(v.y); x[rr][c * 8 + 4] = bflo(v.z); x[rr][c * 8 + 5] = bfhi(v.z); x[rr][c * 8 + 6] = bflo(v.w); x[rr][c * 8 + 7] = bfhi(v.w); } }
#pragma unroll
        for (int rr = 0; rr < 2; ++rr) {
#pragma unroll
            for (int e = 0; e < 48; ++e) sm[rr] += x[rr][e]; }
#pragma unroll
        for (int o = 32; o >= 1; o >>= 1) { sm[0] += shx(sm[0], o, lane); sm[1] += shx(sm[1], o, lane); }
#pragma unroll
        for (int rr = 0; rr < 2; ++rr) { const float mean = sm[rr] * (1.0f / 3072.0f); sm[rr] = mean;
#pragma unroll
            for (int e = 0; e < 48; ++e) { const float dd = x[rr][e] - mean; qq[rr] += dd * dd; } }
#pragma unroll
        for (int o = 32; o >= 1; o >>= 1) { qq[0] += shx(qq[0], o, lane); qq[1] += shx(qq[1], o, lane); }
        if (lane == 0) {
#pragma unroll
            for (int rr = 0; rr < 2; ++rr) { stats[(16 * w + i + rr) * 2] = sm[rr]; stats[(16 * w + i + rr) * 2 + 1] = rsqrtf(qq[rr] * (1.0f / 3072.0f) + opq(1e-5f)); } }
    }
    u32x4 vreg[4];
#pragma unroll
    for (int i = 0; i < 4; ++i) { const int c = tid + 512 * i, q = c >> 4, c8 = (c & 15) * 8; vreg[i] = *(const u32x4*)(Z + (size_t)(t0 + q) * SGIN + SGW + (gh * 4) * 384 + c8); }
#pragma unroll 1
    for (int it = 0; it < 12; ++it) {
        const int g = gh * 4 + it / 3, cb = it % 3, cg0 = g * 384 + cb * 128;
        lds_barrier();
        if (cb == 0) {
#pragma unroll
            for (int i = 0; i < 4; ++i) { const int c = tid + 512 * i, r = c >> 4, k8 = (c & 15) * 8; *(u32x4*)(la + r * LDP + k8) = *(const u32x4*)(wsb + ((size_t)g * 128 + r) * 128 + k8); }
        }
#pragma unroll
        for (int i = 0; i < 4; ++i) { const int c = tid + 512 * i, q = c >> 4, c8 = (c & 15) * 8;
            const u32x4 v = vreg[i];
            const float mean = stats[q * 2], rstd = stats[q * 2 + 1];
            const float xv[8] = {bflo(v.x), bfhi(v.x), bflo(v.y), bfhi(v.y), bflo(v.z), bfhi(v.z), bflo(v.w), bfhi(v.w)};
            const f32x4 g0 = *(const f32x4*)(lng + cg0 + c8), g1 = *(const f32x4*)(lng + cg0 + c8 + 4), b0 = *(const f32x4*)(lnb + cg0 + c8), b1 = *(const f32x4*)(lnb + cg0 + c8 + 4);
#pragma unroll
            for (int e = 0; e < 8; ++e) { const float gg = e < 4 ? g0[e & 3] : g1[e & 3], bb = e < 4 ? b0[e & 3] : b1[e & 3];
                lb[(c8 + e) * LDP + (q ^ (c8 & 0x78))] = f2bf((xv[e] - mean) * rstd * gg + bb); } }
        if (it + 1 < 12) { const int gn = gh * 4 + (it + 1) / 3, cn = gn * 384 + ((it + 1) % 3) * 128;
#pragma unroll
            for (int i = 0; i < 4; ++i) { const int c = tid + 512 * i, q = c >> 4, c8 = (c & 15) * 8; vreg[i] = *(const u32x4*)(Z + (size_t)(t0 + q) * SGIN + SGW + cn + c8); } }
        const int pr = 16 * w + fr;
        u32x2 ureg[8];
#pragma unroll
        for (int nb = 0; nb < 8; ++nb) ureg[nb] = *(const u32x2*)(Z + (size_t)(t0 + pr) * SGIN + cg0 + 16 * nb + 4 * fq);
        const float bias = bs[g * 128 + pr];
        lds_barrier();
        f32x4 acc[8];
#pragma unroll
        for (int nb = 0; nb < 8; ++nb) acc[nb] = (f32x4){0.f, 0.f, 0.f, 0.f};
        tile_mma_128<true>(la, lb, acc, w, fr, fq);
#pragma unroll
        for (int nb = 0; nb < 8; ++nb) { bf16_t* up = Z + (size_t)(t0 + pr) * SGIN + cg0 + 16 * nb + 4 * fq; const u32x2 uv = ureg[nb];
            u32x2 wv; wv.x = cvt_pk_bf16(bflo(uv.x) * (acc[nb][0] + bias), bfhi(uv.x) * (acc[nb][1] + bias)); wv.y = cvt_pk_bf16(bflo(uv.y) * (acc[nb][2] + bias), bfhi(uv.y) * (acc[nb][3] + bias));
            *(u32x2*)up = wv; }
    }
}

__device__ void conv_swiglu(const bf16_t* Z, bf16_t* act, const float* cw, const float* cb, int rows, int row_len) {
    const int gt = bidx() * 512 + tidx(), nt = gridDim.x * 512, total = rows * 352;
    for (int i = gt; i < total; i += nt) {
        const int t = i / 352, j8 = (i % 352) * 8, np = (j8 >> 7) * 256 + (j8 & 127), pos = t % row_len;
        const bool hasL = pos != 0, hasR = pos != row_len - 1;
        const bf16_t* zr = Z + (size_t)t * UPW + np; const u32x4 zero = (u32x4){0u, 0u, 0u, 0u};
        const u32x4 a1 = *(const u32x4*)zr, g1 = *(const u32x4*)(zr + 128);
        const u32x4 a0 = hasL ? *(const u32x4*)(zr - UPW) : zero, g0 = hasL ? *(const u32x4*)(zr - UPW + 128) : zero;
        const u32x4 a2 = hasR ? *(const u32x4*)(zr + UPW) : zero, g2 = hasR ? *(const u32x4*)(zr + UPW + 128) : zero;
        float r[8];
#pragma unroll
        for (int e = 0; e < 8; ++e) { const int j = j8 + e; const unsigned sh = (e & 1) ? 0u : 16u;
            const unsigned wa0 = e < 2 ? a0.x : e < 4 ? a0.y : e < 6 ? a0.z : a0.w, wa1 = e < 2 ? a1.x : e < 4 ? a1.y : e < 6 ? a1.z : a1.w, wa2 = e < 2 ? a2.x : e < 4 ? a2.y : e < 6 ? a2.z : a2.w;
            const unsigned wg0 = e < 2 ? g0.x : e < 4 ? g0.y : e < 6 ? g0.z : g0.w, wg1 = e < 2 ? g1.x : e < 4 ? g1.y : e < 6 ? g1.z : g1.w, wg2 = e < 2 ? g2.x : e < 4 ? g2.y : e < 6 ? g2.z : g2.w;
            const float fa0 = __uint_as_float((wa0 << sh) & 0xffff0000u), fa1 = __uint_as_float((wa1 << sh) & 0xffff0000u), fa2 = __uint_as_float((wa2 << sh) & 0xffff0000u);
            const float fg0 = __uint_as_float((wg0 << sh) & 0xffff0000u), fg1 = __uint_as_float((wg1 << sh) & 0xffff0000u), fg2 = __uint_as_float((wg2 << sh) & 0xffff0000u);
            const float av = cw[j] * fa0 + cw[UPW + j] * fa1 + cw[2 * UPW + j] * fa2 + cb[j];
            const float gv = cw[DFF + j] * fg0 + cw[UPW + DFF + j] * fg1 + cw[2 * UPW + DFF + j] * fg2 + cb[DFF + j];
            r[e] = silu_f(gv) * av; }
        u32x4 w; w.x = cvt_pk_bf16(r[0], r[1]); w.y = cvt_pk_bf16(r[2], r[3]); w.z = cvt_pk_bf16(r[4], r[5]); w.w = cvt_pk_bf16(r[6], r[7]);
        *(u32x4*)(act + (size_t)t * DFF + j8) = w;
    }
}
enum { T_NONE = 0, T_P0, T_INIT, T_GEMM_IN, T_SCAN1, T_SCAN2, T_SCAN3, T_MIX, T_GEMM_OUT, T_LN1, T_GEMM_UP, T_CONV, T_GEMM_DN, T_LN2, T_READOUT };
constexpr int NPHASES = 2 + 14 + 10 + 14 + 10;
__device__ __forceinline__ void decode_phase(int ph, int& type, int& l, int& s) {
    l = 0; s = 0;
    if (ph == 0) { type = T_P0; return; }
    if (ph == 1) { type = T_INIT; return; }
    int q = ph - 2;
    if (q < 14) l = 0; else if (q < 24) { l = 1; q -= 14; } else if (q < 38) { l = 2; q -= 24; } else { l = 3; q -= 38; }
    const int half = (l & 1) ? 3 : 5, nm = 2 * half;
    if (q < nm) { s = q / half; const int st = q % half;
        if (l & 1) type = st == 0 ? T_GEMM_IN : st == 1 ? T_MIX : T_GEMM_OUT;
        else type = st == 0 ? T_GEMM_IN : st == 1 ? T_SCAN1 : st == 2 ? T_SCAN2 : st == 3 ? T_SCAN3 : T_GEMM_OUT;
        return; }
    q -= nm;
    type = q == 0 ? T_LN1 : q == 1 ? T_GEMM_UP : q == 2 ? T_GEMM_DN : T_LN2;
}
__device__ __forceinline__ void decode_ctx(int ph, int& type, int& l) {
    const int c = ph - 2; type = T_NONE; l = 0;
    if (c < 0 || c > 18) return;
    if (c < 9) { l = 0; type = c == 0 ? T_GEMM_IN : c == 1 ? T_SCAN1 : c == 2 ? T_READOUT : c == 3 ? T_GEMM_OUT : c == 4 ? T_LN1 : c == 5 ? T_GEMM_UP : c == 6 ? T_CONV : c == 7 ? T_GEMM_DN : T_LN2; }
    else if (c < 17) { const int d = c - 9; l = 1; type = d == 0 ? T_GEMM_IN : d == 1 ? T_MIX : d == 2 ? T_GEMM_OUT : d == 3 ? T_LN1 : d == 4 ? T_GEMM_UP : d == 5 ? T_CONV : d == 6 ? T_GEMM_DN : T_LN2; }
    else { l = 2; type = c == 17 ? T_GEMM_IN : T_SCAN1; }
}
__device__ __forceinline__ bool is_gemm(int t) { return t == T_GEMM_IN || t == T_GEMM_OUT || t == T_GEMM_UP || t == T_GEMM_DN; }
__global__ __launch_bounds__(512, 2) void fwd_megakernel(Params p) {
    extern __shared__ __attribute__((aligned(16))) unsigned char smem[];
    { cg::grid_group grid = cg::this_grid(); grid.sync(); }
    unsigned char* ws0 = p.ws;
    const int nblk = gridDim.x, bid = bidx();
    unsigned char* ws = ws0;
    volatile XLAS unsigned* xst = (volatile XLAS unsigned*)((XLAS unsigned char*)smem + 131072 + 256);
    if (threadIdx.x == 0) { xst[0] = 0u; xst[1] = 0u; xst[2] = 0u; xst[3] = 0u; }
    if ((threadIdx.x & 63) == 0) *(volatile XLAS int*)((XLAS unsigned char*)smem + WTAB_OFF + 4 * hw_slot()) = (int)(threadIdx.x >> 6);
    __syncthreads();
    const XcdBarrier xb = xcd_barrier_post((unsigned*)(ws + OFF_BAR), xst);
#ifdef PROBE_MASK
    unsigned long long pr_acc = 0ull, pr_t0 = __builtin_amdgcn_s_memrealtime();
#endif
    for (int ph = 0; ph < NPHASES; ++ph) {
        int type, l, s, ctype, cl; decode_phase(ph, type, l, s); decode_ctx(ph, ctype, cl);
        unsigned char* ws = ws0; asm volatile("" : "+s"(ws));
        const float* x = p.in[0]; const float* ctxin = p.in[2];
        float* out = p.out; asm volatile("" : "+s"(out));
        float* mod = (float*)(ws + OFF_MOD); const float* lbs = (const float*)(ws + OFF_LBS);
        bf16_t* hmod = (bf16_t*)(ws + OFF_HMOD); float* hc = (float*)(ws + OFF_HC); bf16_t* hcmod = (bf16_t*)(ws + OFF_HCMOD);
        bf16_t* Zc = (bf16_t*)(ws + OFF_ZC); bf16_t* actc = (bf16_t*)(ws + OFF_ACTC); bf16_t* OLc = (bf16_t*)(ws + OFF_OLC);
        float* Uctx = (float*)(ws + OFF_UCTX); float* Dctx = (float*)(ws + OFF_DCTX);
        unsigned char* big = ws + OFF_BIG;
        bf16_t* Zhg = (bf16_t*)(big + BIG_HG_Z); bf16_t* OL = (bf16_t*)(big + BIG_HG_OL); float* U = (float*)(big + BIG_HG_U); float* Dk = (float*)(big + BIG_HG_D);
        bf16_t* Zb = (bf16_t*)big; bf16_t* act = (bf16_t*)big;
        if (type == T_P0) {
            phase0(p, smem);
        } else if (type == T_INIT) {
            ln_mod(x, nullptr, hmod, nullptr, nullptr, false, mod + 0, mod + 1024, MLAT, SEQ, 0);
            ln_mod(ctxin, nullptr, hcmod, nullptr, nullptr, false, mod + 0, mod + 1024, MCTX, 1 << 30, 4);
        }
        if (is_gemm(type) || is_gemm(ctype)) {
            GemmJob j; j.e.kind = 0; j.e.O = nullptr; j.e.ldc = 0; j.e.mode = 0; j.e.silu_tiles = 0; j.e.hin = nullptr; j.e.out = nullptr; j.e.gate = nullptr; j.e.b0 = 0; j.e.ctx = 0;
            j.A = nullptr; j.Bt = nullptr; j.lda = 0; j.M = 0; j.N = 0; j.K = 0;
            for (int job = 0; job < 2; ++job) {
                const bool c = job == 1; const int t = c ? ctype : type, ll = c ? cl : l;
                if (!is_gemm(t)) continue;
                const int kind = ll & 1, idx = ll >> 1; const float* modl = mod + (size_t)ll * 5 * 6144;
                const float* hin = (ll == 0) ? x : out; const float* hcin = (ll == 0) ? ctxin : hc;
                if (t == T_GEMM_IN) {
                    j.A = c ? hcmod : hmod + (size_t)s * SLAB * DM; j.lda = DM; j.K = DM; j.M = c ? MCTX : SLAB; j.e.kind = 0;
                    if (kind == 0) { j.Bt = (const bf16_t*)(ws + OFF_WT_HGIN) + (size_t)idx * HGIN * DM; j.N = HGIN; j.e.O = c ? Zc : Zhg; j.e.ldc = HGIN; j.e.mode = 1; j.e.silu_tiles = 8; }
                    else { j.Bt = (const bf16_t*)(ws + OFF_WT_SGIN) + (size_t)idx * SGIN * DM; j.N = SGIN; j.e.O = c ? Zc : Zb; j.e.ldc = SGIN; j.e.mode = 2; j.e.silu_tiles = 0; }
                } else if (t == T_GEMM_OUT) {
                    j.M = c ? MCTX : SLAB; j.N = DM; j.e.kind = 1; j.e.hin = c ? hcin : hin + (size_t)s * SLAB * DM; j.e.out = c ? hc : out + (size_t)s * SLAB * DM; j.e.gate = modl + 2048; j.e.b0 = s * 2; j.e.ctx = c ? 1 : 0;
                    if (kind == 0) { j.A = (c ? Zc : Zhg) + 1024; j.lda = HGIN; j.K = DM; j.Bt = (const bf16_t*)(ws + OFF_WT_HGOUT) + (size_t)idx * DM * DM; }
                    else { j.A = c ? Zc : Zb; j.lda = SGIN; j.K = SGW; j.Bt = (const bf16_t*)(ws + OFF_WT_SGOUT) + (size_t)idx * DM * SGW; }
                } else if (t == T_GEMM_UP) {
                    j.A = c ? hcmod : hmod; j.lda = DM; j.K = DM; j.M = c ? MCTX : MLAT; j.N = UPW; j.Bt = (const bf16_t*)(ws + OFF_WT_UP) + (size_t)ll * UPW * DM;
                    if (c) { j.e.kind = 0; j.e.O = Zc; j.e.ldc = UPW; j.e.mode = 0; j.e.silu_tiles = 0; }
                    else { j.e.kind = 2; j.e.O = act; j.e.ldc = DFF; j.e.hin = p.in[19] + (size_t)ll * 3 * UPW; j.e.gate = p.in[20] + (size_t)ll * UPW; }
                } else {
                    j.A = c ? actc : act; j.lda = DFF; j.K = DFF; j.M = c ? MCTX : MLAT; j.N = DM; j.Bt = (const bf16_t*)(ws + OFF_WT_DOWN) + (size_t)ll * DM * DFF;
                    j.e.kind = 1; j.e.hin = c ? hc : out; j.e.out = c ? hc : out; j.e.gate = modl + 5120; j.e.b0 = 0; j.e.ctx = c ? 1 : 0;
                }
#ifndef NO_GEMM
                gemm_call(smem, j);
#endif
            }
        }
        {
            const int idx = l >> 1; const float* modl = mod + (size_t)l * 5 * 6144;
            const float* lbf = lbs + (0 * 2 + idx) * 1024; const float* lbb = lbs + (1 * 2 + idx) * 1024; const float* normw = p.in[10] + idx * 128;
            if (type == T_SCAN1 || ctype == T_SCAN1) {
                const int cidx = cl >> 1;
                const int n0 = type == T_SCAN1 ? 256 : 0, nu = n0 + (ctype == T_SCAN1 ? 32 : 0);
                for (int u = bid; u < nu; u += nblk) {
                    bf16_t* Zp; bf16_t* OLp; float *Uf, *Ub, *Df, *Db; int T, h; const float *lf, *lb2;
                    if (u < n0) { const int bl = u >> 7, sc = u & 15; h = (u >> 4) & 7; const size_t t0 = (size_t)bl * SEQ + sc * 512; const int sq = (bl * 8 + h) * 2; T = 512; lf = lbf; lb2 = lbb;
                        Zp = Zhg + t0 * HGIN; OLp = OL + t0 * DM; Uf = U + ((size_t)(sq + 0) * 16 + sc) * 16384; Ub = U + ((size_t)(sq + 1) * 16 + sc) * 16384; Df = Dk + ((sq + 0) * 16 + sc) * 128; Db = Dk + ((sq + 1) * 16 + sc) * 128; }
                    else { const int uc = u - n0, b = uc >> 3; h = uc & 7; const int sq = (b * 8 + h) * 2; T = CTXL; lf = lbs + (0 * 2 + cidx) * 1024; lb2 = lbs + (1 * 2 + cidx) * 1024;
                        Zp = Zc + (size_t)b * CTXL * HGIN; OLp = OLc + (size_t)b * CTXL * DM; Uf = Uctx + (size_t)(sq + 0) * 16384; Ub = Uctx + (size_t)(sq + 1) * 16384; Df = Dctx + (sq + 0) * 128; Db = Dctx + (sq + 1) * 128; }
#ifndef NO_SCAN1
                    scan_unit_mfma(smem, Zp, T, h, lf, lb2, OLp, Uf, Ub, Df, Db);
#endif
                }
            }
            if (type == T_SCAN2) {
#ifndef NO_SCAN2
                scan_pass2(U, Dk, Uctx, s);
#endif
            } else if (type == T_SCAN3) {
#ifndef NO_SCAN3
                for (int u = bid; u < 1024; u += nblk) scan_pass3_unit(smem, Zhg, OL, U, normw, u >> 9, (u >> 6) & 7, u & 63);
#endif
            }
            if (type == T_MIX || ctype == T_MIX) {
                const int n0 = type == T_MIX ? 256 : 0, nu = n0 + (ctype == T_MIX ? 16 : 0);
                for (int u = bid; u < nu; u += nblk) { const bool c = u >= n0; const int uu = c ? u - n0 : u; const int ix = (c ? cl : l) >> 1;
                    const bf16_t* wsb = (const bf16_t*)(ws + OFF_WS_B) + (size_t)ix * 8 * 128 * 128;
#ifndef NO_MIX
                    sgu_mix_unit(smem, c ? Zc : Zb, uu >> 1, uu & 1, wsb, p.in[16] + ix * 8 * 128, p.in[13] + ix * SGW, p.in[14] + ix * SGW);
#endif
                }
            }
            if (type == T_LN1 || type == T_LN2) {
                const int which = type == T_LN1 ? 0 : 1;
                const float* modn = type == T_LN1 ? modl + 3072 : mod + (size_t)(l + 1) * 5 * 6144;
                const bool want_mod = type == T_LN1 || l < 3;
                ln_mod(out, out, want_mod ? hmod : nullptr, p.in[6] + (l * 2 + which) * DM, p.in[7] + (l * 2 + which) * DM, true, modn + 0, modn + 1024, MLAT, SEQ, 0);
            }
        }
        if (ctype == T_READOUT) {
#ifndef NO_CTXR
            ctx_readout(Zc, OLc, p.in[10]);
#endif
        } else if (ctype == T_CONV) {
#ifndef NO_CONV
            conv_swiglu(Zc, actc, p.in[19] + (size_t)cl * 3 * UPW, p.in[20] + (size_t)cl * UPW, MCTX, CTXL);
#endif
        } else if (ctype == T_LN1 || ctype == T_LN2) {
            const int which = ctype == T_LN1 ? 0 : 1;
            const float* modn = ctype == T_LN1 ? mod + (size_t)cl * 5 * 6144 + 3072 : mod + (size_t)(cl + 1) * 5 * 6144;
            ln_mod(hc, hc, hcmod, p.in[6] + (cl * 2 + which) * DM, p.in[7] + (cl * 2 + which) * DM, true, modn + 0, modn + 1024, MCTX, 1 << 30, 4);
        }
#ifdef PROBE_MASK
        xcd_barrier(xb);
        { const unsigned long long t1 = __builtin_amdgcn_s_memrealtime(); if ((PROBE_MASK >> type) & 1u) pr_acc += t1 - pr_t0; pr_t0 = t1; }
#else
        if (ph + 1 < NPHASES) xcd_barrier(xb);
#endif
    }
#ifdef PROBE_MASK
    if (bidx() == 0) { const int n = (int)(pr_acc / 200ull);
        for (int i = tidx(); i < n; i += 512) p.out[(size_t)i * 331] += 0.1f; }
#endif
}

extern "C" void kernel_launch(void* const* d_in, const int* in_sizes, int n_in, void* d_out, int out_size, void* d_ws, size_t ws_size, hipStream_t stream) {
    static int grid_blocks = 0;
    if (!grid_blocks) {
        int dev = 0, cus = 0, per_cu = 0;
        hipGetDevice(&dev);
        hipDeviceGetAttribute(&cus, hipDeviceAttributeMultiprocessorCount, dev);
        hipFuncSetAttribute((const void*)fwd_megakernel, hipFuncAttributeMaxDynamicSharedMemorySize, LDS_BYTES);
        hipOccupancyMaxActiveBlocksPerMultiprocessor(&per_cu, (const void*)fwd_megakernel, 512, LDS_BYTES);
        if (per_cu < 1) per_cu = 1;
        grid_blocks = cus * per_cu;
        (void)hipGetLastError();
    }
    if (n_in != 22 || ws_size < WS_END) { fprintf(stderr, "kernel_launch: unexpected inputs (n_in %d, ws %zu < %zu)\n", n_in, ws_size, (size_t)WS_END); return; }
    (void)hipMemsetAsync((unsigned char*)d_ws + OFF_BAR, 0, (size_t)XCD_BAR_WORDS * 4, stream);
    Params p{};
    for (int i = 0; i < 22; ++i) p.in[i] = (const float*)d_in[i];
    p.out = (float*)d_out; p.ws = (unsigned char*)d_ws;
    void* args[] = {&p};
    hipError_t e = hipLaunchCooperativeKernel((const void*)fwd_megakernel, dim3(grid_blocks), dim3(512), args, LDS_BYTES, stream);
    if (e != hipSuccess) fprintf(stderr, "cooperative launch failed: %s (grid %d)\n", hipGetErrorString(e), grid_blocks);
}
```

```cpp
#include <hip/hip_runtime.h>
#include <hip/hip_cooperative_groups.h>
#include <cstdio>
namespace cg = cooperative_groups;

typedef unsigned short bf16_t;
typedef short bf16x8 __attribute__((ext_vector_type(8)));
typedef float f32x4 __attribute__((ext_vector_type(4)));
typedef float f32x2 __attribute__((ext_vector_type(2)));
typedef unsigned u32x4 __attribute__((ext_vector_type(4)));
typedef unsigned u32x2 __attribute__((ext_vector_type(2)));

__device__ __forceinline__ unsigned cvt_pk_bf16(float lo, float hi) { unsigned r; asm volatile("v_cvt_pk_bf16_f32 %0, %1, %2" : "=v"(r) : "v"(lo), "v"(hi)); return r; }
__device__ __forceinline__ bf16_t f2bf(float f) { return (bf16_t)(cvt_pk_bf16(f, 0.f) & 0xffffu); }
__device__ __forceinline__ float bf2f(bf16_t b) { return __uint_as_float(((unsigned)b) << 16); }
__device__ __forceinline__ float bflo(unsigned w) { return __uint_as_float(w << 16); }
__device__ __forceinline__ float bfhi(unsigned w) { return __uint_as_float(w & 0xffff0000u); }
__device__ __forceinline__ float silu_f(float v) { return v * __builtin_amdgcn_rcpf(1.0f + __expf(-v)); }
__device__ __forceinline__ float sigmoid_f(float v) { return __builtin_amdgcn_rcpf(1.0f + __expf(-v)); }
__device__ __forceinline__ f32x2 gelu_pk(f32x2 v) {
    const f32x2 av = __builtin_elementwise_abs(v), d = av * 0.2316418882f + 1.0f;
    f32x2 t; t.x = __builtin_amdgcn_rcpf(d.x); t.y = __builtin_amdgcn_rcpf(d.y);
    f32x2 q = t * 0.5307027145f + (-0.7265760135f); q = q * t + 0.7107068705f; q = q * t + (-0.142248368f); q = q * t + 0.127414796f; q = q * t;
    const f32x2 s = (v * v) * (-0.72134752044f);
    f32x2 e; e.x = __builtin_amdgcn_exp2f(s.x); e.y = __builtin_amdgcn_exp2f(s.y);
    const f32x2 m = v * (q * e), r = v - m;
    f32x2 o; o.x = v.x < 0.f ? m.x : r.x; o.y = v.y < 0.f ? m.y : r.y; return o;
}

constexpr int WTAB_OFF = 131072 + 512;
__device__ __forceinline__ int hw_slot() { return (int)(__builtin_amdgcn_s_getreg((5 << 11) | 4) & 0x3fu); }
__device__ __forceinline__ int tidx() {
    extern __shared__ __attribute__((aligned(16))) unsigned char smem_t[];
    const int w = *(volatile __attribute__((address_space(3))) int*)((__attribute__((address_space(3))) unsigned char*)smem_t + WTAB_OFF + 4 * hw_slot());
    int lane; asm volatile("v_mbcnt_lo_u32_b32 %0, -1, 0\n\tv_mbcnt_hi_u32_b32 %0, -1, %0" : "=v"(lane));
    return __builtin_amdgcn_readfirstlane(w) * 64 + lane; }
__device__ __forceinline__ int bidx() { int b = blockIdx.x; asm volatile("" : "+s"(b)); return b; }


#define XB_TMO      128
#define XB_XCNT(j)  (256  + 64 * (j))
#define XB_XSUB(j)  (1280 + 64 * (j))
#define XB_XGEN(j)  (2304 + 64 * (j))
#define XB_TOP      3328
#define XB_TOPGEN   3392
#define XCD_BAR_WORDS 3456
#define XB_SPIN_CAP (1u << 20)
#define XLAS __attribute__((address_space(3)))
__device__ __forceinline__ unsigned xb_ld(unsigned* p)              { return __hip_atomic_load(p, __ATOMIC_RELAXED, __HIP_MEMORY_SCOPE_AGENT); }
__device__ __forceinline__ unsigned xb_add(unsigned* p, unsigned v) { return __hip_atomic_fetch_add(p, v, __ATOMIC_RELAXED, __HIP_MEMORY_SCOPE_AGENT); }
__device__ __forceinline__ unsigned xb_xcc_id() { return (unsigned)__builtin_amdgcn_s_getreg((3 << 11) | 20) & 0xFu; }
#define XB_SPIN(cond, bar) do { unsigned _sp = 0; while (cond) { __builtin_amdgcn_s_sleep(1); \
    if ((++_sp & 255u) == 0u) { if (xb_ld(&(bar)[XB_TMO])) break; if (_sp > XB_SPIN_CAP) { atomicAdd(&(bar)[XB_TMO], 1u); break; } } } } while (0)
struct XcdBarrier { unsigned* bar; unsigned x; volatile XLAS unsigned* st; };
__device__ __forceinline__ XcdBarrier xcd_barrier_post(unsigned* bar, volatile XLAS unsigned* st) {
    XcdBarrier b; b.bar = bar; b.x = xb_xcc_id(); b.st = st;
    if (threadIdx.x == 0) (void)xb_add(&bar[XB_XCNT(b.x)], 1u);
    return b;
}
__device__ __forceinline__ void xcd_barrier_complete(unsigned* bar, unsigned x, unsigned& nloc, unsigned& nx) {
    const unsigned G = gridDim.x * gridDim.y * gridDim.z;
    unsigned sum, cnt, mine, sp = 0u;
    for (;;) {
        sum = 0u; cnt = 0u; mine = 0u;
#pragma unroll
        for (unsigned j = 0; j < 16; ++j) { const unsigned c = xb_ld(&bar[XB_XCNT(j)]); sum += c; cnt += (c > 0u) ? 1u : 0u; mine = (j == x) ? c : mine; }
        if (sum == G) break;
        __builtin_amdgcn_s_sleep(1);
        if ((++sp & 255u) == 0u) { if (xb_ld(&bar[XB_TMO])) break; if (sp > XB_SPIN_CAP) { atomicAdd(&bar[XB_TMO], 1u); break; } }
    }
    nloc = mine > 0u ? mine : 1u; nx = cnt > 0u ? cnt : 1u;
}
__device__ __forceinline__ void xcd_barrier(const XcdBarrier& b) {
    asm volatile("s_waitcnt vmcnt(0)" ::: "memory");
    __syncthreads();
    if (tidx() == 0) {
        unsigned* bar = b.bar; asm volatile("" : "+s"(bar));
        __builtin_amdgcn_s_waitcnt(0);
        unsigned nloc = b.st[0], nx = b.st[1];
        if (nloc == 0u) { xcd_barrier_complete(bar, b.x, nloc, nx); b.st[0] = nloc; b.st[1] = nx; }
        const unsigned old = xb_add(&bar[XB_XSUB(b.x)], 1u);
        const unsigned gen = old / nloc;
        if (old + 1u == (gen + 1u) * nloc) {
            __builtin_amdgcn_fence(__ATOMIC_RELEASE, "agent");
            asm volatile("s_waitcnt vmcnt(0)" ::: "memory");
            const unsigned og = xb_add(&bar[XB_TOP], 1u);
            const unsigned tg = og / nx;
            if (og + 1u == (tg + 1u) * nx) xb_add(&bar[XB_TOPGEN], 1u);
            else XB_SPIN(xb_ld(&bar[XB_TOPGEN]) == tg, bar);
            __builtin_amdgcn_fence(__ATOMIC_ACQUIRE, "agent");
            xb_add(&bar[XB_XGEN(b.x)], 1u);
            asm volatile("s_waitcnt vmcnt(0)" ::: "memory");
        } else {
            XB_SPIN(xb_ld(&bar[XB_XGEN(b.x)]) == gen, bar);
            __builtin_amdgcn_fence(__ATOMIC_ACQUIRE, "agent");
            asm volatile("s_waitcnt vmcnt(0)" ::: "memory");
        }
    }
    __syncthreads();
}

__device__ __forceinline__ void lds_barrier() { asm volatile("s_waitcnt lgkmcnt(0)" ::: "memory"); __builtin_amdgcn_s_barrier(); asm volatile("" ::: "memory"); }

__device__ __forceinline__ float shx(float v, int o, int lane) { return __int_as_float(__builtin_amdgcn_ds_bpermute((lane ^ o) << 2, __float_as_int(v))); }
__device__ __forceinline__ float opq(float c) { asm volatile("" : "+s"(c)); return c; }
__device__ __forceinline__ f32x4 zero4() { const float z = opq(0.f); return (f32x4){z, z, z, z}; }

constexpr int DM = 1024, NB = 4, SEQ = 8192, CTXL = 256, MLAT = NB * SEQ, MCTX = NB * CTXL;
constexpr int HGIN = 5120, SGW = 3072, SGIN = 6144, DFF = 2816, UPW = 5632;
constexpr int SLAB = 16384;
constexpr float ALPHA_F = 1.6817928305074292f;
constexpr int LDP = 136;

constexpr size_t al256(size_t x) { return (x + 255) & ~(size_t)255; }
constexpr size_t OFF_WT_HGIN = 0;
constexpr size_t OFF_WT_HGOUT = OFF_WT_HGIN + al256((size_t)2 * HGIN * DM * 2);
constexpr size_t OFF_WT_SGIN = OFF_WT_HGOUT + al256((size_t)2 * DM * DM * 2);
constexpr size_t OFF_WT_SGOUT = OFF_WT_SGIN + al256((size_t)2 * SGIN * DM * 2);
constexpr size_t OFF_WT_UP = OFF_WT_SGOUT + al256((size_t)2 * DM * SGW * 2);
constexpr size_t OFF_WT_DOWN = OFF_WT_UP + al256((size_t)4 * UPW * DM * 2);
constexpr size_t OFF_WS_B = OFF_WT_DOWN + al256((size_t)4 * DM * DFF * 2);
constexpr size_t OFF_MOD = OFF_WS_B + al256((size_t)2 * 8 * 128 * 128 * 2);
constexpr size_t OFF_LBS = OFF_MOD + al256((size_t)4 * 5 * 6144 * 4);
constexpr size_t OFF_HMOD = OFF_LBS + al256((size_t)2 * 2 * 1024 * 4);
constexpr size_t OFF_HC = OFF_HMOD + al256((size_t)MLAT * DM * 2);
constexpr size_t OFF_HCMOD = OFF_HC + al256((size_t)MCTX * DM * 4);
constexpr size_t OFF_ZC = OFF_HCMOD + al256((size_t)MCTX * DM * 2);
constexpr size_t OFF_ACTC = OFF_ZC + al256((size_t)MCTX * SGIN * 2);
constexpr size_t OFF_OLC = OFF_ACTC + al256((size_t)MCTX * DFF * 2);
constexpr size_t OFF_UCTX = OFF_OLC + al256((size_t)MCTX * DM * 2);
constexpr size_t OFF_DCTX = OFF_UCTX + al256((size_t)NB * 8 * 2 * 16384 * 4);
constexpr size_t OFF_BAR = OFF_DCTX + al256((size_t)NB * 8 * 2 * 128 * 4);
constexpr size_t OFF_SGST = OFF_BAR + al256((size_t)XCD_BAR_WORDS * 4);
constexpr size_t SGST_BYTES = ((size_t)4 * SLAB + MCTX) * 2 * 4;
constexpr size_t OFF_BIG = OFF_SGST + al256(SGST_BYTES);
constexpr size_t BIG_HG_Z = 0;
constexpr size_t BIG_HG_OL = BIG_HG_Z + (size_t)SLAB * HGIN * 2;
constexpr size_t BIG_HG_U = BIG_HG_OL + (size_t)SLAB * DM * 2;
constexpr size_t BIG_HG_D = BIG_HG_U + (size_t)32 * 16 * 16384 * 4;
constexpr size_t BIG_HG_END = BIG_HG_D + (size_t)32 * 16 * 128 * 4;
constexpr size_t BIG_FF_ACT = (size_t)SLAB * UPW * 2;
constexpr size_t BIG_FF_END = BIG_FF_ACT + (size_t)SLAB * DFF * 2;
constexpr size_t BIG_SG_END = (size_t)SLAB * SGIN * 2;
constexpr size_t BIG_BYTES = BIG_FF_END > BIG_HG_END ? (BIG_FF_END > BIG_SG_END ? BIG_FF_END : BIG_SG_END) : (BIG_HG_END > BIG_SG_END ? BIG_HG_END : BIG_SG_END);
constexpr size_t WS_END = OFF_BIG + BIG_BYTES;
static_assert(WS_END <= (size_t)536870912, "workspace map exceeds the guaranteed 512 MiB");
constexpr int LDS_BYTES = 144 * 1024;

struct Params { const float* in[22]; float* out; unsigned char* ws; };
namespace pg8 {
#define PG8_LAS __attribute__((address_space(3)))
constexpr int BM = 256, BK = 64, HALF = 128, HTB = HALF * BK * 2, STAGE_BYTES = 8 * HTB, NXCD = 8, WGM = 8;
__host__ __device__ __forceinline__ int lds_byte(int r, int c) { const int st = (r >> 4) * 2 + (c >> 5), rr = r & 15, cc = c & 31, ob = rr * 64 + cc * 2; return st * 1024 + (ob ^ (((ob >> 9) & 1) << 5)); }
__host__ __device__ __forceinline__ void stage_rc(int b, int& R, int& C) { const int st = b / 1024, sb = b % 1024, swz = sb ^ (((sb >> 9) & 1) << 5); R = (st >> 1) * 16 + swz / 64; C = (st & 1) * 32 + (swz % 64) / 2; }
__host__ __device__ __forceinline__ int perm32(int rho) { const int n = rho >> 4, i = rho & 15; return 8 * (i >> 2) + 4 * n + (i & 3); }
struct Unit { int pm, pn; };
struct Gemm { const bf16_t* A; const bf16_t* Bt; int M, N, K, lda; };
struct StaticOrder {
    int nM, nN, nwg, G, c;
    __device__ void init(int M, int N, int G_, int c_) { nM = M / BM; nN = N / BM; nwg = nM * nN; G = G_; c = c_; }
    __device__ bool next(int i, Unit& u) const {
        const long L = (long)i * G + c; if (L >= nwg) return false;
        int wgid = (int)L; { const int q = nwg / NXCD, r = nwg % NXCD, xcd = wgid % NXCD, off = wgid / NXCD; wgid = (xcd < r ? xcd * (q + 1) : r * (q + 1) + (xcd - r) * q) + off; }
        const int nig = WGM * nN, gid = wgid / nig, fm = gid * WGM, gsz = (nM - fm) < WGM ? (nM - fm) : WGM;
        u.pm = fm + ((wgid % nig) % gsz); u.pn = (wgid % nig) / gsz; return true;
    }
};
template <class Epi>
__device__ __forceinline__ void gemm_phase(PG8_LAS unsigned char* lds, const Gemm g, const StaticOrder& S, const Epi& E) {
    const bool perm = E.perm();
    const int tid = tidx(), wid = __builtin_amdgcn_readfirstlane(tid >> 6), lane = tid & 63, wr = wid >> 2, wc = wid & 3, fr = lane & 15, fq = lane >> 4;
    const int K = g.K, nt = K / BK, lda = g.lda;
    unsigned voffA[2], voffB[2];
#pragma unroll
    for (int i = 0; i < 2; ++i) { int R, C; stage_rc(tid * 16 + i * 8192, R, C); const int Rb = perm ? ((R & ~31) + perm32(R & 31)) : R;
        voffA[i] = (unsigned)(R * lda + C) * 2u; voffB[i] = (unsigned)(Rb * K + C) * 2u; }
    const size_t kstep = (size_t)(BK * 2);
    const size_t hstepA = (size_t)HALF * lda * 2, hstepB = (size_t)HALF * K * 2;
    const size_t tstepA = 2 * hstepA, tstepB = 2 * hstepB;
    const unsigned ldsw = (unsigned)wid * 1024u;
    const int aoff = lds_byte(wr * 64 + fr, fq * 8), boff = lds_byte(wc * 32 + fr, fq * 8);
#define PG8_SA(b, h) (((b) * 2 + (h)) * HTB)
#define PG8_SB(b, h) ((4 + (b) * 2 + (h)) * HTB)
#define PG8_R64_voffA r64A
#define PG8_R64_voffB r64B
#define PG8_R64(v) PG8_R64_##v
#define PG8_STAGE(bufoff, gbase, voff) do { _Pragma("unroll") for (int _i = 0; _i < 2; ++_i) \
        __builtin_amdgcn_global_load_lds((const unsigned*)((const char*)(gbase) + (voff)[_i]), (PG8_LAS unsigned*)(lds + (bufoff) + ldsw + _i * 8192), 16, 0, 0); } while (0)
#define PG8_LDA(dst, b, h) do { _Pragma("unroll") for (int m = 0; m < 4; ++m) _Pragma("unroll") for (int k = 0; k < 2; ++k) dst[m][k] = *(const PG8_LAS bf16x8*)(lds + PG8_SA(b, h) + aoff + m * 2048 + k * 1024); } while (0)
#define PG8_LDB(dst, b, h) do { _Pragma("unroll") for (int n = 0; n < 2; ++n) _Pragma("unroll") for (int k = 0; k < 2; ++k) dst[n][k] = *(const PG8_LAS bf16x8*)(lds + PG8_SB(b, h) + boff + n * 2048 + k * 1024); } while (0)
#define PG8_MMA(ai, bj, At, Bt) do { __builtin_amdgcn_s_setprio(1); _Pragma("unroll") for (int m = 0; m < 4; ++m) _Pragma("unroll") for (int n = 0; n < 2; ++n) _Pragma("unroll") for (int k = 0; k < 2; ++k) \
        acc[ai][bj][m][n] = __builtin_amdgcn_mfma_f32_16x16x32_bf16(Bt[n][k], At[m][k], acc[ai][bj][m][n], 0, 0, 0); __builtin_amdgcn_s_setprio(0); } while (0)
#define PG8_WAIT_V(n) asm volatile("s_waitcnt vmcnt(" #n ")" ::: "memory")
#define PG8_WAIT_L(n) asm volatile("s_waitcnt lgkmcnt(" #n ")" ::: "memory")
#define PG8_BAR __builtin_amdgcn_s_barrier()
#define PG8_SCHED __builtin_amdgcn_sched_barrier(0)
    Unit cur, nxt; int ui = 0;
    if (!S.next(0, cur)) return;
    f32x4 acc[2][2][4][2];
#pragma unroll
    for (int a = 0; a < 2; ++a)
#pragma unroll
        for (int b = 0; b < 2; ++b)
#pragma unroll
            for (int m = 0; m < 4; ++m)
#pragma unroll
                for (int n = 0; n < 2; ++n) acc[a][b][m][n] = (f32x4){0.f, 0.f, 0.f, 0.f};
    bf16x8 At[4][2], B0[2][2], B1[2][2];
    const char* cA = (const char*)g.A + (size_t)cur.pm * tstepA; const char* cB = (const char*)g.Bt + (size_t)cur.pn * tstepB;
    PG8_STAGE(PG8_SB(0, 0), cB, voffB); PG8_STAGE(PG8_SA(0, 0), cA, voffA); PG8_STAGE(PG8_SB(0, 1), cB + hstepB, voffB); PG8_STAGE(PG8_SA(0, 1), cA + hstepA, voffA);
    if (wr == 1) PG8_BAR;
    PG8_WAIT_V(4); PG8_BAR;
    PG8_STAGE(PG8_SB(1, 0), cB + kstep, voffB); PG8_STAGE(PG8_SA(1, 0), cA + kstep, voffA); PG8_STAGE(PG8_SB(1, 1), cB + hstepB + kstep, voffB);
    PG8_WAIT_V(6); PG8_BAR;
    for (;;) {
        const bool has_next = S.next(ui + 1, nxt);
        const char* nA = has_next ? (const char*)g.A + (size_t)nxt.pm * tstepA : cA; const char* nB = has_next ? (const char*)g.Bt + (size_t)nxt.pn * tstepB : cB;
        for (int t = 0; t < nt; t += 2) {
            const bool last = (t == nt - 2);
            const char* a1 = cA + (size_t)(t + 1) * kstep;
            const char* a2 = last ? nA : cA + (size_t)(t + 2) * kstep; const char* b2 = last ? nB : cB + (size_t)(t + 2) * kstep;
            const char* a3 = a2 + kstep; const char* b3 = b2 + kstep;
            PG8_LDB(B0, 0, 0); PG8_SCHED; PG8_LDA(At, 0, 0); PG8_STAGE(PG8_SA(1, 1), a1 + hstepA, voffA);
            PG8_WAIT_L(8); PG8_BAR; PG8_WAIT_L(0); PG8_MMA(0, 0, At, B0); PG8_BAR; PG8_SCHED;
            PG8_LDB(B1, 0, 1); PG8_STAGE(PG8_SB(0, 0), b2, voffB);
            PG8_BAR; PG8_WAIT_L(0); PG8_MMA(0, 1, At, B1); PG8_BAR;
            PG8_LDA(At, 0, 1); PG8_STAGE(PG8_SA(0, 0), a2, voffA);
            PG8_BAR; PG8_WAIT_L(0); PG8_MMA(1, 0, At, B0); PG8_BAR; PG8_SCHED;
            PG8_STAGE(PG8_SB(0, 1), b2 + hstepB, voffB);
            PG8_WAIT_V(6); PG8_BAR; PG8_MMA(1, 1, At, B1); PG8_BAR;
            PG8_LDB(B0, 1, 0); PG8_SCHED; PG8_LDA(At, 1, 0); PG8_STAGE(PG8_SA(0, 1), a2 + hstepA, voffA);
            PG8_WAIT_L(8); PG8_BAR; PG8_WAIT_L(0); PG8_MMA(0, 0, At, B0); PG8_BAR; PG8_SCHED;
            PG8_LDB(B1, 1, 1); PG8_STAGE(PG8_SB(1, 0), b3, voffB);
            PG8_BAR; PG8_WAIT_L(0); PG8_MMA(0, 1, At, B1); PG8_BAR;
            PG8_LDA(At, 1, 1); PG8_STAGE(PG8_SA(1, 0), a3, voffA);
            PG8_BAR; PG8_WAIT_L(0); PG8_MMA(1, 0, At, B0); PG8_BAR; PG8_SCHED;
            PG8_STAGE(PG8_SB(1, 1), b3 + hstepB, voffB);
            PG8_WAIT_V(6); PG8_BAR; PG8_MMA(1, 1, At, B1); PG8_BAR;
        }
        E(acc, cur, wr, wc, fr, fq);
        if (!has_next) break;
#pragma unroll
        for (int a = 0; a < 2; ++a)
#pragma unroll
            for (int b = 0; b < 2; ++b)
#pragma unroll
                for (int m = 0; m < 4; ++m)
#pragma unroll
                    for (int n = 0; n < 2; ++n) acc[a][b][m][n] = (f32x4){0.f, 0.f, 0.f, 0.f};
        cur = nxt; cA = nA; cB = nB; ++ui;
    }
    PG8_WAIT_V(0);
    if (wr == 0) PG8_BAR;
    PG8_BAR;
#undef PG8_SA
#undef PG8_SB
#undef PG8_STAGE
#undef PG8_LDA
#undef PG8_LDB
#undef PG8_MMA
#undef PG8_WAIT_V
#undef PG8_WAIT_L
#undef PG8_BAR
#undef PG8_SCHED
}
}
struct EpiAny {
    int kind;
    bf16_t* O; int ldc; int mode; int silu_tiles;
    const float* hin; float* out; const float* gate; int b0; int ctx;
    __device__ __forceinline__ bool perm() const { return kind != 1; }
    __device__ __forceinline__ void operator()(const f32x4 (&acc)[2][2][4][2], const pg8::Unit& u, int wr, int wc, int fr, int fq) const {
        if (kind == 0) {
            const int row0 = u.pm * 256 + wr * 64 + fr, col0 = u.pn * 256 + wc * 32 + 8 * fq;
            const bool do_silu = (mode == 1) && (u.pn < silu_tiles);
            const bool do_stats = (mode == 2) && (out != nullptr) && (u.pn >= 12);
#pragma unroll
            for (int ai = 0; ai < 2; ++ai)
#pragma unroll
                for (int m = 0; m < 4; ++m) { bf16_t* rowp = O + (size_t)(row0 + ai * 128 + m * 16) * ldc + col0; float ssum = 0.f, ssq = 0.f;
#pragma unroll
                    for (int bj = 0; bj < 2; ++bj) { f32x4 v0 = acc[ai][bj][m][0], v1 = acc[ai][bj][m][1];
                        if (mode == 2) { f32x2 a = gelu_pk((f32x2){v0[0], v0[1]}), b = gelu_pk((f32x2){v0[2], v0[3]}), c = gelu_pk((f32x2){v1[0], v1[1]}), d = gelu_pk((f32x2){v1[2], v1[3]});
                            v0 = (f32x4){a.x, a.y, b.x, b.y}; v1 = (f32x4){c.x, c.y, d.x, d.y}; }
                        else if (do_silu) {
#pragma unroll
                            for (int j = 0; j < 4; ++j) { v0[j] = silu_f(v0[j]); v1[j] = silu_f(v1[j]); } }
                        if (do_stats) { ssum += ((v0[0] + v0[1]) + (v0[2] + v0[3])) + ((v1[0] + v1[1]) + (v1[2] + v1[3]));
                            ssq += ((v0[0] * v0[0] + v0[1] * v0[1]) + (v0[2] * v0[2] + v0[3] * v0[3])) + ((v1[0] * v1[0] + v1[1] * v1[1]) + (v1[2] * v1[2] + v1[3] * v1[3])); }
                        u32x4 w; w.x = cvt_pk_bf16(v0[0], v0[1]); w.y = cvt_pk_bf16(v0[2], v0[3]); w.z = cvt_pk_bf16(v1[0], v1[1]); w.w = cvt_pk_bf16(v1[2], v1[3]);
                        *(u32x4*)(rowp + bj * 128) = w; }
                    if (do_stats) {
                        const int ln_ = fq * 16 + fr;
                        ssum += shx(ssum, 16, ln_); ssq += shx(ssq, 16, ln_); ssum += shx(ssum, 32, ln_); ssq += shx(ssq, 32, ln_);
                        if (fq == 0) { float* sp = out + (size_t)(row0 + ai * 128 + m * 16) * 2; unsafeAtomicAdd(sp, ssum); unsafeAtomicAdd(sp + 1, ssq); } }
                    asm volatile("" ::: "memory"); }
        } else if (kind == 2) {
            const float* cw = hin; const float* cb = gate;
            const bool first = fr == 0, lastl = fr == 15;
#pragma unroll 1
            for (int n = 0; n < 2; ++n) {
                const int j0 = u.pn * 128 + wc * 32 + 8 * fq + 4 * n;
                f32x4 wa[3], wg[3], ba, bg;
#pragma unroll
                for (int k = 0; k < 3; ++k) { wa[k] = *(const f32x4*)(cw + k * UPW + j0); wg[k] = *(const f32x4*)(cw + k * UPW + DFF + j0); }
                ba = *(const f32x4*)(cb + j0); bg = *(const f32x4*)(cb + DFF + j0);
#pragma unroll
                for (int ai = 0; ai < 2; ++ai) {
                    float res[4][4];
#pragma unroll
                    for (int e = 0; e < 4; ++e) {
                        float ya[4], yg[4];
#pragma unroll
                        for (int m = 0; m < 4; ++m) { ya[m] = n == 0 ? acc[ai][0][m][0][e] : acc[ai][0][m][1][e]; yg[m] = n == 0 ? acc[ai][1][m][0][e] : acc[ai][1][m][1][e]; }
#pragma unroll
                        for (int m = 0; m < 4; ++m) {
                            const float pa = m > 0 ? ya[m - 1] : 0.f, na = m < 3 ? ya[m + 1] : 0.f, pg = m > 0 ? yg[m - 1] : 0.f, ng = m < 3 ? yg[m + 1] : 0.f;
                            const float la = __int_as_float(__builtin_amdgcn_update_dpp(0, __float_as_int(lastl ? pa : ya[m]), 0x121, 0xf, 0xf, false));
                            const float ra = __int_as_float(__builtin_amdgcn_update_dpp(0, __float_as_int(first ? na : ya[m]), 0x12F, 0xf, 0xf, false));
                            const float lg = __int_as_float(__builtin_amdgcn_update_dpp(0, __float_as_int(lastl ? pg : yg[m]), 0x121, 0xf, 0xf, false));
                            const float rg = __int_as_float(__builtin_amdgcn_update_dpp(0, __float_as_int(first ? ng : yg[m]), 0x12F, 0xf, 0xf, false));
                            const float av = wa[0][e] * la + wa[1][e] * ya[m] + wa[2][e] * ra + ba[e];
                            const float gv = wg[0][e] * lg + wg[1][e] * yg[m] + wg[2][e] * rg + bg[e];
                            res[m][e] = silu_f(gv) * av;
                        }
                    }
#pragma unroll
                    for (int m = 0; m < 4; ++m) { u32x2 w; w.x = cvt_pk_bf16(res[m][0], res[m][1]); w.y = cvt_pk_bf16(res[m][2], res[m][3]);
                        *(u32x2*)(O + (size_t)(u.pm * 256 + ai * 128 + wr * 64 + m * 16 + fr) * ldc + j0) = w; }
                }
            }
        } else {
            const int row0 = u.pm * 256 + wr * 64 + fr, col0 = u.pn * 256 + wc * 32 + 4 * fq;
            const int b = ctx ? 4 : b0 + (u.pm * 256) / SEQ;
            const float* gp = gate + (size_t)b * 6144 + col0;
            f32x4 gv[2][2];
#pragma unroll
            for (int bj = 0; bj < 2; ++bj)
#pragma unroll
                for (int n = 0; n < 2; ++n) gv[bj][n] = *(const f32x4*)(gp + bj * 128 + n * 16);
#pragma unroll
            for (int ai = 0; ai < 2; ++ai)
#pragma unroll
                for (int m = 0; m < 4; ++m) { const size_t off = (size_t)(row0 + ai * 128 + m * 16) * DM + col0;
#pragma unroll
                    for (int bj = 0; bj < 2; ++bj)
#pragma unroll
                        for (int n = 0; n < 2; ++n) { const f32x4 h4 = *(const f32x4*)(hin + off + bj * 128 + n * 16);
                            *(f32x4*)(out + off + bj * 128 + n * 16) = h4 * ALPHA_F + gv[bj][n] * acc[ai][bj][m][n]; }
                    asm volatile("" ::: "memory"); }
        }
    }
};
struct GemmJob { const bf16_t* A; const bf16_t* Bt; int lda, M, N, K; EpiAny e; };
constexpr int EPI_LDS_OFF = 131072;
struct EpiLds {
    int kind0;
    __device__ __forceinline__ bool perm() const { return kind0 != 1; }
    __device__ __forceinline__ void operator()(const f32x4 (&acc)[2][2][4][2], const pg8::Unit& u, int wr, int wc, int fr, int fq) const {
        extern __shared__ __attribute__((aligned(16))) unsigned char smem_e[];
        const volatile __attribute__((address_space(3))) unsigned* dw = (const volatile __attribute__((address_space(3))) unsigned*)((__attribute__((address_space(3))) unsigned char*)smem_e + EPI_LDS_OFF);
        union { EpiAny e; unsigned w[sizeof(EpiAny) / 4]; } d;
#pragma unroll
        for (int i = 0; i < (int)(sizeof(EpiAny) / 4); ++i) d.w[i] = __builtin_amdgcn_readfirstlane(dw[i]);
        d.e(acc, u, wr, wc, fr, fq);
    }
};
__device__ __forceinline__ void gemm_call(unsigned char* smem, const GemmJob& j) {
    __syncthreads();
    if (tidx() == 0) *(EpiAny*)(smem + EPI_LDS_OFF) = j.e;
    __syncthreads();
    pg8::Gemm g; g.A = j.A; g.Bt = j.Bt; g.M = j.M; g.N = j.N; g.K = j.K; g.lda = j.lda;
    pg8::StaticOrder S; S.init(j.M, j.N, (int)gridDim.x, bidx());
    EpiLds el; el.kind0 = j.e.kind;
    pg8::gemm_phase<EpiLds>((PG8_LAS unsigned char*)smem, g, S, el);
}

__device__ void transpose_cvt(const float* src, bf16_t* dst, int nmat, int K, int N, int ffn_perm, float* tile  ) {
    const int tid = tidx(), tk = K / 64, tn = N / 64, per = tk * tn, total = nmat * per;
    const int lrow = tid >> 4, c4 = (tid & 15) * 4;
    f32x4 pv[2];
    int u = bidx();
    if (u < total) { const int mi = u / per, r = u % per, kt = r / tn, ntl = r % tn; const float* s = src + (size_t)mi * K * N + (size_t)(kt * 64) * N + ntl * 64;
#pragma unroll
        for (int i = 0; i < 2; ++i) pv[i] = *(const f32x4*)(s + (size_t)(lrow + 32 * i) * N + c4); }
    for (; u < total; u += gridDim.x) {
        const int mi = u / per, r = u % per, kt = r / tn, ntl = r % tn;
        lds_barrier();
#pragma unroll
        for (int i = 0; i < 2; ++i) { const int row = lrow + 32 * i; tile[row * 65 + c4 + 0] = pv[i][0]; tile[row * 65 + c4 + 1] = pv[i][1]; tile[row * 65 + c4 + 2] = pv[i][2]; tile[row * 65 + c4 + 3] = pv[i][3]; }
        const int un = u + gridDim.x;
        if (un < total) { const int mi2 = un / per, r2 = un % per, kt2 = r2 / tn, nt2 = r2 % tn; const float* s = src + (size_t)mi2 * K * N + (size_t)(kt2 * 64) * N + nt2 * 64;
#pragma unroll
            for (int i = 0; i < 2; ++i) pv[i] = *(const f32x4*)(s + (size_t)(lrow + 32 * i) * N + c4); }
        lds_barrier();
        { const int n = tid >> 3, k8 = (tid & 7) * 8; int ng = ntl * 64 + n;
          if (ffn_perm) ng = ng < DFF ? ((ng >> 7) * 256 + (ng & 127)) : ((((ng - DFF) >> 7) * 256) + 128 + ((ng - DFF) & 127));
          u32x4 w; w.x = cvt_pk_bf16(tile[(k8 + 0) * 65 + n], tile[(k8 + 1) * 65 + n]); w.y = cvt_pk_bf16(tile[(k8 + 2) * 65 + n], tile[(k8 + 3) * 65 + n]);
          w.z = cvt_pk_bf16(tile[(k8 + 4) * 65 + n], tile[(k8 + 5) * 65 + n]); w.w = cvt_pk_bf16(tile[(k8 + 6) * 65 + n], tile[(k8 + 7) * 65 + n]);
          *(u32x4*)(dst + (size_t)mi * K * N + (size_t)ng * K + kt * 64 + k8) = w; }
    }
    __syncthreads();
}
__device__ void phase0(const Params& p, unsigned char* smem) {
    const int tid = tidx();
    unsigned char* ws = p.ws;
    float* mod = (float*)(ws + OFF_MOD);
    {
        float* sc = (float*)smem; float* red = sc + 5 * 1024;
        const float* c = p.in[1]; const float* cctx = p.in[3]; const float* ada_w = p.in[4]; const float* ada_b = p.in[5];
        for (int i = tid; i < 5 * 1024; i += 512) { const float v = i < 4096 ? c[i] : cctx[i - 4096]; sc[i] = silu_f(v); }
        __syncthreads();
        for (int u = bidx(); u < 256; u += gridDim.x) {
            const int l = u >> 6, col0 = (u & 63) * 96, cq = tid % 24, kp = tid / 24;
            float acc[5][4];
#pragma unroll
            for (int r = 0; r < 5; ++r)
#pragma unroll
                for (int e = 0; e < 4; ++e) acc[r][e] = 0.f;
            if (kp < 21) {
                for (int k = kp; k < 1024; k += 21) { const f32x4 w = *(const f32x4*)(ada_w + ((size_t)l * 1024 + k) * 6144 + col0 + cq * 4);
#pragma unroll
                    for (int r = 0; r < 5; ++r) { const float s = sc[r * 1024 + k];
#pragma unroll
                        for (int e = 0; e < 4; ++e) acc[r][e] += s * w[e]; } }
#pragma unroll
                for (int r = 0; r < 5; ++r)
#pragma unroll
                    for (int e = 0; e < 4; ++e) red[(kp * 5 + r) * 96 + cq * 4 + e] = acc[r][e];
            }
            __syncthreads();
            if (tid < 480) { const int r = tid / 96, cc = tid % 96; float s = ada_b[l * 6144 + col0 + cc];
                for (int k2 = 0; k2 < 21; ++k2) s += red[(k2 * 5 + r) * 96 + cc];
                mod[((size_t)l * 5 + r) * 6144 + col0 + cc] = s; }
            __syncthreads();
        }
    }
    if (bidx() == 0) {
        const float* hg_lb = p.in[9]; float* lbs = (float*)(ws + OFF_LBS);
        for (int i = tid; i < 2048; i += 512) { const int dir = i >> 10, k = i & 1023; const float a0 = hg_lb[(dir * 2 + 0) * 1024 + k], a1 = hg_lb[(dir * 2 + 1) * 1024 + k];
            lbs[(dir * 2 + 0) * 1024 + k] = 0.f; lbs[(dir * 2 + 1) * 1024 + k] = 1.0f / (1.0f + expf(a0 - a1)); }
    }
    {
        const float* s = p.in[15]; bf16_t* d = (bf16_t*)(ws + OFF_WS_B);
        for (int i = bidx() * 512 + tid; i < 2 * 8 * 128 * 128 / 4; i += gridDim.x * 512) { const f32x4 v = *(const f32x4*)(s + (size_t)i * 4); u32x2 w; w.x = cvt_pk_bf16(v[0], v[1]); w.y = cvt_pk_bf16(v[2], v[3]); *(u32x2*)(d + (size_t)i * 4) = w; }
    }
    __syncthreads();
    float* tile = (float*)smem;
    transpose_cvt(p.in[8], (bf16_t*)(ws + OFF_WT_HGIN), 2, DM, HGIN, 0, tile);
    transpose_cvt(p.in[11], (bf16_t*)(ws + OFF_WT_HGOUT), 2, DM, DM, 0, tile);
    transpose_cvt(p.in[12], (bf16_t*)(ws + OFF_WT_SGIN), 2, DM, SGIN, 0, tile);
    transpose_cvt(p.in[17], (bf16_t*)(ws + OFF_WT_SGOUT), 2, SGW, DM, 0, tile);
    transpose_cvt(p.in[18], (bf16_t*)(ws + OFF_WT_UP), 4, DM, UPW, 1, tile);
    transpose_cvt(p.in[21], (bf16_t*)(ws + OFF_WT_DOWN), 4, DFF, DM, 0, tile);
}

__device__ void ln_mod(const float* src, float* hdst, bf16_t* mdst, const float* lng, const float* lnb, bool do_ln,
                       const float* shift, const float* scale, int nrows, int rows_per_b, int b0) {
    const int tid = tidx(), lane = tid & 63, gw = bidx() * 8 + (tid >> 6), nw = gridDim.x * 8;
    f32x4 g4[4], b4[4];
#pragma unroll
    for (int i = 0; i < 4; ++i) { g4[i] = do_ln ? *(const f32x4*)(lng + i * 256 + lane * 4) : zero4(); b4[i] = do_ln ? *(const f32x4*)(lnb + i * 256 + lane * 4) : zero4(); }
    f32x4 xn[2][4];
    int row0 = gw * 2;
    if (row0 < nrows) {
#pragma unroll
        for (int rr = 0; rr < 2; ++rr) { const int row = row0 + rr < nrows ? row0 + rr : row0; const float* s = src + (size_t)row * DM;
#pragma unroll
            for (int i = 0; i < 4; ++i) xn[rr][i] = *(const f32x4*)(s + i * 256 + lane * 4); }
    }
    for (; row0 < nrows; row0 += nw * 2) {
        f32x4 x[2][4];
#pragma unroll
        for (int rr = 0; rr < 2; ++rr)
#pragma unroll
            for (int i = 0; i < 4; ++i) x[rr][i] = xn[rr][i];
        const int nrow0 = row0 + nw * 2;
        if (nrow0 < nrows) {
#pragma unroll
            for (int rr = 0; rr < 2; ++rr) { const int row = nrow0 + rr < nrows ? nrow0 + rr : nrow0; const float* s = src + (size_t)row * DM;
#pragma unroll
                for (int i = 0; i < 4; ++i) xn[rr][i] = *(const f32x4*)(s + i * 256 + lane * 4); }
        }
        f32x4 s4[4], c4[4];
        if (mdst) { const int bb = b0 + row0 / rows_per_b; const float* sh = shift + (size_t)bb * 6144; const float* scl = scale + (size_t)bb * 6144;
#pragma unroll
            for (int i = 0; i < 4; ++i) { s4[i] = *(const f32x4*)(sh + i * 256 + lane * 4); c4[i] = *(const f32x4*)(scl + i * 256 + lane * 4) + 1.0f; } }
        if (do_ln) {
            float sm0 = 0.f, sm1 = 0.f;
#pragma unroll
            for (int i = 0; i < 4; ++i) { sm0 += (x[0][i][0] + x[0][i][1]) + (x[0][i][2] + x[0][i][3]); sm1 += (x[1][i][0] + x[1][i][1]) + (x[1][i][2] + x[1][i][3]); }
#pragma unroll
            for (int o = 32; o >= 1; o >>= 1) { sm0 += shx(sm0, o, lane); sm1 += shx(sm1, o, lane); }
            const float m0 = sm0 * (1.0f / 1024.0f), m1 = sm1 * (1.0f / 1024.0f); float q0 = 0.f, q1 = 0.f;
#pragma unroll
            for (int i = 0; i < 4; ++i) { const f32x4 d0 = x[0][i] - m0, d1 = x[1][i] - m1; q0 += (d0[0] * d0[0] + d0[1] * d0[1]) + (d0[2] * d0[2] + d0[3] * d0[3]); q1 += (d1[0] * d1[0] + d1[1] * d1[1]) + (d1[2] * d1[2] + d1[3] * d1[3]); }
#pragma unroll
            for (int o = 32; o >= 1; o >>= 1) { q0 += shx(q0, o, lane); q1 += shx(q1, o, lane); }
            const float r0 = rsqrtf(q0 * (1.0f / 1024.0f) + opq(1e-5f)), r1 = rsqrtf(q1 * (1.0f / 1024.0f) + opq(1e-5f));
#pragma unroll
            for (int i = 0; i < 4; ++i) { x[0][i] = (x[0][i] - m0) * r0 * g4[i] + b4[i]; x[1][i] = (x[1][i] - m1) * r1 * g4[i] + b4[i]; }
        }
#pragma unroll
        for (int rr = 0; rr < 2; ++rr) {
            const int row = row0 + rr; if (row >= nrows) break;
            if (do_ln) {
#pragma unroll
                for (int i = 0; i < 4; ++i) *(f32x4*)(hdst + (size_t)row * DM + i * 256 + lane * 4) = x[rr][i]; }
            if (mdst) {
#pragma unroll
                for (int i = 0; i < 4; ++i) { const f32x4 y = x[rr][i] * c4[i] + s4[i]; u32x2 w; w.x = cvt_pk_bf16(y[0], y[1]); w.y = cvt_pk_bf16(y[2], y[3]);
                    *(u32x2*)(mdst + (size_t)row * DM + i * 256 + lane * 4) = w; } }
        }
    }
}

template <bool SWZ>
__device__ __forceinline__ void tile_mma_128(const bf16_t* la, const bf16_t* lb, f32x4 (&acc)[8], int w, int fr, int fq) {
#pragma unroll
    for (int kk = 0; kk < 4; ++kk) {
        const bf16x8 a = *(const bf16x8*)(la + (16 * w + fr) * LDP + kk * 32 + fq * 8);
#pragma unroll
        for (int nb = 0; nb < 8; ++nb) { const int col = SWZ ? ((kk * 32 + fq * 8) ^ ((16 * nb + fr) & 0x78)) : (kk * 32 + fq * 8);
            const bf16x8 b = *(const bf16x8*)(lb + (16 * nb + fr) * LDP + col);
            acc[nb] = __builtin_amdgcn_mfma_f32_16x16x32_bf16(b, a, acc[nb], 0, 0, 0); }
    }
}

__device__ void scan_unit_mfma(unsigned char* smem, bf16_t* Z, int T, int h, const float* lbf, const float* lbb, bf16_t* OL, float* Uf, float* Ub, float* Df, float* Db) {
    bf16_t* rq = (bf16_t*)smem; bf16_t* rz = rq + 4096; bf16_t* rv = rz + 4096;
    float* tot = (float*)(smem + 24576); float* EG = tot + 512;
    bf16_t* QS = (bf16_t*)(smem + 27136); bf16_t* QE = QS + 32 * 136; bf16_t* KS0 = QE + 32 * 136; bf16_t* KS1 = KS0 + 16 * 136;
    bf16_t* KET = KS1 + 32 * 136; bf16_t* VT = KET + 128 * 40; bf16_t* Pm = VT + 128 * 40; bf16_t* ST = Pm + 32 * 40;
    const int tid = tidx(), lane = tid & 63, w = tid >> 6, fr = lane & 15, fq = lane >> 4, kc = tid & 127, g = tid >> 7;
    for (int dir = 0; dir < 2; ++dir) {
        const int zcol = (dir ? 4096 : 3072) + h * 128;
        const float lbk = ((dir ? lbb : lbf) + h * 128)[kc];
        float Lprev = 0.f;
        f32x4 sacc[8];
#pragma unroll
        for (int dt = 0; dt < 8; ++dt) sacc[dt] = (f32x4){0.f, 0.f, 0.f, 0.f};
        __syncthreads();
        for (int i = tid; i < 128 * 136 / 8; i += 512) ((u32x4*)ST)[i] = (u32x4){0u, 0u, 0u, 0u};
        u32x4 pfq, pfz, pfv;
        {   const int t = tid >> 4, c8 = (tid & 15) * 8, tok = dir ? (T - 1 - t) : t; const bf16_t* zr = Z + (size_t)tok * HGIN;
            pfq = *(const u32x4*)(zr + h * 128 + c8); pfz = *(const u32x4*)(zr + zcol + c8); pfv = *(const u32x4*)(zr + 2048 + h * 128 + c8); }
#pragma unroll 1
        for (int ch = 0; ch < T / 32; ++ch) {
            lds_barrier();
            {   const int t = tid >> 4, c8 = (tid & 15) * 8;
                *(u32x4*)(rq + t * 128 + c8) = pfq; *(u32x4*)(rz + t * 128 + c8) = pfz; *(u32x4*)(rv + t * 128 + c8) = pfv;
                if (ch + 1 < T / 32) { const int pos = (ch + 1) * 32 + t, tok = dir ? (T - 1 - pos) : pos; const bf16_t* zr = Z + (size_t)tok * HGIN;
                    pfq = *(const u32x4*)(zr + h * 128 + c8); pfz = *(const u32x4*)(zr + zcol + c8); pfv = *(const u32x4*)(zr + 2048 + h * 128 + c8); } }
            u32x2 oprev[2] = {(u32x2){0u, 0u}, (u32x2){0u, 0u}};
            if (dir) {
#pragma unroll
                for (int tt = 0; tt < 2; ++tt) { const int pos = ch * 32 + 16 * tt + fr, tok = T - 1 - pos; oprev[tt] = *(const u32x2*)(OL + (size_t)tok * DM + h * 128 + 16 * w + 4 * fq); } }
            lds_barrier();
            float lg[8], kk[8], qv[8]; float run = 0.f;
#pragma unroll
            for (int i = 0; i < 8; ++i) { const int t = 8 * g + i; const float z = bf2f(rz[t * 128 + kc]); const float f = lbk + (1.0f - lbk) * sigmoid_f(z);
                kk[i] = 1.0f - f; run += __logf(f); lg[i] = run; qv[i] = bf2f(rq[t * 128 + kc]); }
            tot[g * 128 + kc] = run;
            {   u32x4 pk; unsigned short e[8];
#pragma unroll
                for (int i = 0; i < 8; ++i) e[i] = rv[(8 * g + i) * 128 + kc];
                pk.x = (unsigned)e[0] | ((unsigned)e[1] << 16); pk.y = (unsigned)e[2] | ((unsigned)e[3] << 16); pk.z = (unsigned)e[4] | ((unsigned)e[5] << 16); pk.w = (unsigned)e[6] | ((unsigned)e[7] << 16);
                *(u32x4*)(VT + kc * 40 + 8 * g) = pk; }
            lds_barrier();
            {   const float t0 = tot[kc], t1 = tot[128 + kc], t2 = tot[256 + kc], t3 = tot[384 + kc];
                const float base = g == 0 ? 0.f : g == 1 ? t0 : g == 2 ? t0 + t1 : t0 + t1 + t2;
                const float R1 = t0 + t1, gend = R1 + t2 + t3, Rb = g >= 2 ? R1 : 0.f, eRb = g >= 2 ? __expf(R1) : 1.0f, ePrev = __expf(Lprev), eEnd1 = __expf(gend - R1);
                float kev[8];
#pragma unroll
                for (int i = 0; i < 8; ++i) { const int t = 8 * g + i; const float G = base + lg[i];
                    const float qs = qv[i] * __expf(G - Rb), qe = qs * eRb, ks1 = kk[i] * __expf(fminf(R1 - G, 80.f));
                    QS[t * 136 + kc] = f2bf(qs); QE[t * 136 + kc] = f2bf(qe); KS1[t * 136 + kc] = f2bf(ks1);
                    if (g < 2) KS0[t * 136 + kc] = f2bf(kk[i] * __expf(fminf(-G, 80.f)));
                    kev[i] = ks1 * eEnd1;
                    const int pos = ch * 32 + t, tok = dir ? (T - 1 - pos) : pos; Z[(size_t)tok * HGIN + zcol + kc] = f2bf(qe * ePrev); }
                u32x4 pk; pk.x = cvt_pk_bf16(kev[0], kev[1]); pk.y = cvt_pk_bf16(kev[2], kev[3]); pk.z = cvt_pk_bf16(kev[4], kev[5]); pk.w = cvt_pk_bf16(kev[6], kev[7]);
                *(u32x4*)(KET + kc * 40 + 8 * g) = pk;
                if (g == 0) EG[kc] = __expf(gend);
                Lprev += gend; }
            lds_barrier();
            if (w < 3) {
                const int ti = w == 0 ? 0 : 1, sj = w == 2 ? 1 : 0; const bf16_t* ksb = w == 0 ? KS0 : KS1;
                f32x4 c = (f32x4){0.f, 0.f, 0.f, 0.f};
#pragma unroll
                for (int k4 = 0; k4 < 4; ++k4) { const bf16x8 a = *(const bf16x8*)(ksb + (16 * sj + fr) * 136 + k4 * 32 + fq * 8), bb = *(const bf16x8*)(QS + (16 * ti + fr) * 136 + k4 * 32 + fq * 8);
                    c = __builtin_amdgcn_mfma_f32_16x16x32_bf16(a, bb, c, 0, 0, 0); }
                if (ti == sj) {
#pragma unroll
                    for (int r = 0; r < 4; ++r) if (4 * fq + r > fr) c[r] = 0.f; }
                u32x2 pw; pw.x = cvt_pk_bf16(c[0], c[1]); pw.y = cvt_pk_bf16(c[2], c[3]);
                *(u32x2*)(Pm + (16 * ti + fr) * 40 + 16 * sj + 4 * fq) = pw;
            } else if (w == 3) { *(u32x2*)(Pm + fr * 40 + 16 + 4 * fq) = (u32x2){0u, 0u}; }
            lds_barrier();
            {   f32x4 o0 = (f32x4){0.f, 0.f, 0.f, 0.f}, o1 = o0;
#pragma unroll
                for (int k4 = 0; k4 < 4; ++k4) { const bf16x8 a = *(const bf16x8*)(ST + (16 * w + fr) * 136 + k4 * 32 + fq * 8);
                    const bf16x8 b0 = *(const bf16x8*)(QE + fr * 136 + k4 * 32 + fq * 8), b1 = *(const bf16x8*)(QE + (16 + fr) * 136 + k4 * 32 + fq * 8);
                    o0 = __builtin_amdgcn_mfma_f32_16x16x32_bf16(a, b0, o0, 0, 0, 0); o1 = __builtin_amdgcn_mfma_f32_16x16x32_bf16(a, b1, o1, 0, 0, 0); }
                {   const bf16x8 a = *(const bf16x8*)(VT + (16 * w + fr) * 40 + fq * 8), b0 = *(const bf16x8*)(Pm + fr * 40 + fq * 8), b1 = *(const bf16x8*)(Pm + (16 + fr) * 40 + fq * 8);
                    o0 = __builtin_amdgcn_mfma_f32_16x16x32_bf16(a, b0, o0, 0, 0, 0); o1 = __builtin_amdgcn_mfma_f32_16x16x32_bf16(a, b1, o1, 0, 0, 0); }
#pragma unroll
                for (int tt = 0; tt < 2; ++tt) { f32x4 r = tt ? o1 : o0; const int pos = ch * 32 + 16 * tt + fr, tok = dir ? (T - 1 - pos) : pos;
                    bf16_t* op = OL + (size_t)tok * DM + h * 128 + 16 * w + 4 * fq;
                    if (dir) { const u32x2 pv = oprev[tt]; r[0] += bflo(pv.x); r[1] += bfhi(pv.x); r[2] += bflo(pv.y); r[3] += bfhi(pv.y); }
                    u32x2 wv; wv.x = cvt_pk_bf16(r[0], r[1]); wv.y = cvt_pk_bf16(r[2], r[3]); *(u32x2*)op = wv; }
                const f32x4 eg4 = *(const f32x4*)(EG + 16 * w + 4 * fq);
                const bf16x8 ak = *(const bf16x8*)(KET + (16 * w + fr) * 40 + fq * 8);
#pragma unroll
                for (int dt = 0; dt < 8; ++dt) { const bf16x8 bv = *(const bf16x8*)(VT + (16 * dt + fr) * 40 + fq * 8);
                    sacc[dt] = __builtin_amdgcn_mfma_f32_16x16x32_bf16(ak, bv, sacc[dt] * eg4, 0, 0, 0); }
            }
            lds_barrier();
#pragma unroll
            for (int dt = 0; dt < 8; ++dt) { u32x2 sw; sw.x = cvt_pk_bf16(sacc[dt][0], sacc[dt][1]); sw.y = cvt_pk_bf16(sacc[dt][2], sacc[dt][3]);
                *(u32x2*)(ST + (16 * dt + fr) * 136 + 16 * w + 4 * fq) = sw; }
        }
        float* U = dir ? Ub : Uf;
#pragma unroll
        for (int dt = 0; dt < 8; ++dt) *(f32x4*)(U + (16 * dt + fr) * 128 + 16 * w + 4 * fq) = sacc[dt];
        if (g == 0) (dir ? Db : Df)[kc] = __expf(Lprev);
    }
    __syncthreads();
}
__device__ void scan_pass2(float* U, const float* Dk, const float* Uctx, int s) {
    const int gt = bidx() * 512 + tidx(), nt = gridDim.x * 512;
    for (int e4 = gt; e4 < 32 * 4096; e4 += nt) {
        const int seq = e4 >> 12, el = (e4 & 4095) * 4, k = el & 127, bl = seq >> 4, hd = seq & 15, dir = seq & 1;
        f32x4 cur = *(const f32x4*)(Uctx + (size_t)((s * 2 + bl) * 16 + hd) * 16384 + el);
        f32x4 tu[16], td[16];
#pragma unroll
        for (int j = 0; j < 16; ++j) { tu[j] = *(const f32x4*)(U + ((size_t)seq * 16 + j) * 16384 + el); td[j] = *(const f32x4*)(Dk + (seq * 16 + j) * 128 + k); }
        if (dir == 0) {
#pragma unroll
            for (int j = 0; j < 16; ++j) { const f32x4 nxt = cur * td[j] + tu[j]; tu[j] = cur; cur = nxt; }
        } else {
#pragma unroll
            for (int j = 15; j >= 0; --j) { const f32x4 nxt = cur * td[j] + tu[j]; tu[j] = cur; cur = nxt; }
        }
#pragma unroll
        for (int j = 0; j < 16; ++j) *(f32x4*)(U + ((size_t)seq * 16 + j) * 16384 + el) = tu[j];
    }
}
__device__ void scan_pass3_unit(unsigned char* smem, bf16_t* Z, const bf16_t* OL, const float* U, const float* normw, int bl, int h, int tile) {
    bf16_t* la = (bf16_t*)smem; bf16_t* lb = la + 128 * LDP;
    const int tid = tidx(), w = tid >> 6, lane = tid & 63, fr = lane & 15, fq = lane >> 4;
    const int tok0 = bl * SEQ + tile * 128, j = tile >> 2, tok = tok0 + 16 * w + fr;
    u32x4 ra[2][4]; f32x4 rb[2][4][2]; u32x2 rol[8], rg[8];
#pragma unroll
    for (int dir = 0; dir < 2; ++dir) {
        const int zcol = (dir ? 4096 : 3072) + h * 128; const float* Sp = U + ((size_t)((bl * 8 + h) * 2 + dir) * 16 + j) * 16384;
#pragma unroll
        for (int i = 0; i < 4; ++i) { const int c = tid + 512 * i, r = c >> 4, k8 = (c & 15) * 8;
            ra[dir][i] = *(const u32x4*)(Z + (size_t)(tok0 + r) * HGIN + zcol + k8);
            rb[dir][i][0] = *(const f32x4*)(Sp + r * 128 + k8); rb[dir][i][1] = *(const f32x4*)(Sp + r * 128 + k8 + 4); }
    }
#pragma unroll
    for (int nb = 0; nb < 8; ++nb) { rol[nb] = *(const u32x2*)(OL + (size_t)tok * DM + h * 128 + 16 * nb + 4 * fq); rg[nb] = *(const u32x2*)(Z + (size_t)tok * HGIN + 1024 + h * 128 + 16 * nb + 4 * fq); }
    f32x4 acc[8];
#pragma unroll
    for (int nb = 0; nb < 8; ++nb) acc[nb] = (f32x4){0.f, 0.f, 0.f, 0.f};
#pragma unroll
    for (int dir = 0; dir < 2; ++dir) {
        lds_barrier();
#pragma unroll
        for (int i = 0; i < 4; ++i) { const int c = tid + 512 * i, r = c >> 4, k8 = (c & 15) * 8;
            *(u32x4*)(la + r * LDP + k8) = ra[dir][i];
            u32x4 pk; pk.x = cvt_pk_bf16(rb[dir][i][0][0], rb[dir][i][0][1]); pk.y = cvt_pk_bf16(rb[dir][i][0][2], rb[dir][i][0][3]); pk.z = cvt_pk_bf16(rb[dir][i][1][0], rb[dir][i][1][1]); pk.w = cvt_pk_bf16(rb[dir][i][1][2], rb[dir][i][1][3]);
            *(u32x4*)(lb + r * LDP + k8) = pk; }
        lds_barrier();
        tile_mma_128<false>(la, lb, acc, w, fr, fq);
    }
    float ss = 0.f;
#pragma unroll
    for (int nb = 0; nb < 8; ++nb) { const u32x2 pv = rol[nb];
        acc[nb][0] += bflo(pv.x); acc[nb][1] += bfhi(pv.x); acc[nb][2] += bflo(pv.y); acc[nb][3] += bfhi(pv.y);
        ss += (acc[nb][0] * acc[nb][0] + acc[nb][1] * acc[nb][1]) + (acc[nb][2] * acc[nb][2] + acc[nb][3] * acc[nb][3]); }
    ss += shx(ss, 16, lane); ss += shx(ss, 32, lane);
    const float rn = rsqrtf(ss * (1.0f / 128.0f) + opq(1e-6f));
#pragma unroll
    for (int nb = 0; nb < 8; ++nb) { bf16_t* gp = Z + (size_t)tok * HGIN + 1024 + h * 128 + 16 * nb + 4 * fq; const u32x2 gv = rg[nb];
        const f32x4 nw = *(const f32x4*)(normw + 16 * nb + 4 * fq);
        u32x2 wv; wv.x = cvt_pk_bf16(acc[nb][0] * rn * nw[0] * bflo(gv.x), acc[nb][1] * rn * nw[1] * bfhi(gv.x));
        wv.y = cvt_pk_bf16(acc[nb][2] * rn * nw[2] * bflo(gv.y), acc[nb][3] * rn * nw[3] * bfhi(gv.y)); *(u32x2*)gp = wv; }
}
__device__ void ctx_readout(bf16_t* Zc, const bf16_t* OLc, const float* normw) {
    const int lane = tidx() & 63, gw = bidx() * 8 + (tidx() >> 6), nw = gridDim.x * 8;
    for (int row = gw; row < MCTX; row += nw) {
        const bf16_t* op = OLc + (size_t)row * DM + lane * 16; bf16_t* gp = Zc + (size_t)row * HGIN + 1024 + lane * 16;
        const u32x4 o0 = *(const u32x4*)op, o1 = *(const u32x4*)(op + 8);
        float o[16] = {bflo(o0.x), bfhi(o0.x), bflo(o0.y), bfhi(o0.y), bflo(o0.z), bfhi(o0.z), bflo(o0.w), bfhi(o0.w), bflo(o1.x), bfhi(o1.x), bflo(o1.y), bfhi(o1.y), bflo(o1.z), bfhi(o1.z), bflo(o1.w), bfhi(o1.w)};
        float ss = 0.f;
#pragma unroll
        for (int e = 0; e < 16; ++e) ss += o[e] * o[e];
        ss += shx(ss, 1, lane); ss += shx(ss, 2, lane); ss += shx(ss, 4, lane);
        const float rn = rsqrtf(ss * (1.0f / 128.0f) + opq(1e-6f));
        const u32x4 g0 = *(const u32x4*)gp, g1 = *(const u32x4*)(gp + 8);
        const float g[16] = {bflo(g0.x), bfhi(g0.x), bflo(g0.y), bfhi(g0.y), bflo(g0.z), bfhi(g0.z), bflo(g0.w), bfhi(g0.w), bflo(g1.x), bfhi(g1.x), bflo(g1.y), bfhi(g1.y), bflo(g1.z), bfhi(g1.z), bflo(g1.w), bfhi(g1.w)};
        const float* nwp = normw + (lane & 7) * 16;
#pragma unroll
        for (int e = 0; e < 16; ++e) o[e] = o[e] * rn * nwp[e] * g[e];
        u32x4 w0, w1; w0.x = cvt_pk_bf16(o[0], o[1]); w0.y = cvt_pk_bf16(o[2], o[3]); w0.z = cvt_pk_bf16(o[4], o[5]); w0.w = cvt_pk_bf16(o[6], o[7]);
        w1.x = cvt_pk_bf16(o[8], o[9]); w1.y = cvt_pk_bf16(o[10], o[11]); w1.z = cvt_pk_bf16(o[12], o[13]); w1.w = cvt_pk_bf16(o[14], o[15]);
        *(u32x4*)gp = w0; *(u32x4*)(gp + 8) = w1;
    }
}

__device__ void sgu_mix_unit(unsigned char* smem, bf16_t* Z, int chunk, int gh, const bf16_t* wsb  , const float* bs  , const float* lng, const float* lnb, const float* sgst) {
    float* stats = (float*)smem;
    bf16_t* la = (bf16_t*)(smem + 1024); bf16_t* lb = la + 128 * LDP;
    const int tid = tidx(), w = tid >> 6, lane = tid & 63, fr = lane & 15, fq = lane >> 4;
    const int t0 = chunk * 128;
    __syncthreads();
    if (tid < 128) { const f32x2 sq = *(const f32x2*)(sgst + (size_t)(t0 + tid) * 2); const float mean = sq.x * (1.0f / 3072.0f), var = fmaxf(sq.y * (1.0f / 3072.0f) - mean * mean, 0.f);
        stats[tid * 2] = mean; stats[tid * 2 + 1] = rsqrtf(var + opq(1e-5f)); }
    u32x4 vreg[4];
#pragma unroll
    for (int i = 0; i < 4; ++i) { const int c = tid + 512 * i, q = c >> 4, c8 = (c & 15) * 8; vreg[i] = *(const u32x4*)(Z + (size_t)(t0 + q) * SGIN + SGW + (gh * 4) * 384 + c8); }
#pragma unroll 1
    for (int it = 0; it < 12; ++it) {
        const int g = gh * 4 + it / 3, cb = it % 3, cg0 = g * 384 + cb * 128;
        lds_barrier();
        if (cb == 0) {
#pragma unroll
            for (int i = 0; i < 4; ++i) { const int c = tid + 512 * i, r = c >> 4, k8 = (c & 15) * 8; *(u32x4*)(la + r * LDP + k8) = *(const u32x4*)(wsb + ((size_t)g * 128 + r) * 128 + k8); }
        }
#pragma unroll
        for (int i = 0; i < 4; ++i) { const int c = tid + 512 * i, q = c >> 4, c8 = (c & 15) * 8;
            const u32x4 v = vreg[i];
            const float mean = stats[q * 2], rstd = stats[q * 2 + 1];
            const float xv[8] = {bflo(v.x), bfhi(v.x), bflo(v.y), bfhi(v.y), bflo(v.z), bfhi(v.z), bflo(v.w), bfhi(v.w)};
            const f32x4 g0 = *(const f32x4*)(lng + cg0 + c8), g1 = *(const f32x4*)(lng + cg0 + c8 + 4), b0 = *(const f32x4*)(lnb + cg0 + c8), b1 = *(const f32x4*)(lnb + cg0 + c8 + 4);
#pragma unroll
            for (int e = 0; e < 8; ++e) { const float gg = e < 4 ? g0[e & 3] : g1[e & 3], bb = e < 4 ? b0[e & 3] : b1[e & 3];
                lb[(c8 + e) * LDP + (q ^ (c8 & 0x78))] = f2bf((xv[e] - mean) * rstd * gg + bb); } }
        if (it + 1 < 12) { const int gn = gh * 4 + (it + 1) / 3, cn = gn * 384 + ((it + 1) % 3) * 128;
#pragma unroll
            for (int i = 0; i < 4; ++i) { const int c = tid + 512 * i, q = c >> 4, c8 = (c & 15) * 8; vreg[i] = *(const u32x4*)(Z + (size_t)(t0 + q) * SGIN + SGW + cn + c8); } }
        const int pr = 16 * w + fr;
        u32x2 ureg[8];
#pragma unroll
        for (int nb = 0; nb < 8; ++nb) ureg[nb] = *(const u32x2*)(Z + (size_t)(t0 + pr) * SGIN + cg0 + 16 * nb + 4 * fq);
        const float bias = bs[g * 128 + pr];
        lds_barrier();
        f32x4 acc[8];
#pragma unroll
        for (int nb = 0; nb < 8; ++nb) acc[nb] = (f32x4){0.f, 0.f, 0.f, 0.f};
        tile_mma_128<true>(la, lb, acc, w, fr, fq);
#pragma unroll
        for (int nb = 0; nb < 8; ++nb) { bf16_t* up = Z + (size_t)(t0 + pr) * SGIN + cg0 + 16 * nb + 4 * fq; const u32x2 uv = ureg[nb];
            u32x2 wv; wv.x = cvt_pk_bf16(bflo(uv.x) * (acc[nb][0] + bias), bfhi(uv.x) * (acc[nb][1] + bias)); wv.y = cvt_pk_bf16(bflo(uv.y) * (acc[nb][2] + bias), bfhi(uv.y) * (acc[nb][3] + bias));
            *(u32x2*)up = wv; }
    }
}

__device__ void conv_swiglu(const bf16_t* Z, bf16_t* act, const float* cw, const float* cb, int rows, int row_len) {
    const int gt = bidx() * 512 + tidx(), nt = gridDim.x * 512, total = rows * 352;
    for (int i = gt; i < total; i += nt) {
        const int t = i / 352, j8 = (i % 352) * 8, np = (j8 >> 7) * 256 + (j8 & 127), pos = t % row_len;
        const bool hasL = pos != 0, hasR = pos != row_len - 1;
        const bf16_t* zr = Z + (size_t)t * UPW + np; const u32x4 zero = (u32x4){0u, 0u, 0u, 0u};
        const u32x4 a1 = *(const u32x4*)zr, g1 = *(const u32x4*)(zr + 128);
        const u32x4 a0 = hasL ? *(const u32x4*)(zr - UPW) : zero, g0 = hasL ? *(const u32x4*)(zr - UPW + 128) : zero;
        const u32x4 a2 = hasR ? *(const u32x4*)(zr + UPW) : zero, g2 = hasR ? *(const u32x4*)(zr + UPW + 128) : zero;
        float r[8];
#pragma unroll
        for (int e = 0; e < 8; ++e) { const int j = j8 + e; const unsigned sh = (e & 1) ? 0u : 16u;
            const unsigned wa0 = e < 2 ? a0.x : e < 4 ? a0.y : e < 6 ? a0.z : a0.w, wa1 = e < 2 ? a1.x : e < 4 ? a1.y : e < 6 ? a1.z : a1.w, wa2 = e < 2 ? a2.x : e < 4 ? a2.y : e < 6 ? a2.z : a2.w;
            const unsigned wg0 = e < 2 ? g0.x : e < 4 ? g0.y : e < 6 ? g0.z : g0.w, wg1 = e < 2 ? g1.x : e < 4 ? g1.y : e < 6 ? g1.z : g1.w, wg2 = e < 2 ? g2.x : e < 4 ? g2.y : e < 6 ? g2.z : g2.w;
            const float fa0 = __uint_as_float((wa0 << sh) & 0xffff0000u), fa1 = __uint_as_float((wa1 << sh) & 0xffff0000u), fa2 = __uint_as_float((wa2 << sh) & 0xffff0000u);
            const float fg0 = __uint_as_float((wg0 << sh) & 0xffff0000u), fg1 = __uint_as_float((wg1 << sh) & 0xffff0000u), fg2 = __uint_as_float((wg2 << sh) & 0xffff0000u);
            const float av = cw[j] * fa0 + cw[UPW + j] * fa1 + cw[2 * UPW + j] * fa2 + cb[j];
            const float gv = cw[DFF + j] * fg0 + cw[UPW + DFF + j] * fg1 + cw[2 * UPW + DFF + j] * fg2 + cb[DFF + j];
            r[e] = silu_f(gv) * av; }
        u32x4 w; w.x = cvt_pk_bf16(r[0], r[1]); w.y = cvt_pk_bf16(r[2], r[3]); w.z = cvt_pk_bf16(r[4], r[5]); w.w = cvt_pk_bf16(r[6], r[7]);
        *(u32x4*)(act + (size_t)t * DFF + j8) = w;
    }
}
enum { T_NONE = 0, T_P0, T_INIT, T_GEMM_IN, T_SCAN1, T_SCAN2, T_SCAN3, T_MIX, T_GEMM_OUT, T_LN1, T_GEMM_UP, T_CONV, T_GEMM_DN, T_LN2, T_READOUT };
constexpr int NPHASES = 2 + 14 + 10 + 14 + 10;
__device__ __forceinline__ void decode_phase(int ph, int& type, int& l, int& s) {
    l = 0; s = 0;
    if (ph == 0) { type = T_P0; return; }
    if (ph == 1) { type = T_INIT; return; }
    int q = ph - 2;
    if (q < 14) l = 0; else if (q < 24) { l = 1; q -= 14; } else if (q < 38) { l = 2; q -= 24; } else { l = 3; q -= 38; }
    const int half = (l & 1) ? 3 : 5, nm = 2 * half;
    if (q < nm) { s = q / half; const int st = q % half;
        if (l & 1) type = st == 0 ? T_GEMM_IN : st == 1 ? T_MIX : T_GEMM_OUT;
        else type = st == 0 ? T_GEMM_IN : st == 1 ? T_SCAN1 : st == 2 ? T_SCAN2 : st == 3 ? T_SCAN3 : T_GEMM_OUT;
        return; }
    q -= nm;
    type = q == 0 ? T_LN1 : q == 1 ? T_GEMM_UP : q == 2 ? T_GEMM_DN : T_LN2;
}
__device__ __forceinline__ void decode_ctx(int ph, int& type, int& l) {
    const int c = ph - 2; type = T_NONE; l = 0;
    if (c < 0 || c > 18) return;
    if (c < 9) { l = 0; type = c == 0 ? T_GEMM_IN : c == 1 ? T_SCAN1 : c == 2 ? T_READOUT : c == 3 ? T_GEMM_OUT : c == 4 ? T_LN1 : c == 5 ? T_GEMM_UP : c == 6 ? T_CONV : c == 7 ? T_GEMM_DN : T_LN2; }
    else if (c < 17) { const int d = c - 9; l = 1; type = d == 0 ? T_GEMM_IN : d == 1 ? T_MIX : d == 2 ? T_GEMM_OUT : d == 3 ? T_LN1 : d == 4 ? T_GEMM_UP : d == 5 ? T_CONV : d == 6 ? T_GEMM_DN : T_LN2; }
    else { l = 2; type = c == 17 ? T_GEMM_IN : T_SCAN1; }
}
__device__ __forceinline__ bool is_gemm(int t) { return t == T_GEMM_IN || t == T_GEMM_OUT || t == T_GEMM_UP || t == T_GEMM_DN; }
__global__ __launch_bounds__(512, 2) void fwd_megakernel(Params p) {
    extern __shared__ __attribute__((aligned(16))) unsigned char smem[];
    { cg::grid_group grid = cg::this_grid(); grid.sync(); }
    unsigned char* ws0 = p.ws;
    const int nblk = gridDim.x, bid = bidx();
    unsigned char* ws = ws0;
    volatile XLAS unsigned* xst = (volatile XLAS unsigned*)((XLAS unsigned char*)smem + 131072 + 256);
    if (threadIdx.x == 0) { xst[0] = 0u; xst[1] = 0u; xst[2] = 0u; xst[3] = 0u; }
    if ((threadIdx.x & 63) == 0) *(volatile XLAS int*)((XLAS unsigned char*)smem + WTAB_OFF + 4 * hw_slot()) = (int)(threadIdx.x >> 6);
    __syncthreads();
    const XcdBarrier xb = xcd_barrier_post((unsigned*)(ws + OFF_BAR), xst);
#ifdef PROBE_MASK
    unsigned long long pr_acc = 0ull, pr_t0 = __builtin_amdgcn_s_memrealtime();
#endif
    for (int ph = 0; ph < NPHASES; ++ph) {
        int type, l, s, ctype, cl; decode_phase(ph, type, l, s); decode_ctx(ph, ctype, cl);
        unsigned char* ws = ws0; asm volatile("" : "+s"(ws));
        const float* x = p.in[0]; const float* ctxin = p.in[2];
        float* out = p.out; asm volatile("" : "+s"(out));
        float* mod = (float*)(ws + OFF_MOD); const float* lbs = (const float*)(ws + OFF_LBS);
        bf16_t* hmod = (bf16_t*)(ws + OFF_HMOD); float* hc = (float*)(ws + OFF_HC); bf16_t* hcmod = (bf16_t*)(ws + OFF_HCMOD);
        bf16_t* Zc = (bf16_t*)(ws + OFF_ZC); bf16_t* actc = (bf16_t*)(ws + OFF_ACTC); bf16_t* OLc = (bf16_t*)(ws + OFF_OLC);
        float* Uctx = (float*)(ws + OFF_UCTX); float* Dctx = (float*)(ws + OFF_DCTX);
        unsigned char* big = ws + OFF_BIG;
        bf16_t* Zhg = (bf16_t*)(big + BIG_HG_Z); bf16_t* OL = (bf16_t*)(big + BIG_HG_OL); float* U = (float*)(big + BIG_HG_U); float* Dk = (float*)(big + BIG_HG_D);
        bf16_t* Zb = (bf16_t*)big; bf16_t* act = (bf16_t*)big;
        if (type == T_P0) {
            phase0(p, smem);
        } else if (type == T_INIT) {
            ln_mod(x, nullptr, hmod, nullptr, nullptr, false, mod + 0, mod + 1024, MLAT, SEQ, 0);
            ln_mod(ctxin, nullptr, hcmod, nullptr, nullptr, false, mod + 0, mod + 1024, MCTX, 1 << 30, 4);
        }
        if (is_gemm(type) || is_gemm(ctype)) {
            GemmJob j; j.e.kind = 0; j.e.O = nullptr; j.e.ldc = 0; j.e.mode = 0; j.e.silu_tiles = 0; j.e.hin = nullptr; j.e.out = nullptr; j.e.gate = nullptr; j.e.b0 = 0; j.e.ctx = 0;
            j.A = nullptr; j.Bt = nullptr; j.lda = 0; j.M = 0; j.N = 0; j.K = 0;
            for (int job = 0; job < 2; ++job) {
                const bool c = job == 1; const int t = c ? ctype : type, ll = c ? cl : l;
                if (!is_gemm(t)) continue;
                const int kind = ll & 1, idx = ll >> 1; const float* modl = mod + (size_t)ll * 5 * 6144;
                const float* hin = (ll == 0) ? x : out; const float* hcin = (ll == 0) ? ctxin : hc;
                if (t == T_GEMM_IN) {
                    j.A = c ? hcmod : hmod + (size_t)s * SLAB * DM; j.lda = DM; j.K = DM; j.M = c ? MCTX : SLAB; j.e.kind = 0;
                    if (kind == 0) { j.Bt = (const bf16_t*)(ws + OFF_WT_HGIN) + (size_t)idx * HGIN * DM; j.N = HGIN; j.e.O = c ? Zc : Zhg; j.e.ldc = HGIN; j.e.mode = 1; j.e.silu_tiles = 8; }
                    else { j.Bt = (const bf16_t*)(ws + OFF_WT_SGIN) + (size_t)idx * SGIN * DM; j.N = SGIN; j.e.O = c ? Zc : Zb; j.e.ldc = SGIN; j.e.mode = 2; j.e.silu_tiles = 0;
                        j.e.out = (float*)(ws + OFF_SGST) + (c ? (size_t)4 * SLAB * 2 : (size_t)(idx * 2 + s) * SLAB * 2); }
                } else if (t == T_GEMM_OUT) {
                    j.M = c ? MCTX : SLAB; j.N = DM; j.e.kind = 1; j.e.hin = c ? hcin : hin + (size_t)s * SLAB * DM; j.e.out = c ? hc : out + (size_t)s * SLAB * DM; j.e.gate = modl + 2048; j.e.b0 = s * 2; j.e.ctx = c ? 1 : 0;
                    if (kind == 0) { j.A = (c ? Zc : Zhg) + 1024; j.lda = HGIN; j.K = DM; j.Bt = (const bf16_t*)(ws + OFF_WT_HGOUT) + (size_t)idx * DM * DM; }
                    else { j.A = c ? Zc : Zb; j.lda = SGIN; j.K = SGW; j.Bt = (const bf16_t*)(ws + OFF_WT_SGOUT) + (size_t)idx * DM * SGW; }
                } else if (t == T_GEMM_UP) {
                    j.A = c ? hcmod : hmod; j.lda = DM; j.K = DM; j.M = c ? MCTX : MLAT; j.N = UPW; j.Bt = (const bf16_t*)(ws + OFF_WT_UP) + (size_t)ll * UPW * DM;
                    if (c) { j.e.kind = 0; j.e.O = Zc; j.e.ldc = UPW; j.e.mode = 0; j.e.silu_tiles = 0; }
                    else { j.e.kind = 2; j.e.O = act; j.e.ldc = DFF; j.e.hin = p.in[19] + (size_t)ll * 3 * UPW; j.e.gate = p.in[20] + (size_t)ll * UPW; }
                } else {
                    j.A = c ? actc : act; j.lda = DFF; j.K = DFF; j.M = c ? MCTX : MLAT; j.N = DM; j.Bt = (const bf16_t*)(ws + OFF_WT_DOWN) + (size_t)ll * DM * DFF;
                    j.e.kind = 1; j.e.hin = c ? hc : out; j.e.out = c ? hc : out; j.e.gate = modl + 5120; j.e.b0 = 0; j.e.ctx = c ? 1 : 0;
                }
#ifndef NO_GEMM
                gemm_call(smem, j);
#endif
            }
        }
        {
            const int idx = l >> 1; const float* modl = mod + (size_t)l * 5 * 6144;
            const float* lbf = lbs + (0 * 2 + idx) * 1024; const float* lbb = lbs + (1 * 2 + idx) * 1024; const float* normw = p.in[10] + idx * 128;
            if (type == T_SCAN1 || ctype == T_SCAN1) {
                const int cidx = cl >> 1;
                const int n0 = type == T_SCAN1 ? 256 : 0, nu = n0 + (ctype == T_SCAN1 ? 32 : 0);
                for (int u = bid; u < nu; u += nblk) {
                    bf16_t* Zp; bf16_t* OLp; float *Uf, *Ub, *Df, *Db; int T, h; const float *lf, *lb2;
                    if (u < n0) { const int bl = u >> 7, sc = u & 15; h = (u >> 4) & 7; const size_t t0 = (size_t)bl * SEQ + sc * 512; const int sq = (bl * 8 + h) * 2; T = 512; lf = lbf; lb2 = lbb;
                        Zp = Zhg + t0 * HGIN; OLp = OL + t0 * DM; Uf = U + ((size_t)(sq + 0) * 16 + sc) * 16384; Ub = U + ((size_t)(sq + 1) * 16 + sc) * 16384; Df = Dk + ((sq + 0) * 16 + sc) * 128; Db = Dk + ((sq + 1) * 16 + sc) * 128; }
                    else { const int uc = u - n0, b = uc >> 3; h = uc & 7; const int sq = (b * 8 + h) * 2; T = CTXL; lf = lbs + (0 * 2 + cidx) * 1024; lb2 = lbs + (1 * 2 + cidx) * 1024;
                        Zp = Zc + (size_t)b * CTXL * HGIN; OLp = OLc + (size_t)b * CTXL * DM; Uf = Uctx + (size_t)(sq + 0) * 16384; Ub = Uctx + (size_t)(sq + 1) * 16384; Df = Dctx + (sq + 0) * 128; Db = Dctx + (sq + 1) * 128; }
#ifndef NO_SCAN1
                    scan_unit_mfma(smem, Zp, T, h, lf, lb2, OLp, Uf, Ub, Df, Db);
#endif
                }
            }
            if (type == T_SCAN2) {
#ifndef NO_SCAN2
                scan_pass2(U, Dk, Uctx, s);
#endif
            } else if (type == T_SCAN3) {
#ifndef NO_SCAN3
                for (int u = bid; u < 1024; u += nblk) scan_pass3_unit(smem, Zhg, OL, U, normw, u >> 9, (u >> 6) & 7, u & 63);
#endif
            }
            if (type == T_MIX || ctype == T_MIX) {
                const int n0 = type == T_MIX ? 256 : 0, nu = n0 + (ctype == T_MIX ? 16 : 0);
                for (int u = bid; u < nu; u += nblk) { const bool c = u >= n0; const int uu = c ? u - n0 : u; const int ix = (c ? cl : l) >> 1;
                    const bf16_t* wsb = (const bf16_t*)(ws + OFF_WS_B) + (size_t)ix * 8 * 128 * 128;
#ifndef NO_MIX
                    sgu_mix_unit(smem, c ? Zc : Zb, uu >> 1, uu & 1, wsb, p.in[16] + ix * 8 * 128, p.in[13] + ix * SGW, p.in[14] + ix * SGW, (const float*)(ws + OFF_SGST) + (c ? (size_t)4 * SLAB * 2 : (size_t)(ix * 2 + s) * SLAB * 2));
#endif
                }
            }
            if (type == T_LN1 || type == T_LN2) {
                const int which = type == T_LN1 ? 0 : 1;
                const float* modn = type == T_LN1 ? modl + 3072 : mod + (size_t)(l + 1) * 5 * 6144;
                const bool want_mod = type == T_LN1 || l < 3;
                ln_mod(out, out, want_mod ? hmod : nullptr, p.in[6] + (l * 2 + which) * DM, p.in[7] + (l * 2 + which) * DM, true, modn + 0, modn + 1024, MLAT, SEQ, 0);
            }
        }
        if (ctype == T_READOUT) {
#ifndef NO_CTXR
            ctx_readout(Zc, OLc, p.in[10]);
#endif
        } else if (ctype == T_CONV) {
#ifndef NO_CONV
            conv_swiglu(Zc, actc, p.in[19] + (size_t)cl * 3 * UPW, p.in[20] + (size_t)cl * UPW, MCTX, CTXL);
#endif
        } else if (ctype == T_LN1 || ctype == T_LN2) {
            const int which = ctype == T_LN1 ? 0 : 1;
            const float* modn = ctype == T_LN1 ? mod + (size_t)cl * 5 * 6144 + 3072 : mod + (size_t)(cl + 1) * 5 * 6144;
            ln_mod(hc, hc, hcmod, p.in[6] + (cl * 2 + which) * DM, p.in[7] + (cl * 2 + which) * DM, true, modn + 0, modn + 1024, MCTX, 1 << 30, 4);
        }
#ifdef PROBE_MASK
        xcd_barrier(xb);
        { const unsigned long long t1 = __builtin_amdgcn_s_memrealtime(); if ((PROBE_MASK >> type) & 1u) pr_acc += t1 - pr_t0; pr_t0 = t1; }
#else
        if (ph + 1 < NPHASES) xcd_barrier(xb);
#endif
    }
#ifdef PROBE_MASK
    if (bidx() == 0) { const int n = (int)(pr_acc / 200ull);
        for (int i = tidx(); i < n; i += 512) p.out[(size_t)i * 331] += 0.1f; }
#endif
}

extern "C" void kernel_launch(void* const* d_in, const int* in_sizes, int n_in, void* d_out, int out_size, void* d_ws, size_t ws_size, hipStream_t stream) {
    static int grid_blocks = 0;
    if (!grid_blocks) {
        int dev = 0, cus = 0, per_cu = 0;
        hipGetDevice(&dev);
        hipDeviceGetAttribute(&cus, hipDeviceAttributeMultiprocessorCount, dev);
        hipFuncSetAttribute((const void*)fwd_megakernel, hipFuncAttributeMaxDynamicSharedMemorySize, LDS_BYTES);
        hipOccupancyMaxActiveBlocksPerMultiprocessor(&per_cu, (const void*)fwd_megakernel, 512, LDS_BYTES);
        if (per_cu < 1) per_cu = 1;
        grid_blocks = cus * per_cu;
        (void)hipGetLastError();
    }
    if (n_in != 22 || ws_size < WS_END) { fprintf(stderr, "kernel_launch: unexpected inputs (n_in %d, ws %zu < %zu)\n", n_in, ws_size, (size_t)WS_END); return; }
    (void)hipMemsetAsync((unsigned char*)d_ws + OFF_BAR, 0, (OFF_SGST - OFF_BAR) + SGST_BYTES, stream);
    Params p{};
    for (int i = 0; i < 22; ++i) p.in[i] = (const float*)d_in[i];
    p.out = (float*)d_out; p.ws = (unsigned char*)d_ws;
    void* args[] = {&p};
    hipError_t e = hipLaunchCooperativeKernel((const void*)fwd_megakernel, dim3(grid_blocks), dim3(512), args, LDS_BYTES, stream);
    if (e != hipSuccess) fprintf(stderr, "cooperative launch failed: %s (grid %d)\n", hipGetErrorString(e), grid_blocks);
}
```
